# Optimizing an MI355X kernel written in HIP

```python
import math
import jax, jax.numpy as jnp
from jax import lax
import numpy as np

D_MODEL = 2048
BATCH = 4
SEQ = 4096
DEPTH = 2

N_A = DEPTH // 2
N_B = DEPTH - N_A

POOL_WINDOWS = (2, 4, 8, 16)
N_POOL_GROUPS = len(POOL_WINDOWS)
POOL_GROUP = D_MODEL // N_POOL_GROUPS

N_DIFF_HEADS = D_MODEL // 256
DIFF_HEAD_DIM = D_MODEL // N_DIFF_HEADS // 2
V_HEAD_DIM = 2 * DIFF_HEAD_DIM
ROT_DIM = DIFF_HEAD_DIM // 4
ROPE_THETA = 500000.0
Q_BLOCK = 128

D_FF = -(-8 * D_MODEL // (3 * 256)) * 256

EPS = 1e-6

kernel_name = "yoco_pool_diffattn_hybrid"


def rmsnorm(x, g):
    xf = x.astype(jnp.float32)
    y = xf * lax.rsqrt(jnp.mean(xf * xf, axis=-1, keepdims=True) + EPS)
    return (y * g.astype(jnp.float32)).astype(x.dtype)


def lambda_init_for(layer_idx):
    return 0.8 - 0.6 * math.exp(-0.3 * layer_idx)


def rope_tables(s):
    inv = ROPE_THETA ** (-jnp.arange(0, ROT_DIM, 2, dtype=jnp.float32) / ROT_DIM)
    ang = jnp.arange(s, dtype=jnp.float32)[:, None] * inv[None, :]
    return jnp.cos(ang), jnp.sin(ang)


def apply_partial_rope(x, cos, sin):
    half = ROT_DIM // 2
    xr = x[..., :ROT_DIM].astype(jnp.float32)
    x1, x2 = xr[..., :half], xr[..., half:]
    c = cos[None, :, None, :]
    s_ = sin[None, :, None, :]
    rot = jnp.concatenate([x1 * c - x2 * s_, x2 * c + x1 * s_], axis=-1)
    return jnp.concatenate([rot.astype(x.dtype), x[..., ROT_DIM:]], axis=-1)


def pool_mixer(h, w_pool, pool_scale):
    b, s, d = h.shape
    hf = h.astype(jnp.float32).reshape(b, s, N_POOL_GROUPS, POOL_GROUP)
    cs = jnp.cumsum(hf, axis=1)
    pos = jnp.arange(s)
    means = []
    for g, w in enumerate(POOL_WINDOWS):
        csg = cs[:, :, g]
        lagged = jnp.pad(csg, ((0, 0), (w, 0), (0, 0)))[:, :s]
        cnt = jnp.minimum(pos + 1, w).astype(jnp.float32)[None, :, None]
        means.append((csg - lagged) / cnt)
    mixed = (jnp.stack(means, axis=2) - hf).astype(h.dtype)
    y = jnp.einsum('bsgc,gcf->bsgf', mixed, w_pool)
    return y.reshape(b, s, d) * pool_scale


def shared_kv(x, kv_norm, w_kv, cos, sin):
    b, s, _ = x.shape
    kv = rmsnorm(x, kv_norm) @ w_kv
    k = kv[..., :D_MODEL].reshape(b, s, 2 * N_DIFF_HEADS, DIFF_HEAD_DIM)
    v = kv[..., D_MODEL:].reshape(b, s, N_DIFF_HEADS, V_HEAD_DIM)
    k = apply_partial_rope(k, cos, sin)
    return k.transpose(0, 2, 1, 3), v.transpose(0, 2, 1, 3)


def diff_attention(h, k, v, w_q, lam_q1, lam_k1, lam_q2, lam_k2, subln_gain, w_o,
                   lambda_init, cos, sin):
    b, s, _ = h.shape
    q = (h @ w_q).reshape(b, s, 2 * N_DIFF_HEADS, DIFF_HEAD_DIM)
    q = apply_partial_rope(q, cos, sin)
    lam = (jnp.exp(jnp.sum(lam_q1.astype(jnp.float32) * lam_k1.astype(jnp.float32)))
           - jnp.exp(jnp.sum(lam_q2.astype(jnp.float32) * lam_k2.astype(jnp.float32)))
           + lambda_init)
    scale = DIFF_HEAD_DIM ** -0.5
    nblk = s // Q_BLOCK
    qb = q.reshape(b, nblk, Q_BLOCK, 2 * N_DIFF_HEADS, DIFF_HEAD_DIM).transpose(1, 0, 3, 2, 4)
    kpos = jnp.arange(s)

    def one_block(args):
        qblk, i = args
        sc = jnp.einsum('bhqd,bhkd->bhqk', qblk, k,
                        preferred_element_type=jnp.float32) * scale
        qpos = i * Q_BLOCK + jnp.arange(Q_BLOCK)
        sc = jnp.where(kpos[None, :] <= qpos[:, None], sc, -jnp.inf)
        p = jax.nn.softmax(sc, axis=-1).reshape(b, N_DIFF_HEADS, 2, Q_BLOCK, s)
        a = p[:, :, 0] - lam * p[:, :, 1]
        return jnp.einsum('bhqk,bhkd->bhqd', a.astype(v.dtype), v)

    o = lax.map(one_block, (qb, jnp.arange(nblk)))
    o = o.transpose(1, 0, 3, 2, 4).reshape(b, s, N_DIFF_HEADS, V_HEAD_DIM)
    o = rmsnorm(o, subln_gain) * (1.0 - lambda_init)
    return o.reshape(b, s, D_MODEL) @ w_o


def swiglu(h, w_gate, w_up, w_down):
    return (jax.nn.silu(h @ w_gate) * (h @ w_up)) @ w_down


def setup_inputs(seed: int = 0) -> dict:
    key = jax.random.key(seed)
    ks = jax.random.split(key, 20)
    f32 = jnp.float32
    D = D_MODEL

    def gain(k, shape):
        return 1.0 + 0.05 * jax.random.normal(k, shape, f32)

    return {
        "x": jax.random.normal(ks[0], (BATCH, SEQ, D), f32),
        "norm_mix_pre": gain(ks[1], (DEPTH, D)),
        "norm_mix_post": gain(ks[2], (DEPTH, D)),
        "norm_ffn_pre": gain(ks[3], (DEPTH, D)),
        "norm_ffn_post": gain(ks[4], (DEPTH, D)),
        "w_pool": jax.random.normal(ks[5], (N_A, N_POOL_GROUPS, POOL_GROUP, POOL_GROUP), f32) * POOL_GROUP ** -0.5,
        "pool_scale": 1.0 + 0.1 * jax.random.normal(ks[6], (N_A, D), f32),
        "kv_norm": gain(ks[7], (D,)),
        "w_kv": jax.random.normal(ks[8], (D, 2 * D), f32) * D ** -0.5,
        "w_q": jax.random.normal(ks[9], (N_B, D, D), f32) * D ** -0.5,
        "lambda_q1": 0.1 * jax.random.normal(ks[10], (N_B, DIFF_HEAD_DIM), f32),
        "lambda_k1": 0.1 * jax.random.normal(ks[11], (N_B, DIFF_HEAD_DIM), f32),
        "lambda_q2": 0.1 * jax.random.normal(ks[12], (N_B, DIFF_HEAD_DIM), f32),
        "lambda_k2": 0.1 * jax.random.normal(ks[13], (N_B, DIFF_HEAD_DIM), f32),
        "subln_gain": gain(ks[14], (N_B, V_HEAD_DIM)),
        "w_o": jax.random.normal(ks[15], (N_B, D, D), f32) * D ** -0.5,
        "w_ffn_gate": jax.random.normal(ks[16], (DEPTH, D, D_FF), f32) * D ** -0.5,
        "w_ffn_up": jax.random.normal(ks[17], (DEPTH, D, D_FF), f32) * D ** -0.5,
        "w_ffn_down": jax.random.normal(ks[18], (DEPTH, D_FF, D), f32) * D_FF ** -0.5,
    }


def reference(x, norm_mix_pre, norm_mix_post, norm_ffn_pre, norm_ffn_post, w_pool, pool_scale,
              kv_norm, w_kv, w_q, lambda_q1, lambda_k1, lambda_q2, lambda_k2, subln_gain, w_o,
              w_ffn_gate, w_ffn_up, w_ffn_down):
    cos, sin = rope_tables(x.shape[1])
    k_sh, v_sh = None, None
    for l in range(DEPTH):
        if l == N_A:
            k_sh, v_sh = shared_kv(x, kv_norm, w_kv, cos, sin)
        h = rmsnorm(x, norm_mix_pre[l])
        if l < N_A:
            m = pool_mixer(h, w_pool[l], pool_scale[l])
        else:
            j = l - N_A
            m = diff_attention(h, k_sh, v_sh, w_q[j], lambda_q1[j], lambda_k1[j], lambda_q2[j],
                               lambda_k2[j], subln_gain[j], w_o[j], lambda_init_for(l), cos, sin)
        x = x + rmsnorm(m, norm_mix_post[l])
        h = rmsnorm(x, norm_ffn_pre[l])
        x = x + rmsnorm(swiglu(h, w_ffn_gate[l], w_ffn_up[l], w_ffn_down[l]), norm_ffn_post[l])
    return x
```

```cpp
#include <hip/hip_runtime.h>
#include <hip/hip_bf16.h>
#include <hip/hip_cooperative_groups.h>
#include <cstdio>
#include <cstdint>
namespace pg8 {
#define PG8_LAS __attribute__((address_space(3)))
typedef unsigned short bf16_t;
typedef short bf16x8 __attribute__((ext_vector_type(8)));
typedef float f32x4 __attribute__((ext_vector_type(4)));
typedef unsigned u32x4 __attribute__((ext_vector_type(4)));
constexpr int BM = 256, BK = 64, HALF = 128, HTB = HALF * BK * 2  , STAGE_BYTES = 8 * HTB, NXCD = 8, WGM = 8;

__host__ __device__ __forceinline__ int lds_byte(int r, int c) { const int st = (r >> 4) * 2 + (c >> 5), rr = r & 15, cc = c & 31, ob = rr * 64 + cc * 2; return st * 1024 + (ob ^ (((ob >> 9) & 1) << 5)); }
__host__ __device__ __forceinline__ void stage_rc(int b, int& R, int& C) { const int st = b / 1024, sb = b % 1024, swz = sb ^ (((sb >> 9) & 1) << 5); R = (st >> 1) * 16 + swz / 64; C = (st & 1) * 32 + (swz % 64) / 2; }
__host__ __device__ __forceinline__ int perm32(int rho) { const int n = rho >> 4, i = rho & 15; return 8 * (i >> 2) + 4 * n + (i & 3); }

struct Unit { int pm, pn; };
struct Gemm { const bf16_t* A; const bf16_t* Bt; int M, N, K; };

struct StaticOrder {
    int nM, nN, nwg, G, c;
    __host__ __device__ void init(int M, int N, int G_, int c_) { nM = M / BM; nN = N / BM; nwg = nM * nN; G = G_; c = c_; }
    __host__ __device__ bool next(int i, Unit& u) const {
        const long L = (long)i * G + c; if (L >= nwg) return false;
        int wgid = (int)L; { const int q = nwg / NXCD, r = nwg % NXCD, xcd = wgid % NXCD, off = wgid / NXCD; wgid = (xcd < r ? xcd * (q + 1) : r * (q + 1) + (xcd - r) * q) + off; }
        const int nig = WGM * nN, gid = wgid / nig, fm = gid * WGM, gsz = (nM - fm) < WGM ? (nM - fm) : WGM;
        u.pm = fm + ((wgid % nig) % gsz); u.pn = (wgid % nig) / gsz; return true;
    }
    __device__ __forceinline__ void a_ready(const Unit&) const {}
    __device__ __forceinline__ void done(const Unit&) const {}
};
__device__ __forceinline__ unsigned cvt_pk_bf16(float lo, float hi) { unsigned r; asm volatile("v_cvt_pk_bf16_f32 %0, %1, %2" : "=v"(r) : "v"(lo), "v"(hi)); return r; }
template <class Epi, class Sched, bool STAMP = false>
__device__ __forceinline__ void gemm_phase(PG8_LAS unsigned char* lds, const Gemm g, const Sched& S, const Epi& E, unsigned long long* stamps) {
    const int tid = threadIdx.x, wid = __builtin_amdgcn_readfirstlane(tid >> 6), lane = tid & 63, wr = wid >> 2, wc = wid & 3, fr = lane & 15, fq = lane >> 4;
    const int K = g.K, nt = K / BK;
    int ts_lo = 0, ts_hi = 0, nts = 0; const unsigned long long rt_entry = STAMP ? (unsigned long long)wall_clock64() : 0ull;
#define PG8_STAMP() do { if (STAMP && wid == 0 && nts < 64) { const unsigned long long _c = (unsigned long long)clock64(); \
        ts_lo = (lane == nts) ? (int)(unsigned)_c : ts_lo; ts_hi = (lane == nts) ? (int)(unsigned)(_c >> 32) : ts_hi; ++nts; } } while (0)
    PG8_STAMP();
    unsigned voffA[2], voffB[2];
#pragma unroll
    for (int i = 0; i < 2; ++i) { int R, C; stage_rc(tid * 16 + i * 8192, R, C); const int Rb = Epi::PERM ? ((R & ~31) + perm32(R & 31)) : R;
        voffA[i] = (unsigned)(R * K + C) * 2u; voffB[i] = (unsigned)(Rb * K + C) * 2u; }
    const size_t kstep = (size_t)(BK * 2);
    const size_t hstep = (size_t)HALF * K * 2;
    const size_t tstep = 2 * hstep;
    const unsigned ldsw = (unsigned)wid * 1024u;
    const int aoff = lds_byte(wr * 64 + fr, fq * 8), boff = lds_byte(wc * 32 + fr, fq * 8);
#define PG8_SA(b, h) (((b) * 2 + (h)) * HTB)
#define PG8_SB(b, h) ((4 + (b) * 2 + (h)) * HTB)
#define PG8_STAGE(bufoff, gbase, voff) do { _Pragma("unroll") for (int _i = 0; _i < 2; ++_i) \
        __builtin_amdgcn_global_load_lds((const unsigned*)((const char*)(gbase) + (voff)[_i]), (PG8_LAS unsigned*)(lds + (bufoff) + ldsw + _i * 8192), 16, 0, 0); } while (0)
#define PG8_LDA(dst, b, h) do { _Pragma("unroll") for (int m = 0; m < 4; ++m) _Pragma("unroll") for (int k = 0; k < 2; ++k) dst[m][k] = *(const PG8_LAS bf16x8*)(lds + PG8_SA(b, h) + aoff + m * 2048 + k * 1024); } while (0)
#define PG8_LDB(dst, b, h) do { _Pragma("unroll") for (int n = 0; n < 2; ++n) _Pragma("unroll") for (int k = 0; k < 2; ++k) dst[n][k] = *(const PG8_LAS bf16x8*)(lds + PG8_SB(b, h) + boff + n * 2048 + k * 1024); } while (0)
#define PG8_MMA(ai, bj, At, Bt) do { __builtin_amdgcn_s_setprio(1); _Pragma("unroll") for (int m = 0; m < 4; ++m) _Pragma("unroll") for (int n = 0; n < 2; ++n) _Pragma("unroll") for (int k = 0; k < 2; ++k) \
        acc[ai][bj][m][n] = __builtin_amdgcn_mfma_f32_16x16x32_bf16(Bt[n][k], At[m][k], acc[ai][bj][m][n], 0, 0, 0); __builtin_amdgcn_s_setprio(0); } while (0)
#define PG8_WAIT_V(n) asm volatile("s_waitcnt vmcnt(" #n ")" ::: "memory")
#define PG8_WAIT_L(n) asm volatile("s_waitcnt lgkmcnt(" #n ")" ::: "memory")
#define PG8_BAR __builtin_amdgcn_s_barrier()
#define PG8_SCHED __builtin_amdgcn_sched_barrier(0)
    Unit cur, nxt; int ui = 0;
    if (!S.next(0, cur)) return;
    f32x4 acc[2][2][4][2];
#pragma unroll
    for (int a = 0; a < 2; ++a)
#pragma unroll
        for (int b = 0; b < 2; ++b)
#pragma unroll
            for (int m = 0; m < 4; ++m)
#pragma unroll
                for (int n = 0; n < 2; ++n) acc[a][b][m][n] = (f32x4){0.f, 0.f, 0.f, 0.f};
    bf16x8 At[4][2], B0[2][2], B1[2][2];
    const char* cA = (const char*)g.A + (size_t)cur.pm * tstep; const char* cB = (const char*)g.Bt + (size_t)cur.pn * tstep;
    S.a_ready(cur);
    PG8_STAGE(PG8_SB(0, 0), cB, voffB); PG8_STAGE(PG8_SA(0, 0), cA, voffA); PG8_STAGE(PG8_SB(0, 1), cB + hstep, voffB); PG8_STAGE(PG8_SA(0, 1), cA + hstep, voffA);
    if (wr == 1) PG8_BAR;
    PG8_WAIT_V(4); PG8_BAR;
    PG8_STAGE(PG8_SB(1, 0), cB + kstep, voffB); PG8_STAGE(PG8_SA(1, 0), cA + kstep, voffA); PG8_STAGE(PG8_SB(1, 1), cB + hstep + kstep, voffB);
    PG8_WAIT_V(6); PG8_BAR;
    PG8_STAMP();
    for (;;) {
        const bool has_next = S.next(ui + 1, nxt);
        const char* nA = has_next ? (const char*)g.A + (size_t)nxt.pm * tstep : cA; const char* nB = has_next ? (const char*)g.Bt + (size_t)nxt.pn * tstep : cB;
        for (int t = 0; t < nt; t += 2) {
            const bool last = (t == nt - 2);
            const char* a1 = cA + (size_t)(t + 1) * kstep;
            const char* a2 = last ? nA : cA + (size_t)(t + 2) * kstep; const char* b2 = last ? nB : cB + (size_t)(t + 2) * kstep;
            const char* a3 = a2 + kstep; const char* b3 = b2 + kstep;
            if (last && has_next) S.a_ready(nxt);
            PG8_LDB(B0, 0, 0); PG8_SCHED; PG8_LDA(At, 0, 0); PG8_STAGE(PG8_SA(1, 1), a1 + hstep, voffA);
            PG8_WAIT_L(8); PG8_BAR; PG8_WAIT_L(0); PG8_MMA(0, 0, At, B0); PG8_BAR; PG8_SCHED;
            PG8_LDB(B1, 0, 1); PG8_STAGE(PG8_SB(0, 0), b2, voffB);
            PG8_BAR; PG8_WAIT_L(0); PG8_MMA(0, 1, At, B1); PG8_BAR;
            PG8_LDA(At, 0, 1); PG8_STAGE(PG8_SA(0, 0), a2, voffA);
            PG8_BAR; PG8_WAIT_L(0); PG8_MMA(1, 0, At, B0); PG8_BAR; PG8_SCHED;
            PG8_STAGE(PG8_SB(0, 1), b2 + hstep, voffB);
            PG8_WAIT_V(6); PG8_BAR; PG8_MMA(1, 1, At, B1); PG8_BAR;
            PG8_LDB(B0, 1, 0); PG8_SCHED; PG8_LDA(At, 1, 0); PG8_STAGE(PG8_SA(0, 1), a2 + hstep, voffA);
            PG8_WAIT_L(8); PG8_BAR; PG8_WAIT_L(0); PG8_MMA(0, 0, At, B0); PG8_BAR; PG8_SCHED;
            PG8_LDB(B1, 1, 1); PG8_STAGE(PG8_SB(1, 0), b3, voffB);
            PG8_BAR; PG8_WAIT_L(0); PG8_MMA(0, 1, At, B1); PG8_BAR;
            PG8_LDA(At, 1, 1); PG8_STAGE(PG8_SA(1, 0), a3, voffA);
            PG8_BAR; PG8_WAIT_L(0); PG8_MMA(1, 0, At, B0); PG8_BAR; PG8_SCHED;
            PG8_STAGE(PG8_SB(1, 1), b3 + hstep, voffB);
            PG8_WAIT_V(6); PG8_BAR; PG8_MMA(1, 1, At, B1); PG8_BAR;
        }
        PG8_STAMP();
        if constexpr (!Epi::AFTER_DRAIN) { E(acc, cur, wr, wc, fr, fq); S.done(cur); }
        PG8_STAMP();
        if (!has_next) break;
#pragma unroll
        for (int a = 0; a < 2; ++a)
#pragma unroll
            for (int b = 0; b < 2; ++b)
#pragma unroll
                for (int m = 0; m < 4; ++m)
#pragma unroll
                    for (int n = 0; n < 2; ++n) acc[a][b][m][n] = (f32x4){0.f, 0.f, 0.f, 0.f};
        cur = nxt; cA = nA; cB = nB; ++ui;
    }
    PG8_WAIT_V(0);
    if (wr == 0) PG8_BAR;
    PG8_BAR;
    if constexpr (Epi::AFTER_DRAIN) { E.fused(acc, cur, wr, wc, fr, fq, lds, wid, lane); S.done(cur); }
    PG8_STAMP();
    if (STAMP && wid == 0) { stamps[lane] = lane < nts ? (((unsigned long long)(unsigned)ts_hi << 32) | (unsigned)ts_lo) : 0ull;
        if (lane == 62) stamps[62] = rt_entry; if (lane == 63) stamps[63] = (unsigned long long)wall_clock64(); }
#undef PG8_STAMP
#undef PG8_SA
#undef PG8_SB
#undef PG8_STAGE
#undef PG8_LDA
#undef PG8_LDB
#undef PG8_MMA
#undef PG8_WAIT_V
#undef PG8_WAIT_L
#undef PG8_BAR
#undef PG8_SCHED
}
}
namespace att {
constexpr int D = 128;
constexpr float THR = 8.f;
constexpr bool WSKIP = false;
constexpr float SCALE = 0.08838834764831845f;
constexpr int NW = 8, QBLK = 32, KVBLK = 64, QB = NW * QBLK;
constexpr int SHM_V = KVBLK * D * 2, SHM_K = KVBLK * D * 2;
using bf16 = __hip_bfloat16;
typedef short bf16x8 __attribute__((ext_vector_type(8)));
typedef short s16x4 __attribute__((ext_vector_type(4)));
typedef float f32x16 __attribute__((ext_vector_type(16)));
typedef float f32x4 __attribute__((ext_vector_type(4)));
typedef unsigned u32x4 __attribute__((ext_vector_type(4)));
template <class A, class Bt> struct same_t { static constexpr bool v = false; };
template <class A> struct same_t<A, A> { static constexpr bool v = true; };

#define KSWZ(row, colB) ((row) * 256 + ((colB) ^ (((row) & 7) << 4)))
#define SBAR() __builtin_amdgcn_sched_barrier(0)
__device__ __forceinline__ int v_st(int k, int c) { const int kk = (k & ~0xC) | ((k & 4) << 1) | ((k & 8) >> 1); return ((kk >> 3) * 4 + (c >> 5)) * 512 + ((kk & 7) * 32 + (c & 31)) * 2; }
__device__ __forceinline__ int v_rd_base(int lane) { return ((lane & 3) << 3) | (((lane >> 2) & 3) << 6) | (((lane >> 4) & 1) << 5) | (((lane >> 5) & 1) << 8); }
constexpr int v_rd_off(int d0, int ks, int half) { return d0 * 512 + ks * 4096 + half * 2048; }
__device__ __forceinline__ int crow(int r, int hi) { return (r & 3) + 8 * (r >> 2) + 4 * hi; }
__device__ __forceinline__ unsigned cvtpk(float lo, float hi) {
    unsigned r; asm volatile("v_cvt_pk_bf16_f32 %0, %1, %2" : "=v"(r) : "v"(lo), "v"(hi)); return r;
}
__device__ __forceinline__ bf16x8 pack8(f32x4 a, f32x4 b) {
    u32x4 w = {cvtpk(a[0], a[1]), cvtpk(a[2], a[3]), cvtpk(b[0], b[1]), cvtpk(b[2], b[3])};
    return *reinterpret_cast<bf16x8*>(&w);
}
template <class T> __device__ __forceinline__ bf16x8 load8(const T* p) {
    if constexpr (same_t<T, float>::v) { return pack8(*(const f32x4*)p, *(const f32x4*)(p + 4)); }
    else { return *reinterpret_cast<const bf16x8*>(p); }
}
__device__ __forceinline__ void mask_tile(f32x16& p0, f32x16& p1, int dq, unsigned W) {
    const float NEG = -__builtin_inff();
#pragma unroll
    for (int r = 0; r < 16; ++r) {
        const int c = (r & 3) + 8 * (r >> 2);
        if ((unsigned)(dq - c) >= W) p0[r] = NEG;
        if ((unsigned)(dq - c - 32) >= W) p1[r] = NEG;
    }
}
__device__ __forceinline__ void partialSM(f32x16& p0, f32x16& p1, float& m_reg, float& mn, float& alpha) {
    float pmax = p0[0]; for (int r = 1; r < 16; ++r) pmax = fmaxf(pmax, p0[r]); for (int r = 0; r < 16; ++r) pmax = fmaxf(pmax, p1[r]);
    { auto rr = __builtin_amdgcn_permlane32_swap(__float_as_uint(pmax), __float_as_uint(pmax), false, false);
      pmax = fmaxf(__uint_as_float(rr[0]), __uint_as_float(rr[1])); }
    constexpr float C2 = 1.4426950408889634f * SCALE;
    if (__builtin_expect(__all((pmax - m_reg) * SCALE <= THR), 1)) { mn = m_reg; alpha = 1.f; }
    else { mn = fmaxf(m_reg, pmax); alpha = __builtin_amdgcn_exp2f((m_reg - mn) * C2); m_reg = mn; }
    const float mnL = -mn * C2;
    for (int r = 0; r < 16; ++r) p0[r] = fmaf(p0[r], C2, mnL); for (int r = 0; r < 16; ++r) p1[r] = fmaf(p1[r], C2, mnL);
    for (int r = 0; r < 16; ++r) p0[r] = __builtin_amdgcn_exp2f(p0[r]);
}
__device__ __forceinline__ void finishSM(f32x16& p0, f32x16& p1, float alpha, float& l_reg, bf16x8& pa0, bf16x8& pa1, bf16x8& pa2, bf16x8& pa3) {
    for (int r = 0; r < 16; ++r) p1[r] = __builtin_amdgcn_exp2f(p1[r]);
    float ps = 0; for (int r = 0; r < 16; ++r) ps += p0[r]; for (int r = 0; r < 16; ++r) ps += p1[r];
    { auto rr = __builtin_amdgcn_permlane32_swap(__float_as_uint(ps), __float_as_uint(ps), false, false);
      ps = __uint_as_float(rr[0]) + __uint_as_float(rr[1]); }
    l_reg = l_reg * alpha + ps;
#define PK4(P, B_, OUT) do { unsigned a0 = cvtpk(P[B_+0], P[B_+1]), a1 = cvtpk(P[B_+2], P[B_+3]);                          \
        unsigned b0 = cvtpk(P[B_+4], P[B_+5]), b1 = cvtpk(P[B_+6], P[B_+7]);                                             \
        auto r0 = __builtin_amdgcn_permlane32_swap(a0, b0, false, false); auto r1 = __builtin_amdgcn_permlane32_swap(a1, b1, false, false); \
        u32x4 w = {r0[0], r1[0], r0[1], r1[1]}; OUT = *reinterpret_cast<bf16x8*>(&w); } while (0)
    PK4(p0, 0, pa0); PK4(p0, 8, pa1); PK4(p1, 0, pa2); PK4(p1, 8, pa3);
#undef PK4
}
template <int KB, bool SK>
__device__ __forceinline__ void qkt(f32x16& p0, f32x16& p1, const char* K_lds, int r32, int hi, const bf16x8* qr, bool act) {
    if (SK && !act) { const float NEG = -__builtin_inff();
#pragma unroll
        for (int r = 0; r < 16; ++r) { p0[r] = NEG; p1[r] = NEG; } return; }
    p0 = f32x16{}; p1 = f32x16{};
    const char* kb[4];
#pragma unroll
    for (int dd = 0; dd < 4; ++dd) kb[dd] = K_lds + KB * SHM_K + KSWZ(r32, (dd * 16 + hi * 8) * 2);
#pragma unroll
    for (int d0 = 0; d0 < 8; ++d0) { const char* a = kb[d0 & 3] + (d0 >> 2) * 128;
        bf16x8 b0 = *reinterpret_cast<const bf16x8*>(a);
        bf16x8 b1 = *reinterpret_cast<const bf16x8*>(a + 32 * 256);
        p0 = __builtin_amdgcn_mfma_f32_32x32x16_bf16(b0, qr[d0], p0, 0, 0, 0);
        p1 = __builtin_amdgcn_mfma_f32_32x32x16_bf16(b1, qr[d0], p1, 0, 0, 0); }
}
template <int VB, bool SK>
__device__ __forceinline__ void pv_tile(f32x16* o, int vb0, bf16x8 pa0, bf16x8 pa1, bf16x8 pa2, bf16x8 pa3, bool act) {
    if (SK && !act) return;
#define TRRD(dst, off) asm volatile("ds_read_b64_tr_b16 %0, %1 offset:%2" : "=&v"(dst) : "v"(vb0), "i"(off) : "memory")
#define PV_D0(d0) do { s16x4 l0, l1, l2, l3, h0, h1, h2, h3; constexpr int b_ = VB * SHM_V + v_rd_off(d0, 0, 0);     \
        TRRD(l0, b_); TRRD(h0, b_ + 2048); TRRD(l1, b_ + 4096); TRRD(h1, b_ + 6144); TRRD(l2, b_ + 8192); TRRD(h2, b_ + 10240); TRRD(l3, b_ + 12288); TRRD(h3, b_ + 14336); \
        asm volatile("s_waitcnt lgkmcnt(0)" ::: "memory"); SBAR();                 \
        o[d0] = __builtin_amdgcn_mfma_f32_32x32x16_bf16(pa0, (bf16x8){l0[0], l0[1], l0[2], l0[3], h0[0], h0[1], h0[2], h0[3]}, o[d0], 0, 0, 0);   \
        o[d0] = __builtin_amdgcn_mfma_f32_32x32x16_bf16(pa1, (bf16x8){l1[0], l1[1], l1[2], l1[3], h1[0], h1[1], h1[2], h1[3]}, o[d0], 0, 0, 0);   \
        o[d0] = __builtin_amdgcn_mfma_f32_32x32x16_bf16(pa2, (bf16x8){l2[0], l2[1], l2[2], l2[3], h2[0], h2[1], h2[2], h2[3]}, o[d0], 0, 0, 0);   \
        o[d0] = __builtin_amdgcn_mfma_f32_32x32x16_bf16(pa3, (bf16x8){l3[0], l3[1], l3[2], l3[3], h3[0], h3[1], h3[2], h3[3]}, o[d0], 0, 0, 0); } while (0)
    PV_D0(0); PV_D0(1); PV_D0(2); PV_D0(3);
#undef PV_D0
#undef TRRD
}

template <class TIn, class TOut> struct BlockRef { const TIn* Q; const TIn* K; const TIn* V; TOut* O; int P0; };
template <class TIn> struct Seam {
    bf16x8 qr[8];
    bf16x8 st_v0, st_v1, st_k0, st_k1; f32x4 sf0, sf1, sf2, sf3;
    f32x4 tq[16];
};
__device__ __forceinline__ int swa_jlo(int P0, int W) { const int lowk = P0 - W + 1; return lowk > 0 ? lowk / KVBLK : 0; }
#define ROW(p, k0, rr) ((p) + (size_t)((k0) + (rr)) * D + sc)
#define VMW() asm volatile("s_waitcnt vmcnt(0)" ::: "memory")
#define VMWN(n) asm volatile("s_waitcnt vmcnt(%0)" :: "i"(n) : "memory")
#define SLOAD_H(Kp, Vp, k0) do { S.st_v0 = load8<TIn>(ROW(Vp, k0, sr)); S.st_v1 = load8<TIn>(ROW(Vp, k0, 32 + sr));              \
                         S.st_k0 = load8<TIn>(ROW(Kp, k0, sr)); S.st_k1 = load8<TIn>(ROW(Kp, k0, 32 + sr)); } while (0)
#define SWRITE_HK(bf) do { *(bf16x8*)(K_lds + (bf) * SHM_K + kws) = S.st_k0; *(bf16x8*)(K_lds + (bf) * SHM_K + kws + 32 * 256) = S.st_k1; } while (0)
#define SWRITE_HV(bf) do { *(bf16x8*)(V_lds + (bf) * SHM_V + vst0) = S.st_v0; *(bf16x8*)(V_lds + (bf) * SHM_V + vst1) = S.st_v1; } while (0)
#define SWRITE_H(bf) do { SWRITE_HV(bf); SWRITE_HK(bf); } while (0)
#define SLOAD_F(p, k0) do { S.sf0 = *(const f32x4*)ROW(p, k0, sr); S.sf1 = *(const f32x4*)(ROW(p, k0, sr) + 4);                \
                            S.sf2 = *(const f32x4*)ROW(p, k0, 32 + sr); S.sf3 = *(const f32x4*)(ROW(p, k0, 32 + sr) + 4); } while (0)
#define SWRITE_KF(bf) do { *(bf16x8*)(K_lds + (bf) * SHM_K + kws) = pack8(S.sf0, S.sf1); *(bf16x8*)(K_lds + (bf) * SHM_K + kws + 32 * 256) = pack8(S.sf2, S.sf3); } while (0)
#define SWRITE_VF(bf) do { *(bf16x8*)(V_lds + (bf) * SHM_V + vst0) = pack8(S.sf0, S.sf1); *(bf16x8*)(V_lds + (bf) * SHM_V + vst1) = pack8(S.sf2, S.sf3); } while (0)
template <class TIn, class TOut>
__device__ __forceinline__ void causal_swa_prime(const BlockRef<TIn, TOut>& cur, int W, char* lds, Seam<TIn>& S) {
    constexpr bool F32 = same_t<TIn, float>::v;
    const int tid = threadIdx.x, wid = __builtin_amdgcn_readfirstlane(tid >> 6), lane = tid & 63, r32 = lane & 31, hi = lane >> 5;
    const int sr = tid >> 4, sc = (tid & 15) * 8, kws = KSWZ(sr, sc * 2); char* K_lds = lds + 2 * SHM_V;
    const int kb0 = swa_jlo(cur.P0, W) * KVBLK;
    for (int d0 = 0; d0 < 8; ++d0) S.qr[d0] = load8<TIn>(cur.Q + (size_t)(wid * QBLK + r32) * D + d0 * 16 + hi * 8);
    if constexpr (F32) { SLOAD_F((const float*)cur.K, kb0); VMW(); SWRITE_KF(0); SBAR(); SLOAD_F((const float*)cur.V, kb0); }
    else { SLOAD_H(cur.K, cur.V, kb0); VMW(); SWRITE_HK(0); }
    __syncthreads();
}
template <class TIn, class TOut>
__device__ __forceinline__ void causal_swa_block(const BlockRef<TIn, TOut>& cur, const BlockRef<TIn, TOut>& nxt, int skv, int W, char* lds, Seam<TIn>& S) {
    constexpr bool F32 = same_t<TIn, float>::v;
    const int tid = threadIdx.x, wid = __builtin_amdgcn_readfirstlane(tid >> 6), lane = tid & 63, r32 = lane & 31, hi = lane >> 5;
    const int j_lo = swa_jlo(cur.P0, W);
    int j_hi = (cur.P0 + QB - 1) / KVBLK + 1; if (j_hi > skv / KVBLK) j_hi = skv / KVBLK;
    const int NT = j_hi - j_lo;
    const int kbn = swa_jlo(nxt.P0, W) * KVBLK;
    const int qlo = cur.P0 + wid * QBLK, qm = qlo + r32 - 4 * hi;
    char* V_lds = lds; char* K_lds = lds + 2 * SHM_V;
    float* ws = (float*)(lds + 2 * SHM_V + 2 * SHM_K) + wid * 64; float* li_l = ws, * al_l = ws + 32;
    float m_reg = -1e30f, l_reg = 0; f32x16 o[4] = {};
    const int sr = tid >> 4, sc = (tid & 15) * 8, vst0 = v_st(sr, sc), vst1 = v_st(32 + sr, sc), kws = KSWZ(sr, sc * 2);
    const int vb0 = (int)(uintptr_t)V_lds + v_rd_base(lane);
    const TIn* Kh = cur.K; const TIn* Vh = cur.V;
#define RESC(a) do { if (__any((a) < 1.f)) { if (hi == 0) al_l[r32] = (a); asm volatile("s_waitcnt lgkmcnt(0)" ::: "memory");              \
                     for (int d_ = 0; d_ < 4; ++d_) for (int r = 0; r < 16; ++r) o[d_][r] *= al_l[crow(r, hi)]; } } while (0)
#define KBASE(t) ((j_lo + (t)) * KVBLK)
#define ACT(t) (KBASE(t) <= qlo + QBLK - 1 && KBASE(t) + KVBLK - 1 >= qlo - W + 1)
#define MASKT(P0_, P1_, t) do { const int kb_ = KBASE(t); if ((!SK || ACT(t)) && (kb_ + KVBLK - 1 > qlo || kb_ <= qlo + QBLK - 1 - W)) mask_tile(P0_, P1_, qm - kb_, (unsigned)W); } while (0)
    constexpr int NQL = F32 ? 16 : 8;
    constexpr bool SK = WSKIP && !F32;
#define SEAM_K0() do { VMWN(NQL); if constexpr (F32) { SWRITE_KF(0); SBAR(); SLOAD_F((const float*)nxt.V, kbn); } else { SWRITE_HK(0); } SBAR(); } while (0)
    f32x16 pA0, pA1, pB0, pB1; float mnA, mnB, alA, alB; bf16x8 pa0, pa1, pa2, pa3;
    if constexpr (F32) { VMW(); SWRITE_VF(0); SBAR(); } else { SWRITE_HV(0); SBAR(); }
    if (NT > 1) { if constexpr (F32) SLOAD_F((const float*)Kh, KBASE(1)); else SLOAD_H(Kh, Vh, KBASE(1)); }
    SBAR(); qkt<0, SK>(pA0, pA1, K_lds, r32, hi, S.qr, ACT(0));
    if constexpr (F32) { if (NT > 1) { VMW(); SWRITE_KF(1); SBAR(); SLOAD_F((const float*)Vh, KBASE(1)); } }
    MASKT(pA0, pA1, 0); partialSM(pA0, pA1, m_reg, mnA, alA);
    if (NT > 1) { VMW(); if constexpr (F32) { SWRITE_VF(1); SBAR(); if (NT > 2) SLOAD_F((const float*)Kh, KBASE(2)); } else SWRITE_H(1); }
    __syncthreads();
#define HALF_STEP(PX0, PX1, mnX, alX, PY0, PY1, alY, t, KB, VB, SB) do {                                                      \
        SBAR(); qkt<KB, SK>(PX0, PX1, K_lds, r32, hi, S.qr, ACT(t));                                             \
        finishSM(PY0, PY1, alY, l_reg, pa0, pa1, pa2, pa3); SBAR();                                                           \
        if ((t) + 1 < NT) { if constexpr (F32) { VMW(); SWRITE_KF(SB); SBAR(); SLOAD_F((const float*)Vh, KBASE((t) + 1)); }  \
                            else { SLOAD_H(Kh, Vh, KBASE((t) + 1)); } SBAR(); }                                               \
        pv_tile<VB, SK>(o, vb0, pa0, pa1, pa2, pa3, ACT((t) - 1)); MASKT(PX0, PX1, (t)); partialSM(PX0, PX1, m_reg, mnX, alX);                                        \
        __syncthreads();                                                                                                      \
        if ((t) + 1 < NT) { VMW(); if constexpr (F32) { SWRITE_VF(SB); SBAR(); if ((t) + 2 < NT) SLOAD_F((const float*)Kh, KBASE((t) + 2)); } \
                            else { SWRITE_H(SB); } }                                                                          \
        RESC(alX); __syncthreads(); } while (0)
    for (int t = 1; t + 1 < NT; t += 2) {
        HALF_STEP(pB0, pB1, mnB, alB, pA0, pA1, alA, t, 1, 0, 0);
        HALF_STEP(pA0, pA1, mnA, alA, pB0, pB1, alB, t + 1, 0, 1, 1);
    }
    const bool even = (NT & 1) == 0;
    if (even) { SBAR(); qkt<1, SK>(pB0, pB1, K_lds, r32, hi, S.qr, ACT(NT - 1)); SBAR(); }
#define QROW(e) (nxt.Q + (size_t)(wid * QBLK + r32) * D + ((e) >> 1) * 16 + hi * 8 + ((e) & 1) * 4)
    if constexpr (F32) { SLOAD_F((const float*)nxt.K, kbn); SBAR();
#pragma unroll
        for (int e = 0; e < 8; ++e) S.tq[e] = *(const f32x4*)QROW(e); }
    else { SLOAD_H(nxt.K, nxt.V, kbn); SBAR();
#pragma unroll
        for (int d0 = 0; d0 < 8; ++d0) S.qr[d0] = load8<TIn>(nxt.Q + (size_t)(wid * QBLK + r32) * D + d0 * 16 + hi * 8); }
    SBAR();
    finishSM(pA0, pA1, alA, l_reg, pa0, pa1, pa2, pa3); SBAR();
    if constexpr (F32) {
#pragma unroll
        for (int e = 8; e < 16; ++e) S.tq[e] = *(const f32x4*)QROW(e); SBAR(); }
#undef QROW
    pv_tile<0, SK>(o, vb0, pa0, pa1, pa2, pa3, ACT(even ? NT - 2 : NT - 1));
    if (even) { MASKT(pB0, pB1, NT - 1); partialSM(pB0, pB1, m_reg, mnB, alB); __syncthreads(); RESC(alB);
        finishSM(pB0, pB1, alB, l_reg, pa0, pa1, pa2, pa3); SBAR(); pv_tile<1, SK>(o, vb0, pa0, pa1, pa2, pa3, ACT(NT - 1)); }
    SBAR(); SEAM_K0();
    if (hi == 0) li_l[r32] = l_reg; asm volatile("s_waitcnt lgkmcnt(0)" ::: "memory");
    float rli[16];
#pragma unroll
    for (int r = 0; r < 16; ++r) rli[r] = __builtin_amdgcn_rcpf(li_l[crow(r, hi)]);
    TOut* Ow = cur.O + (size_t)(wid * QBLK) * D;
#pragma unroll
    for (int r = 0; r < 16; ++r) { const int orow = crow(r, hi);
#pragma unroll
        for (int d0 = 0; d0 < 4; ++d0) { const float v = o[d0][r] * rli[r];
            if constexpr (same_t<TOut, float>::v) { Ow[(size_t)orow * D + d0 * 32 + r32] = v; }
            else { const float vn = __shfl_xor(v, 1);
                   if ((r32 & 1) == 0) *(unsigned*)(Ow + (size_t)orow * D + d0 * 32 + r32) = cvtpk(v, vn); } } }
    if constexpr (F32) {
#pragma unroll
        for (int d0 = 0; d0 < 8; ++d0) S.qr[d0] = pack8(S.tq[2 * d0], S.tq[2 * d0 + 1]); }
    __syncthreads();
#undef RESC
#undef KBASE
#undef ACT
#undef MASKT
#undef SEAM_K0
#undef HALF_STEP
}
#undef ROW
#undef VMW
#undef VMWN
#undef SLOAD_H
#undef SWRITE_HK
#undef SWRITE_HV
#undef SWRITE_H
#undef SLOAD_F
#undef SWRITE_KF
#undef SWRITE_VF
}
namespace cg = cooperative_groups;
typedef unsigned short u16;
typedef float f32x4v __attribute__((ext_vector_type(4)));
typedef unsigned u32x4v __attribute__((ext_vector_type(4)));
typedef unsigned u32x2v __attribute__((ext_vector_type(2)));

constexpr int T_TOK = 16384, DM = 2048, DFF = 5632, SEQ = 4096, NBATCH = 4;
constexpr float EPS = 1e-6f;
constexpr float LAMBDA_INIT = 0.35550906759096934f;
constexpr size_t MiB = (size_t)1 << 20;
constexpr size_t WS_WPOOL = 0, WS_WGU = 2 * MiB, WS_WDN = 46 * MiB, WS_WQKV = 68 * MiB, WS_WO = 92 * MiB, WS_MISC = 100 * MiB,
                 WS_A = 101 * MiB, WS_B = 293 * MiB, WS_C = 357 * MiB, WS_END = 485 * MiB;
constexpr size_t MISC_RSTD = 0, MISC_COS = 64 * 1024, MISC_SIN = 320 * 1024;
constexpr int LDS_TOTAL = 131072;
constexpr int NPHASE = 14;

struct Params {
    const float* x; const float* norm_mix_pre; const float* norm_mix_post; const float* norm_ffn_pre; const float* norm_ffn_post;
    const float* w_pool; const float* pool_scale; const float* kv_norm; const float* w_kv; const float* w_q;
    const float* lq1; const float* lk1; const float* lq2; const float* lk2; const float* subln; const float* w_o;
    const float* w_gate; const float* w_up; const float* w_down;
    float* out; unsigned char* ws;
    int ph_lo, ph_hi;
};

__device__ __forceinline__ unsigned pk_bf16(float lo, float hi) { unsigned r; asm volatile("v_cvt_pk_bf16_f32 %0, %1, %2" : "=v"(r) : "v"(lo), "v"(hi)); return r; }
__device__ __forceinline__ float bf_lo(unsigned w) { return __uint_as_float(w << 16); }
__device__ __forceinline__ float bf_hi(unsigned w) { return __uint_as_float(w & 0xffff0000u); }
__device__ __forceinline__ float wave_sum(float v) {
#pragma unroll
    for (int o = 32; o >= 1; o >>= 1) v += __shfl_xor(v, o);
    return v;
}

struct ConvJob { const float* src; int ld; int c0; int k0; const float* rgain; int rmask; const float* cgain; float scal; u16* dst; int Kdst; };

__device__ __forceinline__ void conv_tile(const ConvJob& j, unsigned char* lds) {
    const int tid = threadIdx.x, w = tid >> 6, lane = tid & 63;
    float v[32];
    const float* sp = j.src + (size_t)(j.k0 + w * 16) * j.ld + j.c0 + lane;
#pragma unroll
    for (int q = 0; q < 32; ++q) v[q] = sp[(size_t)(q >> 1) * j.ld + (q & 1) * 64];
    float cg0 = j.scal, cg1 = j.scal;
    if (j.cgain) { cg0 *= j.cgain[j.c0 + lane]; cg1 *= j.cgain[j.c0 + 64 + lane]; }
#pragma unroll
    for (int q = 0; q < 32; ++q) {
        const int kl = w * 16 + (q >> 1), n = (q & 1) * 64 + lane;
        float s = (q & 1) ? cg1 : cg0;
        if (j.rgain) s *= j.rgain[(j.k0 + kl) & j.rmask];
        const unsigned b = pk_bf16(v[q] * s, 0.f);
        *(u16*)(lds + n * 260 + kl * 2) = (u16)b;
    }
    __syncthreads();
#pragma unroll
    for (int i = 0; i < 4; ++i) {
        const int id = tid + 512 * i, n = id >> 4, c = id & 15;
        const unsigned* lp = (const unsigned*)(lds + n * 260 + c * 16);
        u32x4v o; o.x = lp[0]; o.y = lp[1]; o.z = lp[2]; o.w = lp[3];
        *(u32x4v*)(j.dst + (size_t)n * j.Kdst + j.k0 + c * 8) = o;
    }
    __syncthreads();
}

__device__ __forceinline__ void conv_ffn_tile(const Params& p, int l, int t, unsigned char* lds) {
    ConvJob j; j.rmask = -1; j.cgain = nullptr; j.scal = 1.f;
    if (t < 1408) { const int nb = t % 88, kt = t / 88, pn = nb >> 1, which = nb & 1;
        j.src = (which ? p.w_up : p.w_gate) + (size_t)l * DM * DFF; j.ld = DFF; j.c0 = pn * 128; j.k0 = kt * 128; j.rgain = p.norm_ffn_pre + l * DM;
        j.dst = (u16*)(p.ws + WS_WGU) + (size_t)nb * 128 * DM; j.Kdst = DM; }
    else { t -= 1408; const int nb = t % 16, kt = t / 16;
        j.src = p.w_down + (size_t)l * DFF * DM; j.ld = DM; j.c0 = nb * 128; j.k0 = kt * 128; j.rgain = nullptr;
        j.dst = (u16*)(p.ws + WS_WDN) + (size_t)nb * 128 * DFF; j.Kdst = DFF; }
    conv_tile(j, lds);
}
__device__ __forceinline__ void conv_misc_tile(const Params& p, int t, unsigned char* lds) {
    ConvJob j; j.rmask = -1; j.cgain = nullptr; j.scal = 1.f;
    if (t < 64) { const int g = t >> 4, r = t & 15, nt = r & 3, kt = r >> 2;
        j.src = p.w_pool + (size_t)g * 512 * 512; j.ld = 512; j.c0 = nt * 128; j.k0 = kt * 128; j.rgain = p.norm_mix_pre + g * 512; j.cgain = p.pool_scale + g * 512;
        j.dst = (u16*)(p.ws + WS_WPOOL) + (size_t)(g * 512 + nt * 128) * 512; j.Kdst = 512; }
    else if (t < 64 + 768) { t -= 64; const int nb = t % 48, kt = t / 48;
        if (nb < 32) { j.src = p.w_kv; j.ld = 2 * DM; j.c0 = nb * 128; j.rgain = p.kv_norm; }
        else { j.src = p.w_q; j.ld = DM; j.c0 = (nb - 32) * 128; j.rgain = p.norm_mix_pre + DM; }
        j.k0 = kt * 128; j.dst = (u16*)(p.ws + WS_WQKV) + (size_t)nb * 128 * DM; j.Kdst = DM; }
    else { t -= 64 + 768; const int nb = t % 16, kt = t / 16;
        j.src = p.w_o; j.ld = DM; j.c0 = nb * 128; j.k0 = kt * 128; j.rgain = p.subln; j.rmask = 255; j.scal = 1.f - LAMBDA_INIT;
        j.dst = (u16*)(p.ws + WS_WO) + (size_t)nb * 128 * DM; j.Kdst = DM; }
    conv_tile(j, lds);
}

__device__ const float ROPE_INV[16] = {1.000000000e+00f, 4.403665960e-01f, 1.939227432e-01f, 8.539710194e-02f, 3.760603070e-02f, 1.656044088e-02f, 7.292664610e-03f, 3.211446106e-03f,
                                        1.414213562e-03f, 6.227724371e-04f, 2.742481884e-04f, 1.207697351e-04f, 5.318295734e-05f, 2.341999971e-05f, 1.031338525e-05f, 4.541670478e-06f};
__device__ __forceinline__ void rope_entry(int e, float* cosT, float* sinT) {
    constexpr double I2PI = 0.15915494309189535;
    constexpr float HI = (float)I2PI, LO = (float)(I2PI - (double)HI);
    const int s = e >> 4, i = e & 15;
    const float ang = (float)s * ROPE_INV[i];
    const float pr = ang * HI;
    float er = fmaf(ang, HI, -pr); er = fmaf(ang, LO, er);
    const float fr = (pr - rintf(pr)) + er;
    cosT[e] = __builtin_amdgcn_cosf(fr); sinT[e] = __builtin_amdgcn_sinf(fr);
}

__device__ __forceinline__ void rstd_rows(const float* x, float* rstd) {
    const int lane = threadIdx.x & 63, gw = blockIdx.x * 8 + (threadIdx.x >> 6), nw = gridDim.x * 8;
    for (int row = gw; row < T_TOK; row += nw) {
        const f32x4v* rp = (const f32x4v*)(x + (size_t)row * DM);
        float ss = 0.f;
#pragma unroll
        for (int i = 0; i < 8; ++i) { const f32x4v v = rp[lane + 64 * i]; ss += v.x * v.x + v.y * v.y + v.z * v.z + v.w * v.w; }
        ss = wave_sum(ss);
        if (lane == 0) rstd[row] = rsqrtf(ss * (1.f / DM) + EPS);
    }
}

__device__ __forceinline__ void mixed_phase(const float* __restrict__ x, const float* __restrict__ rstd, u16* __restrict__ mixed) {
    const int tid = threadIdx.x, g = tid >> 7, w = 2 << g, col = tid * 4;
    for (int ch = blockIdx.x; ch < T_TOK / 64; ch += gridDim.x) {
        const int t0 = ch * 64, pos0 = t0 & (SEQ - 1);
        f32x4v S = {0.f, 0.f, 0.f, 0.f};
        for (int jj = 1; jj <= w; ++jj) if (pos0 - jj >= 0) { const f32x4v v = *(const f32x4v*)(x + (size_t)(t0 - jj) * DM + col); S += v * rstd[t0 - jj]; }
        u16* op = mixed + ((size_t)g * T_TOK + t0) * 512 + (col & 511);
#pragma unroll 8
        for (int i = 0; i < 64; ++i) {
            const int t = t0 + i, pos = pos0 + i;
            const f32x4v vt = *(const f32x4v*)(x + (size_t)t * DM + col) * rstd[t];
            S += vt;
            if (pos - w >= 0) { const f32x4v vo = *(const f32x4v*)(x + (size_t)(t - w) * DM + col) * rstd[t - w]; S -= vo; }
            const float ic = 1.f / (float)min(pos + 1, w);
            const f32x4v o = S * ic - vt;
            u32x2v pk; pk.x = pk_bf16(o.x, o.y); pk.y = pk_bf16(o.z, o.w);
            *(u32x2v*)(op + (size_t)i * 512) = pk;
        }
    }
}

template <bool LAST>
__device__ __forceinline__ void norm_phase(const float* xin, const u16* m, const float* gpost, float* xout, u16* xn) {
    const int lane = threadIdx.x & 63, gw = blockIdx.x * 8 + (threadIdx.x >> 6), nw = gridDim.x * 8;
    for (int row = gw; row < T_TOK; row += nw) {
        const u32x4v* mp = (const u32x4v*)(m + (size_t)row * DM);
        const f32x4v* xp = (const f32x4v*)(xin + (size_t)row * DM);
        u32x4v mv[4]; f32x4v xv[8];
#pragma unroll
        for (int i = 0; i < 4; ++i) mv[i] = mp[lane + 64 * i];
#pragma unroll
        for (int i = 0; i < 4; ++i) { xv[2 * i] = xp[2 * (lane + 64 * i)]; xv[2 * i + 1] = xp[2 * (lane + 64 * i) + 1]; }
        float mf[32];
#pragma unroll
        for (int i = 0; i < 4; ++i) { mf[8 * i + 0] = bf_lo(mv[i].x); mf[8 * i + 1] = bf_hi(mv[i].x); mf[8 * i + 2] = bf_lo(mv[i].y); mf[8 * i + 3] = bf_hi(mv[i].y);
                                      mf[8 * i + 4] = bf_lo(mv[i].z); mf[8 * i + 5] = bf_hi(mv[i].z); mf[8 * i + 6] = bf_lo(mv[i].w); mf[8 * i + 7] = bf_hi(mv[i].w); }
        float ss = 0.f;
#pragma unroll
        for (int i = 0; i < 32; ++i) ss += mf[i] * mf[i];
        ss = wave_sum(ss);
        const float rs = rsqrtf(ss * (1.f / DM) + EPS);
        const f32x4v* gp = (const f32x4v*)gpost;
        float sx = 0.f;
#pragma unroll
        for (int i = 0; i < 4; ++i) {
#pragma unroll
            for (int h = 0; h < 2; ++h) {
                const f32x4v gv = gp[2 * (lane + 64 * i) + h]; f32x4v& xr = xv[2 * i + h];
                xr.x += mf[8 * i + 4 * h + 0] * rs * gv.x; xr.y += mf[8 * i + 4 * h + 1] * rs * gv.y; xr.z += mf[8 * i + 4 * h + 2] * rs * gv.z; xr.w += mf[8 * i + 4 * h + 3] * rs * gv.w;
                sx += xr.x * xr.x + xr.y * xr.y + xr.z * xr.z + xr.w * xr.w;
            }
        }
        f32x4v* op = (f32x4v*)(xout + (size_t)row * DM);
#pragma unroll
        for (int i = 0; i < 4; ++i) { op[2 * (lane + 64 * i)] = xv[2 * i]; op[2 * (lane + 64 * i) + 1] = xv[2 * i + 1]; }
        if (!LAST) {
            sx = wave_sum(sx);
            const float rx = rsqrtf(sx * (1.f / DM) + EPS);
            u32x4v* np = (u32x4v*)(xn + (size_t)row * DM);
#pragma unroll
            for (int i = 0; i < 4; ++i) { const f32x4v a = xv[2 * i] * rx, b = xv[2 * i + 1] * rx; u32x4v o;
                o.x = pk_bf16(a.x, a.y); o.y = pk_bf16(a.z, a.w); o.z = pk_bf16(b.x, b.y); o.w = pk_bf16(b.z, b.w); np[lane + 64 * i] = o; }
        }
    }
}

__device__ __forceinline__ void comb_phase(const Params& p, const u16* osub, u16* attn_out) {
    const int lane = threadIdx.x & 63, gw = blockIdx.x * 8 + (threadIdx.x >> 6), nw = gridDim.x * 8;
    float d1 = p.lq1[lane] * p.lk1[lane] + p.lq1[lane + 64] * p.lk1[lane + 64];
    float d2 = p.lq2[lane] * p.lk2[lane] + p.lq2[lane + 64] * p.lk2[lane + 64];
    d1 = wave_sum(d1); d2 = wave_sum(d2);
    const float lam = __expf(d1) - __expf(d2) + LAMBDA_INIT;
    const int half = lane >> 5, dd = (lane & 31) * 4;
    for (int it = gw; it < T_TOK * 8; it += nw) {
        const int h = it & 7, t = it >> 3, b = t >> 12, s = t & (SEQ - 1);
        const u16* r0 = osub + (((size_t)(b * 32 + (2 * h) * 2 + half)) * SEQ + s) * 128 + dd;
        const u16* r1 = osub + (((size_t)(b * 32 + (2 * h + 1) * 2 + half)) * SEQ + s) * 128 + dd;
        const u32x2v a = *(const u32x2v*)r0, c = *(const u32x2v*)r1;
        const float o0 = bf_lo(a.x) - lam * bf_lo(c.x), o1 = bf_hi(a.x) - lam * bf_hi(c.x), o2 = bf_lo(a.y) - lam * bf_lo(c.y), o3 = bf_hi(a.y) - lam * bf_hi(c.y);
        float ss = o0 * o0 + o1 * o1 + o2 * o2 + o3 * o3;
        ss = wave_sum(ss);
        const float rs = rsqrtf(ss * (1.f / 256.f) + EPS);
        u32x2v o; o.x = pk_bf16(o0 * rs, o1 * rs); o.y = pk_bf16(o2 * rs, o3 * rs);
        *(u32x2v*)(attn_out + (size_t)t * DM + h * 256 + half * 128 + dd) = o;
    }
}

struct EpiPlain {
    static constexpr bool PERM = true, AFTER_DRAIN = false;
    u16* O; int ldc; int pool;
    __device__ __forceinline__ void operator()(const pg8::f32x4 (&acc)[2][2][4][2], const pg8::Unit& u, int wr, int wc, int fr, int fq) const {
        const int pm = pool ? (u.pm & 63) : u.pm;
        const int row0 = pm * 256 + wr * 64 + fr, col0 = u.pn * 256 + wc * 32 + 8 * fq;
#pragma unroll
        for (int ai = 0; ai < 2; ++ai)
#pragma unroll
            for (int m = 0; m < 4; ++m) { u16* rowp = O + (size_t)(row0 + ai * 128 + m * 16) * ldc + col0;
#pragma unroll
                for (int bj = 0; bj < 2; ++bj) { const pg8::f32x4 v0 = acc[ai][bj][m][0], v1 = acc[ai][bj][m][1]; u32x4v w;
                    w.x = pk_bf16(v0[0], v0[1]); w.y = pk_bf16(v0[2], v0[3]); w.z = pk_bf16(v1[0], v1[1]); w.w = pk_bf16(v1[2], v1[3]);
                    *(u32x4v*)(rowp + bj * 128) = w; } }
    }
};
__device__ __forceinline__ float silu_mul(float g, float u) { return g * __builtin_amdgcn_rcpf(1.f + __builtin_amdgcn_exp2f(-1.4426950408889634f * g)) * u; }
struct EpiGateUp {
    static constexpr bool PERM = true, AFTER_DRAIN = false;
    u16* O;
    __device__ __forceinline__ void operator()(const pg8::f32x4 (&acc)[2][2][4][2], const pg8::Unit& u, int wr, int wc, int fr, int fq) const {
        const int row0 = u.pm * 256 + wr * 64 + fr, col0 = u.pn * 128 + wc * 32 + 8 * fq;
#pragma unroll
        for (int ai = 0; ai < 2; ++ai)
#pragma unroll
            for (int m = 0; m < 4; ++m) { u16* rowp = O + (size_t)(row0 + ai * 128 + m * 16) * DFF + col0;
                const pg8::f32x4 g0 = acc[ai][0][m][0], g1 = acc[ai][0][m][1], u0 = acc[ai][1][m][0], u1 = acc[ai][1][m][1]; u32x4v w;
                w.x = pk_bf16(silu_mul(g0[0], u0[0]), silu_mul(g0[1], u0[1])); w.y = pk_bf16(silu_mul(g0[2], u0[2]), silu_mul(g0[3], u0[3]));
                w.z = pk_bf16(silu_mul(g1[0], u1[0]), silu_mul(g1[1], u1[1])); w.w = pk_bf16(silu_mul(g1[2], u1[2]), silu_mul(g1[3], u1[3]));
                *(u32x4v*)rowp = w; }
    }
};
struct EpiQKV {
    static constexpr bool PERM = false, AFTER_DRAIN = false;
    u16* base; const float* cosT; const float* sinT;
    __device__ __forceinline__ void operator()(const pg8::f32x4 (&acc)[2][2][4][2], const pg8::Unit& u, int wr, int wc, int fr, int fq) const {
        const int kind = u.pn >> 3;
        u16* dst = base + (size_t)kind * ((size_t)T_TOK * DM);
        const bool rope = (kind != 1) && (wc == 0);
#pragma unroll
        for (int ai = 0; ai < 2; ++ai)
#pragma unroll
            for (int m = 0; m < 4; ++m) {
                const int row = u.pm * 256 + ai * 128 + wr * 64 + m * 16 + fr, b = row >> 12, s = row & (SEQ - 1);
                f32x4v cs = {1.f, 1.f, 1.f, 1.f}, sn = {0.f, 0.f, 0.f, 0.f};
                if (rope) { cs = *(const f32x4v*)(cosT + s * 16 + 4 * fq); sn = *(const f32x4v*)(sinT + s * 16 + 4 * fq); }
#pragma unroll
                for (int bj = 0; bj < 2; ++bj) {
                    const int head = 2 * (u.pn & 7) + bj;
                    u16* rp = dst + ((size_t)(b * 16 + head) * SEQ + s) * 128 + wc * 32 + 4 * fq;
                    pg8::f32x4 a = acc[ai][bj][m][0], c = acc[ai][bj][m][1];
                    if (rope) {
#pragma unroll
                        for (int j = 0; j < 4; ++j) { const float x1 = a[j], x2 = c[j]; a[j] = x1 * cs[j] - x2 * sn[j]; c[j] = x2 * cs[j] + x1 * sn[j]; }
                    }
                    u32x2v w0, w1; w0.x = pk_bf16(a[0], a[1]); w0.y = pk_bf16(a[2], a[3]); w1.x = pk_bf16(c[0], c[1]); w1.y = pk_bf16(c[2], c[3]);
                    *(u32x2v*)rp = w0; *(u32x2v*)(rp + 16) = w1;
                }
            }
    }
};
struct PoolOrder {
    int G, c;
    __device__ bool next(int i, pg8::Unit& u) const { const int L = i * G + c; if (L >= 512) return false; const int pne = L & 7, pm = L >> 3; u.pm = (pne >> 1) * 64 + pm; u.pn = pne; return true; }
    __device__ __forceinline__ void a_ready(const pg8::Unit&) const {}
    __device__ __forceinline__ void done(const pg8::Unit&) const {}
};

struct AttItem { int vhd, qb0, qb1; };
__device__ __forceinline__ AttItem att_decode(int L) { AttItem it; const int xcd = L & 7, k = L >> 3; it.vhd = xcd * 16 + (k >> 3); it.qb0 = k & 7; it.qb1 = 15 - it.qb0; return it; }
__device__ __forceinline__ att::BlockRef<att::bf16, att::bf16> att_ref(const AttItem& it, int pass, const u16* Kb, const u16* Vb, const u16* Qb, u16* Ob) {
    const int qb = pass ? it.qb1 : it.qb0, b = it.vhd >> 5, r = it.vhd & 31, sh = r >> 1, half = r & 1;
    att::BlockRef<att::bf16, att::bf16> R;
    R.Q = (const att::bf16*)(Qb + ((size_t)(b * 16 + sh) * SEQ + (size_t)qb * 256) * 128);
    R.K = (const att::bf16*)(Kb + ((size_t)(b * 16 + sh) * SEQ) * 128);
    R.V = (const att::bf16*)(Vb + ((size_t)(b * 16 + (sh >> 1) * 2 + half) * SEQ) * 128);
    R.O = (att::bf16*)(Ob + ((size_t)it.vhd * SEQ + (size_t)qb * 256) * 128);
    R.P0 = qb * 256;
    return R;
}
__device__ __forceinline__ void attention_phase(const u16* Kb, const u16* Vb, const u16* Qb, u16* Ob, char* lds) {
    constexpr int TOTAL = 1024;
    int L = blockIdx.x; if (L >= TOTAL) return;
    const int stride = gridDim.x;
    AttItem it = att_decode(L); int pass = 0;
    att::BlockRef<att::bf16, att::bf16> cur = att_ref(it, 0, Kb, Vb, Qb, Ob);
    att::Seam<att::bf16> S;
    att::causal_swa_prime<att::bf16, att::bf16>(cur, SEQ, lds, S);
    for (;;) {
        const bool more_pass = pass == 0, more_item = L + stride < TOTAL, last = !more_pass && !more_item;
        AttItem itn = it; int passn = pass + 1, Ln = L;
        if (!more_pass) { passn = 0; Ln = more_item ? L + stride : L; itn = att_decode(Ln); }
        const att::BlockRef<att::bf16, att::bf16> nxt = last ? cur : att_ref(itn, passn, Kb, Vb, Qb, Ob);
        att::causal_swa_block<att::bf16, att::bf16>(cur, nxt, SEQ, SEQ, lds, S);
        if (last) break;
        cur = nxt; it = itn; pass = passn; L = Ln;
    }
}

__global__ __launch_bounds__(512, 2) void mega(Params p) {
    extern __shared__ __attribute__((aligned(16))) unsigned char shm[];
    cg::grid_group grid = cg::this_grid();
    unsigned char* ws = p.ws;
    u16* const wpool = (u16*)(ws + WS_WPOOL); u16* const wgu = (u16*)(ws + WS_WGU); u16* const wdn = (u16*)(ws + WS_WDN); u16* const wqkv = (u16*)(ws + WS_WQKV); u16* const wo = (u16*)(ws + WS_WO);
    float* const rstd0 = (float*)(ws + WS_MISC + MISC_RSTD); float* const cosT = (float*)(ws + WS_MISC + MISC_COS); float* const sinT = (float*)(ws + WS_MISC + MISC_SIN);
    u16* const bufA = (u16*)(ws + WS_A); u16* const bufB = (u16*)(ws + WS_B); u16* const mixed = (u16*)(ws + WS_C); u16* const mbuf = (u16*)(ws + WS_C + 64 * MiB); u16* const osub = (u16*)(ws + WS_C);
    const int G = (int)gridDim.x, bid = (int)blockIdx.x;
#define IN(k) (p.ph_lo <= (k) && (k) < p.ph_hi)
#define SYNC(k) do { if (IN(k) && IN((k) + 1)) grid.sync(); } while (0)
    if (IN(0)) {
        for (int t = bid; t < 2112 + 1088; t += G) { if (t < 2112) conv_ffn_tile(p, 0, t, shm); else conv_misc_tile(p, t - 2112, shm); }
        for (int e = bid * 512 + (int)threadIdx.x; e < SEQ * 16; e += G * 512) rope_entry(e, cosT, sinT);
        rstd_rows(p.x, rstd0);
    }
    SYNC(0);
    if (IN(1)) mixed_phase(p.x, rstd0, mixed);
    SYNC(1);
    if (IN(2)) { pg8::Gemm g{mixed, wpool, 4 * T_TOK, 512, 512}; PoolOrder S{G, bid}; EpiPlain E{mbuf, DM, 1};
        pg8::gemm_phase<EpiPlain, PoolOrder, false>((PG8_LAS unsigned char*)shm, g, S, E, nullptr); }
    SYNC(2);
    if (IN(3)) norm_phase<false>(p.x, mbuf, p.norm_mix_post, p.out, bufB);
    SYNC(3);
    if (IN(4)) { pg8::Gemm g{bufB, wgu, T_TOK, 2 * DFF, DM}; pg8::StaticOrder S; S.init(T_TOK, 2 * DFF, G, bid); EpiGateUp E{bufA};
        pg8::gemm_phase<EpiGateUp, pg8::StaticOrder, false>((PG8_LAS unsigned char*)shm, g, S, E, nullptr); }
    SYNC(4);
    if (IN(5)) { pg8::Gemm g{bufA, wdn, T_TOK, DM, DFF}; pg8::StaticOrder S; S.init(T_TOK, DM, G, bid); EpiPlain E{mbuf, DM, 0};
        pg8::gemm_phase<EpiPlain, pg8::StaticOrder, false>((PG8_LAS unsigned char*)shm, g, S, E, nullptr); }
    SYNC(5);
    if (IN(6)) { norm_phase<false>(p.out, mbuf, p.norm_ffn_post, p.out, bufB);
        for (int t = bid; t < 2112; t += G) conv_ffn_tile(p, 1, t, shm); }
    SYNC(6);
    if (IN(7)) { pg8::Gemm g{bufB, wqkv, T_TOK, 3 * DM, DM}; pg8::StaticOrder S; S.init(T_TOK, 3 * DM, G, bid); EpiQKV E{bufA, cosT, sinT};
        pg8::gemm_phase<EpiQKV, pg8::StaticOrder, false>((PG8_LAS unsigned char*)shm, g, S, E, nullptr); }
    SYNC(7);
    if (IN(8)) attention_phase(bufA, bufA + (size_t)T_TOK * DM, bufA + 2 * (size_t)T_TOK * DM, osub, (char*)shm);
    SYNC(8);
    if (IN(9)) comb_phase(p, osub, bufB);
    SYNC(9);
    if (IN(10)) { pg8::Gemm g{bufB, wo, T_TOK, DM, DM}; pg8::StaticOrder S; S.init(T_TOK, DM, G, bid); EpiPlain E{mbuf, DM, 0};
        pg8::gemm_phase<EpiPlain, pg8::StaticOrder, false>((PG8_LAS unsigned char*)shm, g, S, E, nullptr); }
    SYNC(10);
    if (IN(11)) norm_phase<false>(p.out, mbuf, p.norm_mix_post + DM, p.out, bufB);
    SYNC(11);
    if (IN(12)) { pg8::Gemm g{bufB, wgu, T_TOK, 2 * DFF, DM}; pg8::StaticOrder S; S.init(T_TOK, 2 * DFF, G, bid); EpiGateUp E{bufA};
        pg8::gemm_phase<EpiGateUp, pg8::StaticOrder, false>((PG8_LAS unsigned char*)shm, g, S, E, nullptr); }
    SYNC(12);
    if (IN(13)) { pg8::Gemm g{bufA, wdn, T_TOK, DM, DFF}; pg8::StaticOrder S; S.init(T_TOK, DM, G, bid); EpiPlain E{mbuf, DM, 0};
        pg8::gemm_phase<EpiPlain, pg8::StaticOrder, false>((PG8_LAS unsigned char*)shm, g, S, E, nullptr); }
    SYNC(13);
    if (IN(14)) norm_phase<true>(p.out, mbuf, p.norm_ffn_post + DM, p.out, nullptr);
#undef IN
#undef SYNC
}

#ifndef MK_PER_PHASE
#define MK_PER_PHASE 0
#endif
extern "C" void kernel_launch(void* const* d_in, const int* in_sizes, int n_in, void* d_out, int out_size, void* d_ws, size_t ws_size, hipStream_t stream) {
    static int grid = 0;
    if (grid == 0) {
        if (n_in != 19 || out_size != T_TOK * DM || ws_size < WS_END) { fprintf(stderr, "kernel_launch: unexpected shapes (n_in %d out %d ws %zu)\n", n_in, out_size, ws_size); grid = -1; return; }
        int dev = 0, cus = 0, per_cu = 0;
        (void)hipGetDevice(&dev);
        if (hipDeviceGetAttribute(&cus, hipDeviceAttributeMultiprocessorCount, dev) != hipSuccess || cus <= 0) cus = 256;
        if (hipFuncSetAttribute((const void*)mega, hipFuncAttributeMaxDynamicSharedMemorySize, LDS_TOTAL) != hipSuccess) { fprintf(stderr, "kernel_launch: hipFuncSetAttribute failed\n"); grid = -1; return; }
        if (hipOccupancyMaxActiveBlocksPerMultiprocessor(&per_cu, (const void*)mega, 512, LDS_TOTAL) != hipSuccess || per_cu < 1) { fprintf(stderr, "kernel_launch: occupancy query says %d\n", per_cu); per_cu = 1; }
        (void)hipGetLastError();
        grid = cus * per_cu;
    }
    if (grid < 0) return;
    Params p{};
    p.x = (const float*)d_in[0]; p.norm_mix_pre = (const float*)d_in[1]; p.norm_mix_post = (const float*)d_in[2]; p.norm_ffn_pre = (const float*)d_in[3]; p.norm_ffn_post = (const float*)d_in[4];
    p.w_pool = (const float*)d_in[5]; p.pool_scale = (const float*)d_in[6]; p.kv_norm = (const float*)d_in[7]; p.w_kv = (const float*)d_in[8]; p.w_q = (const float*)d_in[9];
    p.lq1 = (const float*)d_in[10]; p.lk1 = (const float*)d_in[11]; p.lq2 = (const float*)d_in[12]; p.lk2 = (const float*)d_in[13]; p.subln = (const float*)d_in[14]; p.w_o = (const float*)d_in[15];
    p.w_gate = (const float*)d_in[16]; p.w_up = (const float*)d_in[17]; p.w_down = (const float*)d_in[18];
    p.out = (float*)d_out; p.ws = (unsigned char*)d_ws;
#if MK_PER_PHASE
    for (int ph = 0; ph <= NPHASE; ++ph) { p.ph_lo = ph; p.ph_hi = ph + 1; hipLaunchKernelGGL(mega, dim3(grid), dim3(512), LDS_TOTAL, stream, p); }
#else
    p.ph_lo = 0; p.ph_hi = NPHASE + 1;
    void* args[] = {&p};
    hipError_t e = hipLaunchCooperativeKernel((const void*)mega, dim3(grid), dim3(512), args, LDS_TOTAL, stream);
    if (e != hipSuccess) fprintf(stderr, "cooperative launch failed: %s (grid %d)\n", hipGetErrorString(e), grid);
#endif
}
```

```cpp
#include <hip/hip_runtime.h>
#include <hip/hip_bf16.h>
#include <hip/hip_cooperative_groups.h>
#include <cstdio>
#include <cstdint>
#ifndef REP_GEMM
#define REP_GEMM 1
#endif
namespace pg8 {
#define PG8_LAS __attribute__((address_space(3)))
typedef unsigned short bf16_t;
typedef short bf16x8 __attribute__((ext_vector_type(8)));
typedef float f32x4 __attribute__((ext_vector_type(4)));
typedef unsigned u32x4 __attribute__((ext_vector_type(4)));
constexpr int BM = 256, BK = 64, HALF = 128, HTB = HALF * BK * 2  , STAGE_BYTES = 8 * HTB, NXCD = 8, WGM = 8;

__host__ __device__ __forceinline__ int lds_byte(int r, int c) { const int st = (r >> 4) * 2 + (c >> 5), rr = r & 15, cc = c & 31, ob = rr * 64 + cc * 2; return st * 1024 + (ob ^ (((ob >> 9) & 1) << 5)); }
__host__ __device__ __forceinline__ void stage_rc(int b, int& R, int& C) { const int st = b / 1024, sb = b % 1024, swz = sb ^ (((sb >> 9) & 1) << 5); R = (st >> 1) * 16 + swz / 64; C = (st & 1) * 32 + (swz % 64) / 2; }
__host__ __device__ __forceinline__ int perm32(int rho) { const int n = rho >> 4, i = rho & 15; return 8 * (i >> 2) + 4 * n + (i & 3); }

struct Unit { int pm, pn; };
struct Gemm { const bf16_t* A; const bf16_t* Bt; int M, N, K; };

struct StaticOrder {
    int nM, nN, nwg, G, c, rep = REP_GEMM;
    __host__ __device__ void init(int M, int N, int G_, int c_) { nM = M / BM; nN = N / BM; nwg = nM * nN; G = G_; c = c_; }
    __host__ __device__ bool next(int i, Unit& u) const {
        long L = (long)i * G + c; if (L >= (long)nwg * rep) return false; L %= nwg;
        int wgid = (int)L; { const int q = nwg / NXCD, r = nwg % NXCD, xcd = wgid % NXCD, off = wgid / NXCD; wgid = (xcd < r ? xcd * (q + 1) : r * (q + 1) + (xcd - r) * q) + off; }
        const int nig = WGM * nN, gid = wgid / nig, fm = gid * WGM, gsz = (nM - fm) < WGM ? (nM - fm) : WGM;
        u.pm = fm + ((wgid % nig) % gsz); u.pn = (wgid % nig) / gsz; return true;
    }
    __device__ __forceinline__ void a_ready(const Unit&) const {}
    __device__ __forceinline__ void done(const Unit&) const {}
};
__device__ __forceinline__ unsigned cvt_pk_bf16(float lo, float hi) { unsigned r; asm volatile("v_cvt_pk_bf16_f32 %0, %1, %2" : "=v"(r) : "v"(lo), "v"(hi)); return r; }
template <class Epi, class Sched, bool STAMP = false>
__device__ __forceinline__ void gemm_phase(PG8_LAS unsigned char* lds, const Gemm g, const Sched& S, const Epi& E, unsigned long long* stamps) {
    const int tid = threadIdx.x, wid = __builtin_amdgcn_readfirstlane(tid >> 6), lane = tid & 63, wr = wid >> 2, wc = wid & 3, fr = lane & 15, fq = lane >> 4;
    const int K = g.K, nt = K / BK;
    int ts_lo = 0, ts_hi = 0, nts = 0; const unsigned long long rt_entry = STAMP ? (unsigned long long)wall_clock64() : 0ull;
#define PG8_STAMP() do { if (STAMP && wid == 0 && nts < 64) { const unsigned long long _c = (unsigned long long)clock64(); \
        ts_lo = (lane == nts) ? (int)(unsigned)_c : ts_lo; ts_hi = (lane == nts) ? (int)(unsigned)(_c >> 32) : ts_hi; ++nts; } } while (0)
    PG8_STAMP();
    unsigned voffA[2], voffB[2];
#pragma unroll
    for (int i = 0; i < 2; ++i) { int R, C; stage_rc(tid * 16 + i * 8192, R, C); const int Rb = Epi::PERM ? ((R & ~31) + perm32(R & 31)) : R;
        voffA[i] = (unsigned)(R * K + C) * 2u; voffB[i] = (unsigned)(Rb * K + C) * 2u; }
    const size_t kstep = (size_t)(BK * 2);
    const size_t hstep = (size_t)HALF * K * 2;
    const size_t tstep = 2 * hstep;
    const unsigned ldsw = (unsigned)wid * 1024u;
    const int aoff = lds_byte(wr * 64 + fr, fq * 8), boff = lds_byte(wc * 32 + fr, fq * 8);
#define PG8_SA(b, h) (((b) * 2 + (h)) * HTB)
#define PG8_SB(b, h) ((4 + (b) * 2 + (h)) * HTB)
#define PG8_STAGE(bufoff, gbase, voff) do { _Pragma("unroll") for (int _i = 0; _i < 2; ++_i) \
        __builtin_amdgcn_global_load_lds((const unsigned*)((const char*)(gbase) + (voff)[_i]), (PG8_LAS unsigned*)(lds + (bufoff) + ldsw + _i * 8192), 16, 0, 0); } while (0)
#define PG8_LDA(dst, b, h) do { _Pragma("unroll") for (int m = 0; m < 4; ++m) _Pragma("unroll") for (int k = 0; k < 2; ++k) dst[m][k] = *(const PG8_LAS bf16x8*)(lds + PG8_SA(b, h) + aoff + m * 2048 + k * 1024); } while (0)
#define PG8_LDB(dst, b, h) do { _Pragma("unroll") for (int n = 0; n < 2; ++n) _Pragma("unroll") for (int k = 0; k < 2; ++k) dst[n][k] = *(const PG8_LAS bf16x8*)(lds + PG8_SB(b, h) + boff + n * 2048 + k * 1024); } while (0)
#define PG8_MMA(ai, bj, At, Bt) do { __builtin_amdgcn_s_setprio(1); _Pragma("unroll") for (int m = 0; m < 4; ++m) _Pragma("unroll") for (int n = 0; n < 2; ++n) _Pragma("unroll") for (int k = 0; k < 2; ++k) \
        acc[ai][bj][m][n] = __builtin_amdgcn_mfma_f32_16x16x32_bf16(Bt[n][k], At[m][k], acc[ai][bj][m][n], 0, 0, 0); __builtin_amdgcn_s_setprio(0); } while (0)
#define PG8_WAIT_V(n) asm volatile("s_waitcnt vmcnt(" #n ")" ::: "memory")
#define PG8_WAIT_L(n) asm volatile("s_waitcnt lgkmcnt(" #n ")" ::: "memory")
#define PG8_BAR __builtin_amdgcn_s_barrier()
#define PG8_SCHED __builtin_amdgcn_sched_barrier(0)
    Unit cur, nxt; int ui = 0;
    if (!S.next(0, cur)) return;
    f32x4 acc[2][2][4][2];
#pragma unroll
    for (int a = 0; a < 2; ++a)
#pragma unroll
        for (int b = 0; b < 2; ++b)
#pragma unroll
            for (int m = 0; m < 4; ++m)
#pragma unroll
                for (int n = 0; n < 2; ++n) acc[a][b][m][n] = (f32x4){0.f, 0.f, 0.f, 0.f};
    bf16x8 At[4][2], B0[2][2], B1[2][2];
    const char* cA = (const char*)g.A + (size_t)cur.pm * tstep; const char* cB = (const char*)g.Bt + (size_t)cur.pn * tstep;
    S.a_ready(cur);
    PG8_STAGE(PG8_SB(0, 0), cB, voffB); PG8_STAGE(PG8_SA(0, 0), cA, voffA); PG8_STAGE(PG8_SB(0, 1), cB + hstep, voffB); PG8_STAGE(PG8_SA(0, 1), cA + hstep, voffA);
    if (wr == 1) PG8_BAR;
    PG8_WAIT_V(4); PG8_BAR;
    PG8_STAGE(PG8_SB(1, 0), cB + kstep, voffB); PG8_STAGE(PG8_SA(1, 0), cA + kstep, voffA); PG8_STAGE(PG8_SB(1, 1), cB + hstep + kstep, voffB);
    PG8_WAIT_V(6); PG8_BAR;
    PG8_STAMP();
    for (;;) {
        const bool has_next = S.next(ui + 1, nxt);
        const char* nA = has_next ? (const char*)g.A + (size_t)nxt.pm * tstep : cA; const char* nB = has_next ? (const char*)g.Bt + (size_t)nxt.pn * tstep : cB;
        for (int t = 0; t < nt; t += 2) {
            const bool last = (t == nt - 2);
            const char* a1 = cA + (size_t)(t + 1) * kstep;
            const char* a2 = last ? nA : cA + (size_t)(t + 2) * kstep; const char* b2 = last ? nB : cB + (size_t)(t + 2) * kstep;
            const char* a3 = a2 + kstep; const char* b3 = b2 + kstep;
            if (last && has_next) S.a_ready(nxt);
            PG8_LDB(B0, 0, 0); PG8_SCHED; PG8_LDA(At, 0, 0); PG8_STAGE(PG8_SA(1, 1), a1 + hstep, voffA);
            PG8_WAIT_L(8); PG8_BAR; PG8_WAIT_L(0); PG8_MMA(0, 0, At, B0); PG8_BAR; PG8_SCHED;
            PG8_LDB(B1, 0, 1); PG8_STAGE(PG8_SB(0, 0), b2, voffB);
            PG8_BAR; PG8_WAIT_L(0); PG8_MMA(0, 1, At, B1); PG8_BAR;
            PG8_LDA(At, 0, 1); PG8_STAGE(PG8_SA(0, 0), a2, voffA);
            PG8_BAR; PG8_WAIT_L(0); PG8_MMA(1, 0, At, B0); PG8_BAR; PG8_SCHED;
            PG8_STAGE(PG8_SB(0, 1), b2 + hstep, voffB);
            PG8_WAIT_V(6); PG8_BAR; PG8_MMA(1, 1, At, B1); PG8_BAR;
            PG8_LDB(B0, 1, 0); PG8_SCHED; PG8_LDA(At, 1, 0); PG8_STAGE(PG8_SA(0, 1), a2 + hstep, voffA);
            PG8_WAIT_L(8); PG8_BAR; PG8_WAIT_L(0); PG8_MMA(0, 0, At, B0); PG8_BAR; PG8_SCHED;
            PG8_LDB(B1, 1, 1); PG8_STAGE(PG8_SB(1, 0), b3, voffB);
            PG8_BAR; PG8_WAIT_L(0); PG8_MMA(0, 1, At, B1); PG8_BAR;
            PG8_LDA(At, 1, 1); PG8_STAGE(PG8_SA(1, 0), a3, voffA);
            PG8_BAR; PG8_WAIT_L(0); PG8_MMA(1, 0, At, B0); PG8_BAR; PG8_SCHED;
            PG8_STAGE(PG8_SB(1, 1), b3 + hstep, voffB);
            PG8_WAIT_V(6); PG8_BAR; PG8_MMA(1, 1, At, B1); PG8_BAR;
        }
        PG8_STAMP();
        if constexpr (!Epi::AFTER_DRAIN) { E(acc, cur, wr, wc, fr, fq); S.done(cur); }
        PG8_STAMP();
        if (!has_next) break;
#pragma unroll
        for (int a = 0; a < 2; ++a)
#pragma unroll
            for (int b = 0; b < 2; ++b)
#pragma unroll
                for (int m = 0; m < 4; ++m)
#pragma unroll
                    for (int n = 0; n < 2; ++n) acc[a][b][m][n] = (f32x4){0.f, 0.f, 0.f, 0.f};
        cur = nxt; cA = nA; cB = nB; ++ui;
    }
    PG8_WAIT_V(0);
    if (wr == 0) PG8_BAR;
    PG8_BAR;
    if constexpr (Epi::AFTER_DRAIN) { E.fused(acc, cur, wr, wc, fr, fq, lds, wid, lane); S.done(cur); }
    PG8_STAMP();
    if (STAMP && wid == 0) { stamps[lane] = lane < nts ? (((unsigned long long)(unsigned)ts_hi << 32) | (unsigned)ts_lo) : 0ull;
        if (lane == 62) stamps[62] = rt_entry; if (lane == 63) stamps[63] = (unsigned long long)wall_clock64(); }
#undef PG8_STAMP
#undef PG8_SA
#undef PG8_SB
#undef PG8_STAGE
#undef PG8_LDA
#undef PG8_LDB
#undef PG8_MMA
#undef PG8_WAIT_V
#undef PG8_WAIT_L
#undef PG8_BAR
#undef PG8_SCHED
}
}
namespace att {
constexpr int D = 128;
constexpr float THR = 8.f;
constexpr bool WSKIP = false;
constexpr float SCALE = 0.08838834764831845f;
constexpr int NW = 8, QBLK = 32, KVBLK = 64, QB = NW * QBLK;
constexpr int SHM_V = KVBLK * D * 2, SHM_K = KVBLK * D * 2;
using bf16 = __hip_bfloat16;
typedef short bf16x8 __attribute__((ext_vector_type(8)));
typedef short s16x4 __attribute__((ext_vector_type(4)));
typedef float f32x16 __attribute__((ext_vector_type(16)));
typedef float f32x4 __attribute__((ext_vector_type(4)));
typedef unsigned u32x4 __attribute__((ext_vector_type(4)));
template <class A, class Bt> struct same_t { static constexpr bool v = false; };
template <class A> struct same_t<A, A> { static constexpr bool v = true; };

#define KSWZ(row, colB) ((row) * 256 + ((colB) ^ (((row) & 7) << 4)))
#define SBAR() __builtin_amdgcn_sched_barrier(0)
__device__ __forceinline__ int v_st(int k, int c) { const int kk = (k & ~0xC) | ((k & 4) << 1) | ((k & 8) >> 1); return ((kk >> 3) * 4 + (c >> 5)) * 512 + ((kk & 7) * 32 + (c & 31)) * 2; }
__device__ __forceinline__ int v_rd_base(int lane) { return ((lane & 3) << 3) | (((lane >> 2) & 3) << 6) | (((lane >> 4) & 1) << 5) | (((lane >> 5) & 1) << 8); }
constexpr int v_rd_off(int d0, int ks, int half) { return d0 * 512 + ks * 4096 + half * 2048; }
__device__ __forceinline__ int crow(int r, int hi) { return (r & 3) + 8 * (r >> 2) + 4 * hi; }
__device__ __forceinline__ unsigned cvtpk(float lo, float hi) {
    unsigned r; asm volatile("v_cvt_pk_bf16_f32 %0, %1, %2" : "=v"(r) : "v"(lo), "v"(hi)); return r;
}
__device__ __forceinline__ bf16x8 pack8(f32x4 a, f32x4 b) {
    u32x4 w = {cvtpk(a[0], a[1]), cvtpk(a[2], a[3]), cvtpk(b[0], b[1]), cvtpk(b[2], b[3])};
    return *reinterpret_cast<bf16x8*>(&w);
}
template <class T> __device__ __forceinline__ bf16x8 load8(const T* p) {
    if constexpr (same_t<T, float>::v) { return pack8(*(const f32x4*)p, *(const f32x4*)(p + 4)); }
    else { return *reinterpret_cast<const bf16x8*>(p); }
}
__device__ __forceinline__ void mask_tile(f32x16& p0, f32x16& p1, int dq, unsigned W) {
    const float NEG = -__builtin_inff();
#pragma unroll
    for (int r = 0; r < 16; ++r) {
        const int c = (r & 3) + 8 * (r >> 2);
        if ((unsigned)(dq - c) >= W) p0[r] = NEG;
        if ((unsigned)(dq - c - 32) >= W) p1[r] = NEG;
    }
}
__device__ __forceinline__ void partialSM(f32x16& p0, f32x16& p1, float& m_reg, float& mn, float& alpha) {
    float pmax = p0[0]; for (int r = 1; r < 16; ++r) pmax = fmaxf(pmax, p0[r]); for (int r = 0; r < 16; ++r) pmax = fmaxf(pmax, p1[r]);
    { auto rr = __builtin_amdgcn_permlane32_swap(__float_as_uint(pmax), __float_as_uint(pmax), false, false);
      pmax = fmaxf(__uint_as_float(rr[0]), __uint_as_float(rr[1])); }
    constexpr float C2 = 1.4426950408889634f * SCALE;
    if (__builtin_expect(__all((pmax - m_reg) * SCALE <= THR), 1)) { mn = m_reg; alpha = 1.f; }
    else { mn = fmaxf(m_reg, pmax); alpha = __builtin_amdgcn_exp2f((m_reg - mn) * C2); m_reg = mn; }
    const float mnL = -mn * C2;
    for (int r = 0; r < 16; ++r) p0[r] = fmaf(p0[r], C2, mnL); for (int r = 0; r < 16; ++r) p1[r] = fmaf(p1[r], C2, mnL);
    for (int r = 0; r < 16; ++r) p0[r] = __builtin_amdgcn_exp2f(p0[r]);
}
__device__ __forceinline__ void finishSM(f32x16& p0, f32x16& p1, float alpha, float& l_reg, bf16x8& pa0, bf16x8& pa1, bf16x8& pa2, bf16x8& pa3) {
    for (int r = 0; r < 16; ++r) p1[r] = __builtin_amdgcn_exp2f(p1[r]);
    float ps = 0; for (int r = 0; r < 16; ++r) ps += p0[r]; for (int r = 0; r < 16; ++r) ps += p1[r];
    { auto rr = __builtin_amdgcn_permlane32_swap(__float_as_uint(ps), __float_as_uint(ps), false, false);
      ps = __uint_as_float(rr[0]) + __uint_as_float(rr[1]); }
    l_reg = l_reg * alpha + ps;
#define PK4(P, B_, OUT) do { unsigned a0 = cvtpk(P[B_+0], P[B_+1]), a1 = cvtpk(P[B_+2], P[B_+3]);                          \
        unsigned b0 = cvtpk(P[B_+4], P[B_+5]), b1 = cvtpk(P[B_+6], P[B_+7]);                                             \
        auto r0 = __builtin_amdgcn_permlane32_swap(a0, b0, false, false); auto r1 = __builtin_amdgcn_permlane32_swap(a1, b1, false, false); \
        u32x4 w = {r0[0], r1[0], r0[1], r1[1]}; OUT = *reinterpret_cast<bf16x8*>(&w); } while (0)
    PK4(p0, 0, pa0); PK4(p0, 8, pa1); PK4(p1, 0, pa2); PK4(p1, 8, pa3);
#undef PK4
}
template <int KB, bool SK>
__device__ __forceinline__ void qkt(f32x16& p0, f32x16& p1, const char* K_lds, int r32, int hi, const bf16x8* qr, bool act) {
    if (SK && !act) { const float NEG = -__builtin_inff();
#pragma unroll
        for (int r = 0; r < 16; ++r) { p0[r] = NEG; p1[r] = NEG; } return; }
    p0 = f32x16{}; p1 = f32x16{};
    const char* kb[4];
#pragma unroll
    for (int dd = 0; dd < 4; ++dd) kb[dd] = K_lds + KB * SHM_K + KSWZ(r32, (dd * 16 + hi * 8) * 2);
#pragma unroll
    for (int d0 = 0; d0 < 8; ++d0) { const char* a = kb[d0 & 3] + (d0 >> 2) * 128;
        bf16x8 b0 = *reinterpret_cast<const bf16x8*>(a);
        bf16x8 b1 = *reinterpret_cast<const bf16x8*>(a + 32 * 256);
        p0 = __builtin_amdgcn_mfma_f32_32x32x16_bf16(b0, qr[d0], p0, 0, 0, 0);
        p1 = __builtin_amdgcn_mfma_f32_32x32x16_bf16(b1, qr[d0], p1, 0, 0, 0); }
}
template <int VB, bool SK>
__device__ __forceinline__ void pv_tile(f32x16* o, int vb0, bf16x8 pa0, bf16x8 pa1, bf16x8 pa2, bf16x8 pa3, bool act) {
    if (SK && !act) return;
#define TRRD(dst, off) asm volatile("ds_read_b64_tr_b16 %0, %1 offset:%2" : "=&v"(dst) : "v"(vb0), "i"(off) : "memory")
#define PV_D0(d0) do { s16x4 l0, l1, l2, l3, h0, h1, h2, h3; constexpr int b_ = VB * SHM_V + v_rd_off(d0, 0, 0);     \
        TRRD(l0, b_); TRRD(h0, b_ + 2048); TRRD(l1, b_ + 4096); TRRD(h1, b_ + 6144); TRRD(l2, b_ + 8192); TRRD(h2, b_ + 10240); TRRD(l3, b_ + 12288); TRRD(h3, b_ + 14336); \
        asm volatile("s_waitcnt lgkmcnt(0)" ::: "memory"); SBAR();                 \
        o[d0] = __builtin_amdgcn_mfma_f32_32x32x16_bf16(pa0, (bf16x8){l0[0], l0[1], l0[2], l0[3], h0[0], h0[1], h0[2], h0[3]}, o[d0], 0, 0, 0);   \
        o[d0] = __builtin_amdgcn_mfma_f32_32x32x16_bf16(pa1, (bf16x8){l1[0], l1[1], l1[2], l1[3], h1[0], h1[1], h1[2], h1[3]}, o[d0], 0, 0, 0);   \
        o[d0] = __builtin_amdgcn_mfma_f32_32x32x16_bf16(pa2, (bf16x8){l2[0], l2[1], l2[2], l2[3], h2[0], h2[1], h2[2], h2[3]}, o[d0], 0, 0, 0);   \
        o[d0] = __builtin_amdgcn_mfma_f32_32x32x16_bf16(pa3, (bf16x8){l3[0], l3[1], l3[2], l3[3], h3[0], h3[1], h3[2], h3[3]}, o[d0], 0, 0, 0); } while (0)
    PV_D0(0); PV_D0(1); PV_D0(2); PV_D0(3);
#undef PV_D0
#undef TRRD
}

template <class TIn, class TOut> struct BlockRef { const TIn* Q; const TIn* K; const TIn* V; TOut* O; int P0; };
template <class TIn> struct Seam {
    bf16x8 qr[8];
    bf16x8 st_v0, st_v1, st_k0, st_k1; f32x4 sf0, sf1, sf2, sf3;
    f32x4 tq[16];
};
__device__ __forceinline__ int swa_jlo(int P0, int W) { const int lowk = P0 - W + 1; return lowk > 0 ? lowk / KVBLK : 0; }
#define ROW(p, k0, rr) ((p) + (size_t)((k0) + (rr)) * D + sc)
#define VMW() asm volatile("s_waitcnt vmcnt(0)" ::: "memory")
#define VMWN(n) asm volatile("s_waitcnt vmcnt(%0)" :: "i"(n) : "memory")
#define SLOAD_H(Kp, Vp, k0) do { S.st_v0 = load8<TIn>(ROW(Vp, k0, sr)); S.st_v1 = load8<TIn>(ROW(Vp, k0, 32 + sr));              \
                         S.st_k0 = load8<TIn>(ROW(Kp, k0, sr)); S.st_k1 = load8<TIn>(ROW(Kp, k0, 32 + sr)); } while (0)
#define SWRITE_HK(bf) do { *(bf16x8*)(K_lds + (bf) * SHM_K + kws) = S.st_k0; *(bf16x8*)(K_lds + (bf) * SHM_K + kws + 32 * 256) = S.st_k1; } while (0)
#define SWRITE_HV(bf) do { *(bf16x8*)(V_lds + (bf) * SHM_V + vst0) = S.st_v0; *(bf16x8*)(V_lds + (bf) * SHM_V + vst1) = S.st_v1; } while (0)
#define SWRITE_H(bf) do { SWRITE_HV(bf); SWRITE_HK(bf); } while (0)
#define SLOAD_F(p, k0) do { S.sf0 = *(const f32x4*)ROW(p, k0, sr); S.sf1 = *(const f32x4*)(ROW(p, k0, sr) + 4);                \
                            S.sf2 = *(const f32x4*)ROW(p, k0, 32 + sr); S.sf3 = *(const f32x4*)(ROW(p, k0, 32 + sr) + 4); } while (0)
#define SWRITE_KF(bf) do { *(bf16x8*)(K_lds + (bf) * SHM_K + kws) = pack8(S.sf0, S.sf1); *(bf16x8*)(K_lds + (bf) * SHM_K + kws + 32 * 256) = pack8(S.sf2, S.sf3); } while (0)
#define SWRITE_VF(bf) do { *(bf16x8*)(V_lds + (bf) * SHM_V + vst0) = pack8(S.sf0, S.sf1); *(bf16x8*)(V_lds + (bf) * SHM_V + vst1) = pack8(S.sf2, S.sf3); } while (0)
template <class TIn, class TOut>
__device__ __forceinline__ void causal_swa_prime(const BlockRef<TIn, TOut>& cur, int W, char* lds, Seam<TIn>& S) {
    constexpr bool F32 = same_t<TIn, float>::v;
    const int tid = threadIdx.x, wid = __builtin_amdgcn_readfirstlane(tid >> 6), lane = tid & 63, r32 = lane & 31, hi = lane >> 5;
    const int sr = tid >> 4, sc = (tid & 15) * 8, kws = KSWZ(sr, sc * 2); char* K_lds = lds + 2 * SHM_V;
    const int kb0 = swa_jlo(cur.P0, W) * KVBLK;
    for (int d0 = 0; d0 < 8; ++d0) S.qr[d0] = load8<TIn>(cur.Q + (size_t)(wid * QBLK + r32) * D + d0 * 16 + hi * 8);
    if constexpr (F32) { SLOAD_F((const float*)cur.K, kb0); VMW(); SWRITE_KF(0); SBAR(); SLOAD_F((const float*)cur.V, kb0); }
    else { SLOAD_H(cur.K, cur.V, kb0); VMW(); SWRITE_HK(0); }
    __syncthreads();
}
template <class TIn, class TOut>
__device__ __forceinline__ void causal_swa_block(const BlockRef<TIn, TOut>& cur, const BlockRef<TIn, TOut>& nxt, int skv, int W, char* lds, Seam<TIn>& S) {
    constexpr bool F32 = same_t<TIn, float>::v;
    const int tid = threadIdx.x, wid = __builtin_amdgcn_readfirstlane(tid >> 6), lane = tid & 63, r32 = lane & 31, hi = lane >> 5;
    const int j_lo = swa_jlo(cur.P0, W);
    int j_hi = (cur.P0 + QB - 1) / KVBLK + 1; if (j_hi > skv / KVBLK) j_hi = skv / KVBLK;
    const int NT = j_hi - j_lo;
    const int kbn = swa_jlo(nxt.P0, W) * KVBLK;
    const int qlo = cur.P0 + wid * QBLK, qm = qlo + r32 - 4 * hi;
    char* V_lds = lds; char* K_lds = lds + 2 * SHM_V;
    float* ws = (float*)(lds + 2 * SHM_V + 2 * SHM_K) + wid * 64; float* li_l = ws, * al_l = ws + 32;
    float m_reg = -1e30f, l_reg = 0; f32x16 o[4] = {};
    const int sr = tid >> 4, sc = (tid & 15) * 8, vst0 = v_st(sr, sc), vst1 = v_st(32 + sr, sc), kws = KSWZ(sr, sc * 2);
    const int vb0 = (int)(uintptr_t)V_lds + v_rd_base(lane);
    const TIn* Kh = cur.K; const TIn* Vh = cur.V;
#define RESC(a) do { if (__any((a) < 1.f)) { if (hi == 0) al_l[r32] = (a); asm volatile("s_waitcnt lgkmcnt(0)" ::: "memory");              \
                     for (int d_ = 0; d_ < 4; ++d_) for (int r = 0; r < 16; ++r) o[d_][r] *= al_l[crow(r, hi)]; } } while (0)
#define KBASE(t) ((j_lo + (t)) * KVBLK)
#define ACT(t) (KBASE(t) <= qlo + QBLK - 1 && KBASE(t) + KVBLK - 1 >= qlo - W + 1)
#define MASKT(P0_, P1_, t) do { const int kb_ = KBASE(t); if ((!SK || ACT(t)) && (kb_ + KVBLK - 1 > qlo || kb_ <= qlo + QBLK - 1 - W)) mask_tile(P0_, P1_, qm - kb_, (unsigned)W); } while (0)
    constexpr int NQL = F32 ? 16 : 8;
    constexpr bool SK = WSKIP && !F32;
#define SEAM_K0() do { VMWN(NQL); if constexpr (F32) { SWRITE_KF(0); SBAR(); SLOAD_F((const float*)nxt.V, kbn); } else { SWRITE_HK(0); } SBAR(); } while (0)
    f32x16 pA0, pA1, pB0, pB1; float mnA, mnB, alA, alB; bf16x8 pa0, pa1, pa2, pa3;
    if constexpr (F32) { VMW(); SWRITE_VF(0); SBAR(); } else { SWRITE_HV(0); SBAR(); }
    if (NT > 1) { if constexpr (F32) SLOAD_F((const float*)Kh, KBASE(1)); else SLOAD_H(Kh, Vh, KBASE(1)); }
    SBAR(); qkt<0, SK>(pA0, pA1, K_lds, r32, hi, S.qr, ACT(0));
    if constexpr (F32) { if (NT > 1) { VMW(); SWRITE_KF(1); SBAR(); SLOAD_F((const float*)Vh, KBASE(1)); } }
    MASKT(pA0, pA1, 0); partialSM(pA0, pA1, m_reg, mnA, alA);
    if (NT > 1) { VMW(); if constexpr (F32) { SWRITE_VF(1); SBAR(); if (NT > 2) SLOAD_F((const float*)Kh, KBASE(2)); } else SWRITE_H(1); }
    __syncthreads();
#define HALF_STEP(PX0, PX1, mnX, alX, PY0, PY1, alY, t, KB, VB, SB) do {                                                      \
        SBAR(); qkt<KB, SK>(PX0, PX1, K_lds, r32, hi, S.qr, ACT(t));                                             \
        finishSM(PY0, PY1, alY, l_reg, pa0, pa1, pa2, pa3); SBAR();                                                           \
        if ((t) + 1 < NT) { if constexpr (F32) { VMW(); SWRITE_KF(SB); SBAR(); SLOAD_F((const float*)Vh, KBASE((t) + 1)); }  \
                            else { SLOAD_H(Kh, Vh, KBASE((t) + 1)); } SBAR(); }                                               \
        pv_tile<VB, SK>(o, vb0, pa0, pa1, pa2, pa3, ACT((t) - 1)); MASKT(PX0, PX1, (t)); partialSM(PX0, PX1, m_reg, mnX, alX);                                        \
        __syncthreads();                                                                                                      \
        if ((t) + 1 < NT) { VMW(); if constexpr (F32) { SWRITE_VF(SB); SBAR(); if ((t) + 2 < NT) SLOAD_F((const float*)Kh, KBASE((t) + 2)); } \
                            else { SWRITE_H(SB); } }                                                                          \
        RESC(alX); __syncthreads(); } while (0)
    for (int t = 1; t + 1 < NT; t += 2) {
        HALF_STEP(pB0, pB1, mnB, alB, pA0, pA1, alA, t, 1, 0, 0);
        HALF_STEP(pA0, pA1, mnA, alA, pB0, pB1, alB, t + 1, 0, 1, 1);
    }
    const bool even = (NT & 1) == 0;
    if (even) { SBAR(); qkt<1, SK>(pB0, pB1, K_lds, r32, hi, S.qr, ACT(NT - 1)); SBAR(); }
#define QROW(e) (nxt.Q + (size_t)(wid * QBLK + r32) * D + ((e) >> 1) * 16 + hi * 8 + ((e) & 1) * 4)
    if constexpr (F32) { SLOAD_F((const float*)nxt.K, kbn); SBAR();
#pragma unroll
        for (int e = 0; e < 8; ++e) S.tq[e] = *(const f32x4*)QROW(e); }
    else { SLOAD_H(nxt.K, nxt.V, kbn); SBAR();
#pragma unroll
        for (int d0 = 0; d0 < 8; ++d0) S.qr[d0] = load8<TIn>(nxt.Q + (size_t)(wid * QBLK + r32) * D + d0 * 16 + hi * 8); }
    SBAR();
    finishSM(pA0, pA1, alA, l_reg, pa0, pa1, pa2, pa3); SBAR();
    if constexpr (F32) {
#pragma unroll
        for (int e = 8; e < 16; ++e) S.tq[e] = *(const f32x4*)QROW(e); SBAR(); }
#undef QROW
    pv_tile<0, SK>(o, vb0, pa0, pa1, pa2, pa3, ACT(even ? NT - 2 : NT - 1));
    if (even) { MASKT(pB0, pB1, NT - 1); partialSM(pB0, pB1, m_reg, mnB, alB); __syncthreads(); RESC(alB);
        finishSM(pB0, pB1, alB, l_reg, pa0, pa1, pa2, pa3); SBAR(); pv_tile<1, SK>(o, vb0, pa0, pa1, pa2, pa3, ACT(NT - 1)); }
    SBAR(); SEAM_K0();
    if (hi == 0) li_l[r32] = l_reg; asm volatile("s_waitcnt lgkmcnt(0)" ::: "memory");
    float rli[16];
#pragma unroll
    for (int r = 0; r < 16; ++r) rli[r] = __builtin_amdgcn_rcpf(li_l[crow(r, hi)]);
    TOut* Ow = cur.O + (size_t)(wid * QBLK) * D;
#pragma unroll
    for (int r = 0; r < 16; ++r) { const int orow = crow(r, hi);
#pragma unroll
        for (int d0 = 0; d0 < 4; ++d0) { const float v = o[d0][r] * rli[r];
            if constexpr (same_t<TOut, float>::v) { Ow[(size_t)orow * D + d0 * 32 + r32] = v; }
            else { const float vn = __shfl_xor(v, 1);
                   if ((r32 & 1) == 0) *(unsigned*)(Ow + (size_t)orow * D + d0 * 32 + r32) = cvtpk(v, vn); } } }
    if constexpr (F32) {
#pragma unroll
        for (int d0 = 0; d0 < 8; ++d0) S.qr[d0] = pack8(S.tq[2 * d0], S.tq[2 * d0 + 1]); }
    __syncthreads();
#undef RESC
#undef KBASE
#undef ACT
#undef MASKT
#undef SEAM_K0
#undef HALF_STEP
}
#undef ROW
#undef VMW
#undef VMWN
#undef SLOAD_H
#undef SWRITE_HK
#undef SWRITE_HV
#undef SWRITE_H
#undef SLOAD_F
#undef SWRITE_KF
#undef SWRITE_VF
}
namespace att {
#define A2_LAS __attribute__((address_space(3)))
struct Blk2 { const bf16* Q; const bf16* K; const bf16* V0; const bf16* V1; bf16* O0; bf16* O1; int P0; float* stash; bf16* comb; float lam; };
template <int EPI>
__device__ __forceinline__ void attn_block_v256(const Blk2& c, char* lds) {
    const int tid = threadIdx.x, wid = __builtin_amdgcn_readfirstlane(tid >> 6), lane = tid & 63, r32 = lane & 31, hi = lane >> 5;
    const int NT = c.P0 / KVBLK + 4;
    const int qlo = c.P0 + wid * QBLK, qm = qlo + r32 - 4 * hi;
    char* K_lds = lds; char* V_lds = lds + 2 * SHM_K;
    float* wsf = (float*)(lds + 4 * SHM_V + 2 * SHM_K) + wid * 64; float* li_l = wsf; float* al_l = wsf + 32;
    const int vb0 = (int)(uintptr_t)V_lds + v_rd_base(lane);
    const char* kbs[4];
#pragma unroll
    for (int dd = 0; dd < 4; ++dd) kbs[dd] = K_lds + KSWZ(r32, (dd * 16 + hi * 8) * 2);
    unsigned koff[2];
#pragma unroll
    for (int j = 0; j < 2; ++j) { const int q = (2 * wid + j) * 64 + lane, row = q >> 4, slot = q & 15; koff[j] = (unsigned)(row * 256 + ((slot ^ (row & 7)) << 4)); }
    unsigned voff;
    { const int kk = 8 * wid + ((lane & 31) >> 2), k = (kk & ~0xC) | ((kk & 4) << 1) | ((kk & 8) >> 1); voff = (unsigned)(k * 256 + (lane >> 5) * 64 + (lane & 3) * 16); }
    bf16x8 qr[8];
#pragma unroll
    for (int d0 = 0; d0 < 8; ++d0) qr[d0] = load8<bf16>(c.Q + (size_t)(wid * QBLK + r32) * D + d0 * 16 + hi * 8);
#define A2_DMA(gp, lp) __builtin_amdgcn_global_load_lds((const unsigned*)(gp), (A2_LAS unsigned*)(lp), 16, 0, 0)
#define A2_STAGE(k0, bf) do { const char* kp_ = (const char*)c.K + (size_t)(k0) * (D * 2); const char* v0_ = (const char*)c.V0 + (size_t)(k0) * (D * 2); const char* v1_ = (const char*)c.V1 + (size_t)(k0) * (D * 2); \
        char* kl_ = K_lds + (bf) * SHM_K + wid * 2048; char* vl_ = V_lds + (bf) * (2 * SHM_V) + wid * 2048; \
        A2_DMA(kp_ + koff[0], kl_); A2_DMA(kp_ + koff[1], kl_ + 1024); \
        A2_DMA(v0_ + voff, vl_); A2_DMA(v0_ + voff + 128, vl_ + 1024); A2_DMA(v1_ + voff, vl_ + SHM_V); A2_DMA(v1_ + voff + 128, vl_ + SHM_V + 1024); } while (0)
#define A2_VMW() asm volatile("s_waitcnt vmcnt(0)" ::: "memory")
#define A2_RESC(a) do { if (__any((a) < 1.f)) { if (hi == 0) al_l[r32] = (a); asm volatile("s_waitcnt lgkmcnt(0)" ::: "memory"); \
                        for (int d_ = 0; d_ < 8; ++d_) for (int r = 0; r < 16; ++r) o[d_][r] *= al_l[crow(r, hi)]; } } while (0)
    A2_STAGE(0, 0); A2_VMW();
    __syncthreads();
    float m_reg = -1e30f, l_reg = 0.f; f32x16 o[8] = {};
    f32x16 p0, p1; float mn, alpha; bf16x8 pa0, pa1, pa2, pa3;
#define A2_QKT(KB) do { p0 = f32x16{}; p1 = f32x16{}; _Pragma("unroll") for (int d0 = 0; d0 < 8; ++d0) { const char* a_ = kbs[d0 & 3] + (KB) * SHM_K + (d0 >> 2) * 128; \
        const bf16x8 b0_ = *reinterpret_cast<const bf16x8*>(a_); const bf16x8 b1_ = *reinterpret_cast<const bf16x8*>(a_ + 32 * 256); \
        p0 = __builtin_amdgcn_mfma_f32_32x32x16_bf16(b0_, qr[d0], p0, 0, 0, 0); p1 = __builtin_amdgcn_mfma_f32_32x32x16_bf16(b1_, qr[d0], p1, 0, 0, 0); } } while (0)
#define A2_STEP(t, BUF) do { \
        if ((t) + 1 < NT) { A2_STAGE(((t) + 1) * KVBLK, (BUF) ^ 1); } \
        if ((t) * KVBLK <= qlo + QBLK - 1) {     \
        SBAR(); A2_QKT(BUF); SBAR(); \
        { const int kb_ = (t) * KVBLK; if (kb_ + KVBLK - 1 > qlo) mask_tile(p0, p1, qm - kb_, (unsigned)0x40000000); } \
        partialSM(p0, p1, m_reg, mn, alpha); \
        finishSM(p0, p1, alpha, l_reg, pa0, pa1, pa2, pa3); SBAR(); \
        A2_RESC(alpha); \
        pv_tile<0, false>(o, vb0 + (BUF) * (2 * SHM_V), pa0, pa1, pa2, pa3, true); \
        pv_tile<1, false>(o + 4, vb0 + (BUF) * (2 * SHM_V), pa0, pa1, pa2, pa3, true); } \
        A2_VMW(); __syncthreads(); } while (0)
    for (int t = 0; t < NT; t += 2) { A2_STEP(t, 0); A2_STEP(t + 1, 1); }
    if (hi == 0) li_l[r32] = l_reg; asm volatile("s_waitcnt lgkmcnt(0)" ::: "memory");
    if (EPI == 0) {
    float rli[16];
#pragma unroll
    for (int r = 0; r < 16; ++r) rli[r] = __builtin_amdgcn_rcpf(li_l[crow(r, hi)]);
#pragma unroll
    for (int r = 0; r < 16; ++r) { const int orow = wid * QBLK + crow(r, hi);
#pragma unroll
        for (int d0 = 0; d0 < 8; ++d0) { const float v = o[d0][r] * rli[r]; const float vn = __shfl_xor(v, 1);
            bf16* Ob = (d0 < 4) ? c.O0 : c.O1;
            if ((r32 & 1) == 0) *(unsigned*)(Ob + (size_t)orow * D + (d0 & 3) * 32 + r32) = cvtpk(v, vn); } }
    } else if (EPI == 1) {
        int tid1 = threadIdx.x; asm volatile("" : "+v"(tid1)); const unsigned toff1 = (unsigned)tid1 * 16u;
#pragma unroll
        for (int qq = 0; qq < 2; ++qq) {
            float rl[8];
#pragma unroll
            for (int j = 0; j < 8; ++j) rl[j] = __builtin_amdgcn_rcpf(li_l[crow(8 * qq + j, hi)]);
#pragma unroll
            for (int d0 = 0; d0 < 8; ++d0) { char* sbs = (char*)c.stash + (size_t)(d0 * 2 + qq) * 8192; u32x4 w;
                w.x = cvtpk(o[d0][8 * qq + 0] * rl[0], o[d0][8 * qq + 1] * rl[1]); w.y = cvtpk(o[d0][8 * qq + 2] * rl[2], o[d0][8 * qq + 3] * rl[3]);
                w.z = cvtpk(o[d0][8 * qq + 4] * rl[4], o[d0][8 * qq + 5] * rl[5]); w.w = cvtpk(o[d0][8 * qq + 6] * rl[6], o[d0][8 * qq + 7] * rl[7]);
                *(u32x4*)(sbs + toff1) = w; }
        }
    } else {
        int tid2 = threadIdx.x; asm volatile("" : "+v"(tid2));
        const int lane2 = tid2 & 63;
        char* tl = lds + 2 * SHM_K + (tid2 >> 6) * 8192;
#pragma unroll
        for (int qq = 0; qq < 2; ++qq) {
            u32x4 sv[8];
#pragma unroll
            for (int d0 = 0; d0 < 8; ++d0) { const char* sbs = (const char*)c.stash + (size_t)(d0 * 2 + qq) * 8192; sv[d0] = *(const u32x4*)(sbs + (unsigned)tid2 * 16u); }
#pragma unroll
            for (int j = 0; j < 8; ++j) { const int r = 8 * qq + j;
                const float rl = c.lam * __builtin_amdgcn_rcpf(li_l[crow(r, hi)]);
                float dv[8]; float ss = 0.f;
#pragma unroll
                for (int d0 = 0; d0 < 8; ++d0) { const unsigned wv = sv[d0][j >> 1]; const float s0 = (j & 1) ? __uint_as_float(wv & 0xffff0000u) : __uint_as_float(wv << 16);
                    dv[d0] = s0 - o[d0][r] * rl; ss += dv[d0] * dv[d0]; }
                ss += __shfl_xor(ss, 1); ss += __shfl_xor(ss, 2); ss += __shfl_xor(ss, 4); ss += __shfl_xor(ss, 8); ss += __shfl_xor(ss, 16);
                const float rs = rsqrtf(ss * (1.f / 256.f) + 1e-6f);
                const int lrow = crow(r, hi) - 16 * qq;
#pragma unroll
                for (int d0 = 0; d0 < 8; ++d0) *(unsigned short*)(tl + lrow * 512 + (d0 * 32 + (lane2 & 31)) * 2) = (unsigned short)cvtpk(dv[d0] * rs, 0.f); }
            {
                asm volatile("s_waitcnt lgkmcnt(0)" ::: "memory");
                const unsigned loff = (unsigned)((lane2 >> 5) * 4096 + (lane2 & 31) * 16);
#pragma unroll
                for (int it = 0; it < 8; ++it) {
                    const u32x4 w = *(const u32x4*)(tl + (lane2 >> 5) * 512 + (lane2 & 31) * 16 + it * 1024);
                    char* ob = (char*)c.comb + (size_t)(wid * QBLK + 16 * qq + 2 * it) * 4096;
                    *(u32x4*)(ob + loff) = w; }
                asm volatile("s_waitcnt lgkmcnt(0)" ::: "memory");
            }
        }
    }
    __syncthreads();
#undef A2_VMW
#undef A2_DMA
#undef A2_STAGE
#undef A2_RESC
#undef A2_STEP
#undef A2_QKT
}
}

#define XB_TMO      128
#define XB_XCNT(j)  (256  + 64 * (j))
#define XB_XSUB(j)  (1280 + 64 * (j))
#define XB_XGEN(j)  (2304 + 64 * (j))
#define XB_TOP      3328
#define XB_TOPGEN   3392
#define XCD_BAR_WORDS 3456
#define XB_SPIN_CAP (1u << 18)
#define LAS __attribute__((address_space(3)))

__device__ __forceinline__ unsigned xb_ld(unsigned* p)              { return __hip_atomic_load(p, __ATOMIC_RELAXED, __HIP_MEMORY_SCOPE_AGENT); }
__device__ __forceinline__ unsigned xb_add(unsigned* p, unsigned v) { return __hip_atomic_fetch_add(p, v, __ATOMIC_RELAXED, __HIP_MEMORY_SCOPE_AGENT); }
__device__ __forceinline__ unsigned xb_xcc_id() { return (unsigned)__builtin_amdgcn_s_getreg((3 << 11) | 20) & 0xFu; }
#define XB_SPIN(cond, bar) do { unsigned _sp = 0; while (cond) { __builtin_amdgcn_s_sleep(1); \
    if ((++_sp & 255u) == 0u) { if (xb_ld(&(bar)[XB_TMO])) break; if (_sp > XB_SPIN_CAP) { atomicAdd(&(bar)[XB_TMO], 1u); break; } } } } while (0)

struct XcdBarrier {
    unsigned* bar; unsigned x;
    volatile LAS unsigned* st;
};

__device__ __forceinline__ XcdBarrier xcd_barrier_post(unsigned* bar, volatile LAS unsigned* st) {
    XcdBarrier b; b.bar = bar; b.x = xb_xcc_id(); b.st = st;
    if (threadIdx.x == 0) (void)xb_add(&bar[XB_XCNT(b.x)], 1u);
    return b;
}
__device__ __forceinline__ void xcd_barrier_complete(unsigned* bar, unsigned x, unsigned& nloc, unsigned& nx) {
    const unsigned G = gridDim.x * gridDim.y * gridDim.z;
    unsigned sum, cnt, mine, sp = 0u;
    for (;;) {
        sum = 0u; cnt = 0u; mine = 0u;
#pragma unroll
        for (unsigned j = 0; j < 16; ++j) { const unsigned c = xb_ld(&bar[XB_XCNT(j)]); sum += c; cnt += (c > 0u) ? 1u : 0u; mine = (j == x) ? c : mine; }
        if (sum == G) break;
        __builtin_amdgcn_s_sleep(1);
        if ((++sp & 255u) == 0u) { if (xb_ld(&bar[XB_TMO])) break; if (sp > XB_SPIN_CAP) { atomicAdd(&bar[XB_TMO], 1u); break; } }
    }
    nloc = mine > 0u ? mine : 1u; nx = cnt > 0u ? cnt : 1u;
}

__device__ __forceinline__ void xcd_barrier(const XcdBarrier& b) {
    asm volatile("s_waitcnt vmcnt(0)" ::: "memory");
    __syncthreads();
    if (threadIdx.x == 0) {
        unsigned* bar = b.bar;
        __builtin_amdgcn_s_waitcnt(0);
        unsigned nloc = b.st[0], nx = b.st[1];
        if (nloc == 0u) { xcd_barrier_complete(bar, b.x, nloc, nx); b.st[0] = nloc; b.st[1] = nx; }
        const unsigned old = xb_add(&bar[XB_XSUB(b.x)], 1u);
        const unsigned gen = old / nloc;
        if (old + 1u == (gen + 1u) * nloc) {
            __builtin_amdgcn_fence(__ATOMIC_RELEASE, "agent");
            asm volatile("s_waitcnt vmcnt(0)" ::: "memory");
            const unsigned og = xb_add(&bar[XB_TOP], 1u);
            const unsigned tg = og / nx;
            if (og + 1u == (tg + 1u) * nx) xb_add(&bar[XB_TOPGEN], 1u);
            else XB_SPIN(xb_ld(&bar[XB_TOPGEN]) == tg, bar);
            __builtin_amdgcn_fence(__ATOMIC_ACQUIRE, "agent");
            xb_add(&bar[XB_XGEN(b.x)], 1u);
            asm volatile("s_waitcnt vmcnt(0)" ::: "memory");
        } else {
            XB_SPIN(xb_ld(&bar[XB_XGEN(b.x)]) == gen, bar);
            __builtin_amdgcn_fence(__ATOMIC_ACQUIRE, "agent");
            asm volatile("s_waitcnt vmcnt(0)" ::: "memory");
        }
    }
    __syncthreads();
}

#undef LAS

namespace cg = cooperative_groups;
#ifndef REP_GEMM
#define REP_GEMM 1
#endif
#ifndef REP_GU
#define REP_GU REP_GEMM
#endif
#ifndef REP_DN
#define REP_DN REP_GEMM
#endif
#ifndef REP_P3
#define REP_P3 1
#endif
#ifndef REP_ATT
#define REP_ATT 1
#endif
#ifndef REP_CONV
#define REP_CONV 1
#endif
typedef unsigned short u16;
typedef float f32x4v __attribute__((ext_vector_type(4)));
typedef unsigned u32x4v __attribute__((ext_vector_type(4)));
typedef unsigned u32x2v __attribute__((ext_vector_type(2)));

constexpr int T_TOK = 16384, DM = 2048, DFF = 5632, SEQ = 4096, NBATCH = 4;
constexpr float EPS = 1e-6f;
constexpr float LAMBDA_INIT = 0.35550906759096934f;
constexpr size_t MiB = (size_t)1 << 20;
constexpr size_t WS_WPOOL = 0, WS_WGU = 2 * MiB, WS_WDN = 46 * MiB, WS_WQKV = 68 * MiB, WS_WO = 92 * MiB, WS_MISC = 100 * MiB,
                 WS_A = 101 * MiB, WS_B = 293 * MiB, WS_C = 357 * MiB, WS_END = 485 * MiB;
constexpr size_t MISC_RSTD = 0, MISC_COS = 64 * 1024, MISC_SIN = 320 * 1024, MISC_BAR = 640 * 1024, BAR_BYTES = 16 * 1024, MISC_RSTDX = 704 * 1024;
constexpr int LDS_TOTAL = 131072;
constexpr int NPHASE = 14;

struct Params {
    const float* x; const float* norm_mix_pre; const float* norm_mix_post; const float* norm_ffn_pre; const float* norm_ffn_post;
    const float* w_pool; const float* pool_scale; const float* kv_norm; const float* w_kv; const float* w_q;
    const float* lq1; const float* lk1; const float* lq2; const float* lk2; const float* subln; const float* w_o;
    const float* w_gate; const float* w_up; const float* w_down;
    float* out; unsigned char* ws;
    int ph_lo, ph_hi;
};

__device__ __forceinline__ unsigned pk_bf16(float lo, float hi) { unsigned r; asm volatile("v_cvt_pk_bf16_f32 %0, %1, %2" : "=v"(r) : "v"(lo), "v"(hi)); return r; }
__device__ __forceinline__ float bf_lo(unsigned w) { return __uint_as_float(w << 16); }
__device__ __forceinline__ float bf_hi(unsigned w) { return __uint_as_float(w & 0xffff0000u); }
__device__ __forceinline__ float wave_sum(float v) {
#pragma unroll
    for (int o = 32; o >= 1; o >>= 1) v += __shfl_xor(v, o);
    return v;
}

struct ConvJob { const float* src; int ld; int c0; int k0; const float* rgain; int rmask; const float* cgain; float scal; u16* dst; int Kdst; };

__device__ __forceinline__ void conv_load(const ConvJob& j, float (&v)[32]) {
    const int tid = threadIdx.x, w = tid >> 6, lane = tid & 63;
    const float* sp = j.src + (size_t)(j.k0 + w * 16) * j.ld + j.c0 + lane;
#pragma unroll
    for (int q = 0; q < 32; ++q) v[q] = __builtin_nontemporal_load(sp + (size_t)(q >> 1) * j.ld + (q & 1) * 64);
}
__device__ __forceinline__ void conv_store(const ConvJob& j, const float (&v)[32], unsigned char* lds) {
    const int tid = threadIdx.x, w = tid >> 6, lane = tid & 63;
    float cg0 = j.scal, cg1 = j.scal;
    if (j.cgain) { cg0 *= j.cgain[j.c0 + lane]; cg1 *= j.cgain[j.c0 + 64 + lane]; }
#pragma unroll
    for (int q = 0; q < 32; ++q) {
        const int kl = w * 16 + (q >> 1), n = (q & 1) * 64 + lane;
        float s = (q & 1) ? cg1 : cg0;
        if (j.rgain) s *= j.rgain[(j.k0 + kl) & j.rmask];
        const unsigned b = pk_bf16(v[q] * s, 0.f);
        *(u16*)(lds + n * 260 + kl * 2) = (u16)b;
    }
    __syncthreads();
#pragma unroll
    for (int i = 0; i < 4; ++i) {
        const int id = tid + 512 * i, n = id >> 4, c = id & 15;
        const unsigned* lp = (const unsigned*)(lds + n * 260 + c * 16);
        u32x4v o; o.x = lp[0]; o.y = lp[1]; o.z = lp[2]; o.w = lp[3];
        *(u32x4v*)(j.dst + (size_t)n * j.Kdst + j.k0 + c * 8) = o;
    }
    __syncthreads();
}

__device__ __forceinline__ ConvJob conv_ffn_job(const Params& p, int l, int t) {
    ConvJob j; j.rmask = -1; j.cgain = nullptr; j.scal = 1.f;
    if (t < 1408) { const int nb = t % 88, kt = t / 88, pn = nb >> 1, which = nb & 1;
        j.src = (which ? p.w_up : p.w_gate) + (size_t)l * DM * DFF; j.ld = DFF; j.c0 = pn * 128; j.k0 = kt * 128; j.rgain = p.norm_ffn_pre + l * DM;
        j.dst = (u16*)(p.ws + WS_WGU) + (size_t)nb * 128 * DM; j.Kdst = DM; }
    else { t -= 1408; const int nb = t % 16, kt = t / 16;
        j.src = p.w_down + (size_t)l * DFF * DM; j.ld = DM; j.c0 = nb * 128; j.k0 = kt * 128; j.rgain = nullptr;
        j.dst = (u16*)(p.ws + WS_WDN) + (size_t)nb * 128 * DFF; j.Kdst = DFF; }
    return j;
}
__device__ __forceinline__ ConvJob conv_misc_job(const Params& p, int t) {
    ConvJob j; j.rmask = -1; j.cgain = nullptr; j.scal = 1.f;
    if (t < 64) { const int g = t >> 4, r = t & 15, nt = r & 3, kt = r >> 2;
        j.src = p.w_pool + (size_t)g * 512 * 512; j.ld = 512; j.c0 = nt * 128; j.k0 = kt * 128; j.rgain = p.norm_mix_pre + g * 512; j.cgain = p.pool_scale + g * 512;
        j.dst = (u16*)(p.ws + WS_WPOOL) + (size_t)(g * 512 + nt * 128) * 512; j.Kdst = 512; }
    else if (t < 64 + 768) { t -= 64; const int nb = t % 48, kt = t / 48;
        if (nb < 32) { j.src = p.w_kv; j.ld = 2 * DM; j.c0 = nb * 128; j.rgain = p.kv_norm; }
        else { j.src = p.w_q; j.ld = DM; j.c0 = (nb - 32) * 128; j.rgain = p.norm_mix_pre + DM; }
        j.k0 = kt * 128; j.dst = (u16*)(p.ws + WS_WQKV) + (size_t)nb * 128 * DM; j.Kdst = DM; }
    else { t -= 64 + 768; const int nb = t % 16, kt = t / 16;
        j.src = p.w_o; j.ld = DM; j.c0 = nb * 128; j.k0 = kt * 128; j.rgain = p.subln; j.rmask = 255; j.scal = 1.f - LAMBDA_INIT;
        j.dst = (u16*)(p.ws + WS_WO) + (size_t)nb * 128 * DM; j.Kdst = DM; }
    return j;
}
template <int WHICH>
__device__ __forceinline__ ConvJob conv_job(const Params& p, int t) {
    if (WHICH == 0) { const int tm = t % (2112 + 1088); return tm < 2112 ? conv_ffn_job(p, 0, tm) : conv_misc_job(p, tm - 2112); }
    return conv_ffn_job(p, 1, t);
}
template <int WHICH>
__device__ __forceinline__ void conv_loop(const Params& p, int n, unsigned char* lds) {
    const int G = (int)gridDim.x; int t = (int)blockIdx.x; if (t >= n) return;
    ConvJob j = conv_job<WHICH>(p, t); float v[32]; conv_load(j, v);
    for (;;) {
        const int tn = t + G; const bool more = tn < n;
        ConvJob jn = j; float vn[32];
        if (more) { jn = conv_job<WHICH>(p, tn); conv_load(jn, vn); }
        conv_store(j, v, lds);
        if (!more) break;
        j = jn; t = tn;
#pragma unroll
        for (int q = 0; q < 32; ++q) v[q] = vn[q];
    }
}

__device__ const float ROPE_INV[16] = {1.000000000e+00f, 4.403665960e-01f, 1.939227432e-01f, 8.539710194e-02f, 3.760603070e-02f, 1.656044088e-02f, 7.292664610e-03f, 3.211446106e-03f,
                                        1.414213562e-03f, 6.227724371e-04f, 2.742481884e-04f, 1.207697351e-04f, 5.318295734e-05f, 2.341999971e-05f, 1.031338525e-05f, 4.541670478e-06f};
__device__ __forceinline__ void rope_entry(int e, float* cosT, float* sinT) {
    constexpr double I2PI = 0.15915494309189535;
    constexpr float HI = (float)I2PI, LO = (float)(I2PI - (double)HI);
    const int s = e >> 4, i = e & 15;
    const float ang = (float)s * ROPE_INV[i];
    const float pr = ang * HI;
    float er = fmaf(ang, HI, -pr); er = fmaf(ang, LO, er);
    const float fr = (pr - rintf(pr)) + er;
    cosT[e] = __builtin_amdgcn_cosf(fr); sinT[e] = __builtin_amdgcn_sinf(fr);
}

__device__ __forceinline__ void rstd_rows(const float* __restrict__ x, float* __restrict__ rstd) {
    const int lane = threadIdx.x & 63, gw = blockIdx.x * 8 + (threadIdx.x >> 6), nw = gridDim.x * 8;
    for (int row0 = gw * 4; row0 < T_TOK; row0 += nw * 4) {
        f32x4v v[4][8];
#pragma unroll
        for (int r = 0; r < 4; ++r) { const f32x4v* rp = (const f32x4v*)(x + (size_t)(row0 + r) * DM);
#pragma unroll
            for (int i = 0; i < 8; ++i) v[r][i] = rp[lane + 64 * i]; }
        float ss[4];
#pragma unroll
        for (int r = 0; r < 4; ++r) { float s = 0.f;
#pragma unroll
            for (int i = 0; i < 8; ++i) s += v[r][i].x * v[r][i].x + v[r][i].y * v[r][i].y + v[r][i].z * v[r][i].z + v[r][i].w * v[r][i].w;
            ss[r] = s; }
#pragma unroll
        for (int o = 32; o >= 1; o >>= 1) {
#pragma unroll
            for (int r = 0; r < 4; ++r) ss[r] += __shfl_xor(ss[r], o); }
        if (lane < 4) { const float s = lane == 0 ? ss[0] : lane == 1 ? ss[1] : lane == 2 ? ss[2] : ss[3]; rstd[row0 + lane] = rsqrtf(s * (1.f / DM) + EPS); }
    }
}

__device__ __forceinline__ void mixed_phase(const float* __restrict__ x, u16* __restrict__ mixed, unsigned char* lds) {
    const int tid = threadIdx.x, g = tid >> 7, w = 2 << g, col = tid * 4, wid = tid >> 6, lane = tid & 63;
    float* rs = (float*)(lds + 40 * 1024);
    for (int ch = blockIdx.x; ch < T_TOK / 64; ch += gridDim.x) {
        const int t0 = ch * 64, pos0 = t0 & (SEQ - 1);
#pragma unroll
        for (int gq = 0; gq < 2; ++gq) {
            f32x4v v[5][8]; const int jr0 = wid * 10 + gq * 5;
#pragma unroll
            for (int r = 0; r < 5; ++r) { const int jr = jr0 + r; const bool ok = pos0 - 16 + jr >= 0; const f32x4v* rp = (const f32x4v*)(x + (size_t)(ok ? t0 - 16 + jr : t0) * DM);
#pragma unroll
                for (int i = 0; i < 8; ++i) v[r][i] = rp[lane + 64 * i]; }
            float ss[5];
#pragma unroll
            for (int r = 0; r < 5; ++r) { float s = 0.f;
#pragma unroll
                for (int i = 0; i < 8; ++i) s += v[r][i].x * v[r][i].x + v[r][i].y * v[r][i].y + v[r][i].z * v[r][i].z + v[r][i].w * v[r][i].w;
                ss[r] = s; }
#pragma unroll
            for (int o = 32; o >= 1; o >>= 1) {
#pragma unroll
                for (int r = 0; r < 5; ++r) ss[r] += __shfl_xor(ss[r], o); }
            if (lane < 5) { const float s = lane == 0 ? ss[0] : lane == 1 ? ss[1] : lane == 2 ? ss[2] : lane == 3 ? ss[3] : ss[4]; rs[jr0 + lane] = rsqrtf(s * (1.f / DM) + EPS); }
        }
        __syncthreads();
        f32x4v S = {0.f, 0.f, 0.f, 0.f};
        for (int jj = 1; jj <= w; ++jj) if (pos0 - jj >= 0) { const f32x4v v = *(const f32x4v*)(x + (size_t)(t0 - jj) * DM + col); S += v * rs[16 - jj]; }
        u16* op = mixed + ((size_t)g * T_TOK + t0) * 512 + (col & 511);
#pragma unroll 8
        for (int i = 0; i < 64; ++i) {
            const int t = t0 + i, pos = pos0 + i;
            const f32x4v vt = *(const f32x4v*)(x + (size_t)t * DM + col) * rs[16 + i];
            S += vt;
            if (pos - w >= 0) { const f32x4v vo = *(const f32x4v*)(x + (size_t)(t - w) * DM + col) * rs[16 + i - w]; S -= vo; }
            const float ic = 1.f / (float)min(pos + 1, w);
            const f32x4v o = S * ic - vt;
            u32x2v pk; pk.x = pk_bf16(o.x, o.y); pk.y = pk_bf16(o.z, o.w);
            *(u32x2v*)(op + (size_t)i * 512) = pk;
        }
        __syncthreads();
    }
}

template <int MODE>
__device__ __forceinline__ void norm_phase(const float* __restrict__ xin, const u16* __restrict__ xprev, const float* __restrict__ rprev, const u16* __restrict__ m, const float* __restrict__ gpost, u16* __restrict__ xn, float* __restrict__ rnew, float* __restrict__ out) {
    constexpr int R = 2;
    const int lane = threadIdx.x & 63, gw = blockIdx.x * 8 + (threadIdx.x >> 6), nw = gridDim.x * 8;
    f32x4v gv[8];
#pragma unroll
    for (int i = 0; i < 4; ++i) { gv[2 * i] = ((const f32x4v*)gpost)[2 * (lane + 64 * i)]; gv[2 * i + 1] = ((const f32x4v*)gpost)[2 * (lane + 64 * i) + 1]; }
    for (int row0 = gw * R; row0 < T_TOK; row0 += nw * R) {
        u32x4v mv[R][4]; u32x4v xh[R][4]; f32x4v xw[(MODE == 0) ? R : 1][8];
#pragma unroll
        for (int r = 0; r < R; ++r) {
            const u32x4v* mp = (const u32x4v*)(m + (size_t)(row0 + r) * DM);
#pragma unroll
            for (int i = 0; i < 4; ++i) mv[r][i] = mp[lane + 64 * i];
            if (MODE == 0) { const f32x4v* xp = (const f32x4v*)(xin + (size_t)(row0 + r) * DM);
#pragma unroll
                for (int i = 0; i < 4; ++i) { xw[r][2 * i] = xp[2 * (lane + 64 * i)]; xw[r][2 * i + 1] = xp[2 * (lane + 64 * i) + 1]; } }
            else { const u32x4v* xp = (const u32x4v*)(xprev + (size_t)(row0 + r) * DM);
#pragma unroll
                for (int i = 0; i < 4; ++i) xh[r][i] = xp[lane + 64 * i]; }
        }
        float ss[R];
#pragma unroll
        for (int r = 0; r < R; ++r) { float s = 0.f;
#pragma unroll
            for (int i = 0; i < 4; ++i) { const u32x4v a = mv[r][i];
                const float f0 = bf_lo(a.x), f1 = bf_hi(a.x), f2 = bf_lo(a.y), f3 = bf_hi(a.y), f4 = bf_lo(a.z), f5 = bf_hi(a.z), f6 = bf_lo(a.w), f7 = bf_hi(a.w);
                s += f0 * f0 + f1 * f1 + f2 * f2 + f3 * f3 + f4 * f4 + f5 * f5 + f6 * f6 + f7 * f7; }
            ss[r] = s; }
#pragma unroll
        for (int o = 32; o >= 1; o >>= 1) {
#pragma unroll
            for (int r = 0; r < R; ++r) ss[r] += __shfl_xor(ss[r], o); }
#pragma unroll
        for (int r = 0; r < R; ++r) {
            const float rs = rsqrtf(ss[r] * (1.f / DM) + EPS);
            const float inv = (MODE == 0) ? 1.f : 1.f / rprev[row0 + r];
            f32x4v xv[8]; float sxr = 0.f;
#pragma unroll
            for (int i = 0; i < 4; ++i) {
                const u32x4v a = mv[r][i];
                f32x4v x0, x1;
                if (MODE == 0) { x0 = xw[r][2 * i]; x1 = xw[r][2 * i + 1]; }
                else { const u32x4v b = xh[r][i]; x0 = (f32x4v){bf_lo(b.x), bf_hi(b.x), bf_lo(b.y), bf_hi(b.y)} * inv; x1 = (f32x4v){bf_lo(b.z), bf_hi(b.z), bf_lo(b.w), bf_hi(b.w)} * inv; }
                x0 += (f32x4v){bf_lo(a.x), bf_hi(a.x), bf_lo(a.y), bf_hi(a.y)} * rs * gv[2 * i];
                x1 += (f32x4v){bf_lo(a.z), bf_hi(a.z), bf_lo(a.w), bf_hi(a.w)} * rs * gv[2 * i + 1];
                if (MODE == 2) { f32x4v* op = (f32x4v*)(out + (size_t)(row0 + r) * DM); op[2 * (lane + 64 * i)] = x0; op[2 * (lane + 64 * i) + 1] = x1; }
                else { xv[2 * i] = x0; xv[2 * i + 1] = x1;
                    sxr += x0.x * x0.x + x0.y * x0.y + x0.z * x0.z + x0.w * x0.w + x1.x * x1.x + x1.y * x1.y + x1.z * x1.z + x1.w * x1.w; }
            }
            if (MODE != 2) {
                sxr = wave_sum(sxr);
                const float rx = rsqrtf(sxr * (1.f / DM) + EPS);
                if (lane == 0) rnew[row0 + r] = rx;
#pragma unroll
                for (int i = 0; i < 4; ++i) { const f32x4v a = xv[2 * i] * rx, b = xv[2 * i + 1] * rx; u32x4v o;
                    o.x = pk_bf16(a.x, a.y); o.y = pk_bf16(a.z, a.w); o.z = pk_bf16(b.x, b.y); o.w = pk_bf16(b.z, b.w);
                    ((u32x4v*)(xn + (size_t)(row0 + r) * DM))[lane + 64 * i] = o; }
            }
        }
    }
}

__device__ __forceinline__ void comb_phase(const Params& p, const u16* osub, u16* attn_out) {
    const int lane = threadIdx.x & 63, gw = blockIdx.x * 8 + (threadIdx.x >> 6), nw = gridDim.x * 8;
    float d1 = p.lq1[lane] * p.lk1[lane] + p.lq1[lane + 64] * p.lk1[lane + 64];
    float d2 = p.lq2[lane] * p.lk2[lane] + p.lq2[lane + 64] * p.lk2[lane + 64];
    d1 = wave_sum(d1); d2 = wave_sum(d2);
    const float lam = __expf(d1) - __expf(d2) + LAMBDA_INIT;
    const int half = lane >> 5, dd = (lane & 31) * 4;
    for (int it = gw; it < T_TOK * 8; it += nw) {
        const int h = it & 7, t = it >> 3, b = t >> 12, s = t & (SEQ - 1);
        const u16* r0 = osub + (((size_t)(b * 32 + (2 * h) * 2 + half)) * SEQ + s) * 128 + dd;
        const u16* r1 = osub + (((size_t)(b * 32 + (2 * h + 1) * 2 + half)) * SEQ + s) * 128 + dd;
        const u32x2v a = *(const u32x2v*)r0, c = *(const u32x2v*)r1;
        const float o0 = bf_lo(a.x) - lam * bf_lo(c.x), o1 = bf_hi(a.x) - lam * bf_hi(c.x), o2 = bf_lo(a.y) - lam * bf_lo(c.y), o3 = bf_hi(a.y) - lam * bf_hi(c.y);
        float ss = o0 * o0 + o1 * o1 + o2 * o2 + o3 * o3;
        ss = wave_sum(ss);
        const float rs = rsqrtf(ss * (1.f / 256.f) + EPS);
        u32x2v o; o.x = pk_bf16(o0 * rs, o1 * rs); o.y = pk_bf16(o2 * rs, o3 * rs);
        *(u32x2v*)(attn_out + (size_t)t * DM + h * 256 + half * 128 + dd) = o;
    }
}

struct EpiPlain {
    static constexpr bool PERM = true, AFTER_DRAIN = false;
    u16* O; int ldc; int pool;
    __device__ __forceinline__ void operator()(const pg8::f32x4 (&acc)[2][2][4][2], const pg8::Unit& u, int wr, int wc, int fr, int fq) const {
        const int pm = pool ? (u.pm & 63) : u.pm;
        const int row0 = pm * 256 + wr * 64 + fr, col0 = u.pn * 256 + wc * 32 + 8 * fq;
#pragma unroll
        for (int ai = 0; ai < 2; ++ai)
#pragma unroll
            for (int m = 0; m < 4; ++m) { u16* rowp = O + (size_t)(row0 + ai * 128 + m * 16) * ldc + col0;
#pragma unroll
                for (int bj = 0; bj < 2; ++bj) { const pg8::f32x4 v0 = acc[ai][bj][m][0], v1 = acc[ai][bj][m][1]; u32x4v w;
                    w.x = pk_bf16(v0[0], v0[1]); w.y = pk_bf16(v0[2], v0[3]); w.z = pk_bf16(v1[0], v1[1]); w.w = pk_bf16(v1[2], v1[3]);
                    *(u32x4v*)(rowp + bj * 128) = w; } }
    }
};
__device__ __forceinline__ float silu_mul(float g, float u) { return g * __builtin_amdgcn_rcpf(1.f + __builtin_amdgcn_exp2f(-1.4426950408889634f * g)) * u; }
struct EpiGateUp {
    static constexpr bool PERM = true, AFTER_DRAIN = false;
    u16* O;
    __device__ __forceinline__ void operator()(const pg8::f32x4 (&acc)[2][2][4][2], const pg8::Unit& u, int wr, int wc, int fr, int fq) const {
        const int row0 = u.pm * 256 + wr * 64 + fr, col0 = u.pn * 128 + wc * 32 + 8 * fq;
#pragma unroll
        for (int ai = 0; ai < 2; ++ai)
#pragma unroll
            for (int m = 0; m < 4; ++m) { u16* rowp = O + (size_t)(row0 + ai * 128 + m * 16) * DFF + col0;
                const pg8::f32x4 g0 = acc[ai][0][m][0], g1 = acc[ai][0][m][1], u0 = acc[ai][1][m][0], u1 = acc[ai][1][m][1]; u32x4v w;
                w.x = pk_bf16(silu_mul(g0[0], u0[0]), silu_mul(g0[1], u0[1])); w.y = pk_bf16(silu_mul(g0[2], u0[2]), silu_mul(g0[3], u0[3]));
                w.z = pk_bf16(silu_mul(g1[0], u1[0]), silu_mul(g1[1], u1[1])); w.w = pk_bf16(silu_mul(g1[2], u1[2]), silu_mul(g1[3], u1[3]));
                *(u32x4v*)rowp = w; }
    }
};
struct EpiQKV {
    static constexpr bool PERM = true, AFTER_DRAIN = false;
    u16* base; const float* cosT; const float* sinT;
    __device__ __forceinline__ void operator()(const pg8::f32x4 (&acc)[2][2][4][2], const pg8::Unit& u, int wr, int wc, int fr, int fq) const {
        const int kind = u.pn >> 3;
        u16* dst = base + (size_t)kind * ((size_t)T_TOK * DM);
        const bool rope = (kind != 1) && (wc == 0);
        const bool up = fq >= 2;
#pragma unroll
        for (int ai = 0; ai < 2; ++ai)
#pragma unroll
            for (int m = 0; m < 4; ++m) {
                const int row = u.pm * 256 + ai * 128 + wr * 64 + m * 16 + fr, b = row >> 12, s = row & (SEQ - 1);
                f32x4v cs0 = {1.f, 1.f, 1.f, 1.f}, cs1 = cs0, sn0 = {0.f, 0.f, 0.f, 0.f}, sn1 = sn0;
                if (rope) { const int i0 = s * 16 + 8 * (fq & 1);
                    cs0 = *(const f32x4v*)(cosT + i0); cs1 = *(const f32x4v*)(cosT + i0 + 4); sn0 = *(const f32x4v*)(sinT + i0); sn1 = *(const f32x4v*)(sinT + i0 + 4);
                    if (!up) { sn0 = -sn0; sn1 = -sn1; } }
#pragma unroll
                for (int bj = 0; bj < 2; ++bj) {
                    const int head = 2 * (u.pn & 7) + bj;
                    u16* rp = dst + ((size_t)(b * 16 + head) * SEQ + s) * 128 + wc * 32 + 8 * fq;
                    pg8::f32x4 a = acc[ai][bj][m][0], c = acc[ai][bj][m][1];
                    if (rope) {
#pragma unroll
                        for (int j = 0; j < 4; ++j) {
                            auto ra = __builtin_amdgcn_permlane32_swap(__float_as_uint(a[j]), __float_as_uint(a[j]), false, false);
                            auto rc = __builtin_amdgcn_permlane32_swap(__float_as_uint(c[j]), __float_as_uint(c[j]), false, false);
                            const float pa_ = __uint_as_float(up ? ra[0] : ra[1]), pc_ = __uint_as_float(up ? rc[0] : rc[1]);
                            a[j] = a[j] * cs0[j] + pa_ * sn0[j]; c[j] = c[j] * cs1[j] + pc_ * sn1[j]; }
                    }
                    u32x4v w; w.x = pk_bf16(a[0], a[1]); w.y = pk_bf16(a[2], a[3]); w.z = pk_bf16(c[0], c[1]); w.w = pk_bf16(c[2], c[3]);
                    *(u32x4v*)rp = w;
                }
            }
    }
};
struct PoolOrder {
    int G, c;
    __device__ bool next(int i, pg8::Unit& u) const { int L = i * G + c; if (L >= 512 * REP_GEMM) return false; L &= 511; const int pne = L & 7, pm = L >> 3; u.pm = (pne >> 1) * 64 + pm; u.pn = pne; return true; }
    __device__ __forceinline__ void a_ready(const pg8::Unit&) const {}
    __device__ __forceinline__ void done(const pg8::Unit&) const {}
};

struct AttItem { int vhd, qb0, qb1; };
__device__ __forceinline__ AttItem att_decode(int L) { AttItem it; const int xcd = L & 7, k = (L >> 3) & 127; it.vhd = xcd * 16 + (k >> 3); it.qb0 = k & 7; it.qb1 = 15 - it.qb0; return it; }
__device__ __forceinline__ att::BlockRef<att::bf16, att::bf16> att_ref(const AttItem& it, int pass, const u16* Kb, const u16* Vb, const u16* Qb, u16* Ob) {
    const int qb = pass ? it.qb1 : it.qb0, b = it.vhd >> 5, r = it.vhd & 31, sh = r >> 1, half = r & 1;
    att::BlockRef<att::bf16, att::bf16> R;
    R.Q = (const att::bf16*)(Qb + ((size_t)(b * 16 + sh) * SEQ + (size_t)qb * 256) * 128);
    R.K = (const att::bf16*)(Kb + ((size_t)(b * 16 + sh) * SEQ) * 128);
    R.V = (const att::bf16*)(Vb + ((size_t)(b * 16 + (sh >> 1) * 2 + half) * SEQ) * 128);
    R.O = (att::bf16*)(Ob + ((size_t)it.vhd * SEQ + (size_t)qb * 256) * 128);
    R.P0 = qb * 256;
    return R;
}
__device__ __forceinline__ void attention_phase(const u16* Kb, const u16* Vb, const u16* Qb, u16* Ob, char* lds) {
    constexpr int TOTAL = 1024 * REP_ATT;
    int L = blockIdx.x; if (L >= TOTAL) return;
    const int stride = gridDim.x;
    AttItem it = att_decode(L); int pass = 0;
    att::BlockRef<att::bf16, att::bf16> cur = att_ref(it, 0, Kb, Vb, Qb, Ob);
    att::Seam<att::bf16> S;
    att::causal_swa_prime<att::bf16, att::bf16>(cur, SEQ, lds, S);
    for (;;) {
        const bool more_pass = pass == 0, more_item = L + stride < TOTAL, last = !more_pass && !more_item;
        AttItem itn = it; int passn = pass + 1, Ln = L;
        if (!more_pass) { passn = 0; Ln = more_item ? L + stride : L; itn = att_decode(Ln); }
        const att::BlockRef<att::bf16, att::bf16> nxt = last ? cur : att_ref(itn, passn, Kb, Vb, Qb, Ob);
        att::causal_swa_block<att::bf16, att::bf16>(cur, nxt, SEQ, SEQ, lds, S);
        if (last) break;
        cur = nxt; it = itn; pass = passn; L = Ln;
    }
}


__device__ __forceinline__ void attention_phase3(const Params& p, const u16* Kb, const u16* Vb, const u16* Qb, float* stash, u16* attn_out, char* lds) {
    const int G = (int)gridDim.x, lane = threadIdx.x & 63;
    float d1 = p.lq1[lane] * p.lk1[lane] + p.lq1[lane + 64] * p.lk1[lane + 64];
    float d2 = p.lq2[lane] * p.lk2[lane] + p.lq2[lane + 64] * p.lk2[lane + 64];
    d1 = wave_sum(d1); d2 = wave_sum(d2);
    const float lam = __expf(d1) - __expf(d2) + LAMBDA_INIT;
#pragma nounroll
    for (int idx = 0; ; ++idx) {
        const int L = (int)blockIdx.x + (idx >> 2) * G; if (L >= 256 * REP_ATT) break;
        const int Lm = L & 255, xcd = Lm & 7, k = Lm >> 3, dh = xcd * 4 + (k >> 3), x = k & 7, b = dh >> 3, h = dh & 7;
        const int qb = (idx & 2) ? 15 - x : x, sub = idx & 1, sh = 2 * h + sub;
        att::Blk2 c;
        c.Q = (const att::bf16*)(Qb + ((size_t)(b * 16 + sh) * SEQ + (size_t)qb * 256) * 128);
        c.K = (const att::bf16*)(Kb + ((size_t)(b * 16 + sh) * SEQ) * 128);
        c.V0 = (const att::bf16*)(Vb + ((size_t)(b * 16 + h * 2) * SEQ) * 128);
        c.V1 = c.V0 + (size_t)SEQ * 128;
        c.O0 = nullptr; c.O1 = nullptr; c.P0 = qb * 256;
        c.stash = stash + (size_t)blockIdx.x * (128 * 512);
        c.comb = (att::bf16*)(attn_out + ((size_t)(b * SEQ + qb * 256)) * DM + h * 256);
        c.lam = lam;
        if (sub == 0) att::attn_block_v256<1>(c, lds); else att::attn_block_v256<2>(c, lds);
    }
}

__global__ __launch_bounds__(512, 2) void mega(Params p) {
    extern __shared__ __attribute__((aligned(16))) unsigned char shm[];
    cg::grid_group grid = cg::this_grid();
    __shared__ uint4 xb_words;
    if (threadIdx.x == 0) xb_words = make_uint4(0u, 0u, 0u, 0u);
    __syncthreads();
    if (p.ph_hi > 1000) grid.sync();
    const XcdBarrier xb = xcd_barrier_post((unsigned*)(p.ws + WS_MISC + MISC_BAR), (volatile __attribute__((address_space(3))) unsigned*)&xb_words);
    unsigned char* ws = p.ws;
    u16* const wpool = (u16*)(ws + WS_WPOOL); u16* const wgu = (u16*)(ws + WS_WGU); u16* const wdn = (u16*)(ws + WS_WDN); u16* const wqkv = (u16*)(ws + WS_WQKV); u16* const wo = (u16*)(ws + WS_WO);
    float* const rstd0 = (float*)(ws + WS_MISC + MISC_RSTD); float* const rstdx = (float*)(ws + WS_MISC + MISC_RSTDX); float* const rs1 = (float*)(ws + WS_MISC + 768 * 1024); float* const rs2 = (float*)(ws + WS_MISC + 832 * 1024); float* const rs3 = (float*)(ws + WS_MISC + 896 * 1024); float* const cosT = (float*)(ws + WS_MISC + MISC_COS); float* const sinT = (float*)(ws + WS_MISC + MISC_SIN);
    u16* const bufA = (u16*)(ws + WS_A); u16* const bufB = (u16*)(ws + WS_B); u16* const mixed = (u16*)(ws + WS_C); u16* const mbuf = (u16*)(ws + WS_C + 64 * MiB); u16* const osub = (u16*)(ws + WS_C);
    const int G = (int)gridDim.x, bid = (int)blockIdx.x;
#define IN(k) (p.ph_lo <= (k) && (k) < p.ph_hi)
#define SYNC(k) do { if (IN(k) && IN((k) + 1) && (k) != 9 && (k) != 0) { xcd_barrier(xb); } } while (0)
    if (IN(0)) {
        conv_loop<0>(p, (2112 + 1088) * REP_CONV, shm);
        for (int e = bid * 512 + (int)threadIdx.x; e < SEQ * 16; e += G * 512) rope_entry(e, cosT, sinT);
        mixed_phase(p.x, mixed, shm);
    }
    SYNC(0);
    SYNC(1);
#ifdef PROBE_MFMA
    if (IN(2)) mfma_probe(rstdx);
#endif
    if (IN(2)) { pg8::Gemm g{mixed, wpool, 4 * T_TOK, 512, 512}; PoolOrder S{G, bid}; EpiPlain E{mbuf, DM, 1};
        pg8::gemm_phase<EpiPlain, PoolOrder, false>((PG8_LAS unsigned char*)shm, g, S, E, nullptr); }
    SYNC(2);
    if (IN(3)) norm_phase<0>(p.x, nullptr, nullptr, mbuf, p.norm_mix_post, mixed, rs1, nullptr);
    SYNC(3);
    if (IN(4)) { pg8::Gemm g{mixed, wgu, T_TOK, 2 * DFF, DM}; pg8::StaticOrder S; S.init(T_TOK, 2 * DFF, G, bid); S.rep = REP_GU; EpiGateUp E{bufA};
        pg8::gemm_phase<EpiGateUp, pg8::StaticOrder, false>((PG8_LAS unsigned char*)shm, g, S, E, nullptr); }
    SYNC(4);
    if (IN(5)) { pg8::Gemm g{bufA, wdn, T_TOK, DM, DFF}; pg8::StaticOrder S; S.init(T_TOK, DM, G, bid); S.rep = REP_DN; EpiPlain E{mbuf, DM, 0};
        pg8::gemm_phase<EpiPlain, pg8::StaticOrder, false>((PG8_LAS unsigned char*)shm, g, S, E, nullptr); }
    SYNC(5);
    if (IN(6)) { norm_phase<1>(nullptr, mixed, rs1, mbuf, p.norm_ffn_post, bufB, rs2, nullptr);
        conv_loop<1>(p, 2112, shm); }
    SYNC(6);
    if (IN(7)) { pg8::Gemm g{bufB, wqkv, T_TOK, 3 * DM, DM}; pg8::StaticOrder S; S.init(T_TOK, 3 * DM, G, bid); EpiQKV E{bufA, cosT, sinT};
        pg8::gemm_phase<EpiQKV, pg8::StaticOrder, false>((PG8_LAS unsigned char*)shm, g, S, E, nullptr); }
    SYNC(7);
    if (IN(8)) attention_phase3(p, bufA, bufA + (size_t)T_TOK * DM, bufA + 2 * (size_t)T_TOK * DM, (float*)mixed, mbuf, (char*)shm);
    SYNC(8);
    SYNC(9);
    if (IN(10)) { pg8::Gemm g{mbuf, wo, T_TOK, DM, DM}; pg8::StaticOrder S; S.init(T_TOK, DM, G, bid); EpiPlain E{mixed, DM, 0};
        pg8::gemm_phase<EpiPlain, pg8::StaticOrder, false>((PG8_LAS unsigned char*)shm, g, S, E, nullptr); }
    SYNC(10);
    if (IN(11)) norm_phase<1>(nullptr, bufB, rs2, mixed, p.norm_mix_post + DM, mbuf, rs3, nullptr);
    SYNC(11);
    if (IN(12)) { pg8::Gemm g{mbuf, wgu, T_TOK, 2 * DFF, DM}; pg8::StaticOrder S; S.init(T_TOK, 2 * DFF, G, bid); S.rep = REP_GU; EpiGateUp E{bufA};
        pg8::gemm_phase<EpiGateUp, pg8::StaticOrder, false>((PG8_LAS unsigned char*)shm, g, S, E, nullptr); }
    SYNC(12);
    if (IN(13)) { pg8::Gemm g{bufA, wdn, T_TOK, DM, DFF}; pg8::StaticOrder S; S.init(T_TOK, DM, G, bid); S.rep = REP_DN; EpiPlain E{mixed, DM, 0};
        pg8::gemm_phase<EpiPlain, pg8::StaticOrder, false>((PG8_LAS unsigned char*)shm, g, S, E, nullptr); }
    SYNC(13);
    if (IN(14)) norm_phase<2>(nullptr, mbuf, rs3, mixed, p.norm_ffn_post + DM, nullptr, nullptr, p.out);
#undef IN
#undef SYNC
}

#ifndef MK_PER_PHASE
#define MK_PER_PHASE 0
#endif
extern "C" void kernel_launch(void* const* d_in, const int* in_sizes, int n_in, void* d_out, int out_size, void* d_ws, size_t ws_size, hipStream_t stream) {
    static int grid = 0;
    if (grid == 0) {
        if (n_in != 19 || out_size != T_TOK * DM || ws_size < WS_END) { fprintf(stderr, "kernel_launch: unexpected shapes (n_in %d out %d ws %zu)\n", n_in, out_size, ws_size); grid = -1; return; }
        int dev = 0, cus = 0, per_cu = 0;
        (void)hipGetDevice(&dev);
        if (hipDeviceGetAttribute(&cus, hipDeviceAttributeMultiprocessorCount, dev) != hipSuccess || cus <= 0) cus = 256;
        if (hipFuncSetAttribute((const void*)mega, hipFuncAttributeMaxDynamicSharedMemorySize, LDS_TOTAL) != hipSuccess) { fprintf(stderr, "kernel_launch: hipFuncSetAttribute failed\n"); grid = -1; return; }
        if (hipOccupancyMaxActiveBlocksPerMultiprocessor(&per_cu, (const void*)mega, 512, LDS_TOTAL) != hipSuccess || per_cu < 1) { fprintf(stderr, "kernel_launch: occupancy query says %d\n", per_cu); per_cu = 1; }
        (void)hipGetLastError();
        grid = cus * per_cu;
    }
    if (grid < 0) return;
    Params p{};
    p.x = (const float*)d_in[0]; p.norm_mix_pre = (const float*)d_in[1]; p.norm_mix_post = (const float*)d_in[2]; p.norm_ffn_pre = (const float*)d_in[3]; p.norm_ffn_post = (const float*)d_in[4];
    p.w_pool = (const float*)d_in[5]; p.pool_scale = (const float*)d_in[6]; p.kv_norm = (const float*)d_in[7]; p.w_kv = (const float*)d_in[8]; p.w_q = (const float*)d_in[9];
    p.lq1 = (const float*)d_in[10]; p.lk1 = (const float*)d_in[11]; p.lq2 = (const float*)d_in[12]; p.lk2 = (const float*)d_in[13]; p.subln = (const float*)d_in[14]; p.w_o = (const float*)d_in[15];
    p.w_gate = (const float*)d_in[16]; p.w_up = (const float*)d_in[17]; p.w_down = (const float*)d_in[18];
    p.out = (float*)d_out; p.ws = (unsigned char*)d_ws;
#if MK_PER_PHASE
    for (int ph = 0; ph <= NPHASE; ++ph) { p.ph_lo = ph; p.ph_hi = ph + 1; hipLaunchKernelGGL(mega, dim3(grid), dim3(512), LDS_TOTAL, stream, p); }
#else
    p.ph_lo = 0; p.ph_hi = NPHASE + 1;
    (void)hipMemsetAsync((unsigned char*)d_ws + WS_MISC + MISC_BAR, 0, BAR_BYTES, stream);
    void* args[] = {&p};
    hipError_t e = hipLaunchCooperativeKernel((const void*)mega, dim3(grid), dim3(512), args, LDS_TOTAL, stream);
    if (e != hipSuccess) fprintf(stderr, "cooperative launch failed: %s (grid %d)\n", hipGetErrorString(e), grid);
#endif
}
```

```cpp
#include <hip/hip_runtime.h>
#include <hip/hip_bf16.h>
#include <hip/hip_cooperative_groups.h>
#include <cstdio>
#include <cstdint>
#ifndef REP_GEMM
#define REP_GEMM 1
#endif
namespace pg8 {
#define PG8_LAS __attribute__((address_space(3)))
typedef unsigned short bf16_t;
typedef short bf16x8 __attribute__((ext_vector_type(8)));
typedef float f32x4 __attribute__((ext_vector_type(4)));
typedef unsigned u32x4 __attribute__((ext_vector_type(4)));
constexpr int BM = 256, BK = 64, HALF = 128, HTB = HALF * BK * 2  , STAGE_BYTES = 8 * HTB, NXCD = 8, WGM = 8;

__host__ __device__ __forceinline__ int lds_byte(int r, int c) { const int st = (r >> 4) * 2 + (c >> 5), rr = r & 15, cc = c & 31, ob = rr * 64 + cc * 2; return st * 1024 + (ob ^ (((ob >> 9) & 1) << 5)); }
__host__ __device__ __forceinline__ void stage_rc(int b, int& R, int& C) { const int st = b / 1024, sb = b % 1024, swz = sb ^ (((sb >> 9) & 1) << 5); R = (st >> 1) * 16 + swz / 64; C = (st & 1) * 32 + (swz % 64) / 2; }
__host__ __device__ __forceinline__ int perm32(int rho) { const int n = rho >> 4, i = rho & 15; return 8 * (i >> 2) + 4 * n + (i & 3); }

struct Unit { int pm, pn; };
struct Gemm { const bf16_t* A; const bf16_t* Bt; int M, N, K; };

struct StaticOrder {
    int nM, nN, nwg, G, c, rep = REP_GEMM;
    __host__ __device__ void init(int M, int N, int G_, int c_) { nM = M / BM; nN = N / BM; nwg = nM * nN; G = G_; c = c_; }
    __host__ __device__ bool next(int i, Unit& u) const {
        long L = (long)i * G + c; if (L >= (long)nwg * rep) return false; L %= nwg;
        int wgid = (int)L; { const int q = nwg / NXCD, r = nwg % NXCD, xcd = wgid % NXCD, off = wgid / NXCD; wgid = (xcd < r ? xcd * (q + 1) : r * (q + 1) + (xcd - r) * q) + off; }
        const int nig = WGM * nN, gid = wgid / nig, fm = gid * WGM, gsz = (nM - fm) < WGM ? (nM - fm) : WGM;
        u.pm = fm + ((wgid % nig) % gsz); u.pn = (wgid % nig) / gsz; return true;
    }
    __device__ __forceinline__ void a_ready(const Unit&) const {}
    __device__ __forceinline__ void done(const Unit&) const {}
};
__device__ __forceinline__ unsigned cvt_pk_bf16(float lo, float hi) { unsigned r; asm volatile("v_cvt_pk_bf16_f32 %0, %1, %2" : "=v"(r) : "v"(lo), "v"(hi)); return r; }
template <class Epi, class Sched, bool STAMP = false>
__device__ __forceinline__ void gemm_phase(PG8_LAS unsigned char* lds, const Gemm g, const Sched& S, const Epi& E, unsigned long long* stamps) {
    const int tid = threadIdx.x, wid = __builtin_amdgcn_readfirstlane(tid >> 6), lane = tid & 63, wr = wid >> 2, wc = wid & 3, fr = lane & 15, fq = lane >> 4;
    const int K = g.K, nt = K / BK;
    int ts_lo = 0, ts_hi = 0, nts = 0; const unsigned long long rt_entry = STAMP ? (unsigned long long)wall_clock64() : 0ull;
#define PG8_STAMP() do { if (STAMP && wid == 0 && nts < 64) { const unsigned long long _c = (unsigned long long)clock64(); \
        ts_lo = (lane == nts) ? (int)(unsigned)_c : ts_lo; ts_hi = (lane == nts) ? (int)(unsigned)(_c >> 32) : ts_hi; ++nts; } } while (0)
    PG8_STAMP();
    unsigned voffA[2], voffB[2];
#pragma unroll
    for (int i = 0; i < 2; ++i) { int R, C; stage_rc(tid * 16 + i * 8192, R, C); const int Rb = Epi::PERM ? ((R & ~31) + perm32(R & 31)) : R;
        voffA[i] = (unsigned)(R * K + C) * 2u; voffB[i] = (unsigned)(Rb * K + C) * 2u; }
    const size_t kstep = (size_t)(BK * 2);
    const size_t hstep = (size_t)HALF * K * 2;
    const size_t tstep = 2 * hstep;
    const unsigned ldsw = (unsigned)wid * 1024u;
    const int aoff = lds_byte(wr * 64 + fr, fq * 8), boff = lds_byte(wc * 32 + fr, fq * 8);
#define PG8_SA(b, h) (((b) * 2 + (h)) * HTB)
#define PG8_SB(b, h) ((4 + (b) * 2 + (h)) * HTB)
#define PG8_STAGE(bufoff, gbase, voff) do { _Pragma("unroll") for (int _i = 0; _i < 2; ++_i) \
        __builtin_amdgcn_global_load_lds((const unsigned*)((const char*)(gbase) + (voff)[_i]), (PG8_LAS unsigned*)(lds + (bufoff) + ldsw + _i * 8192), 16, 0, 0); } while (0)
#define PG8_LDA(dst, b, h) do { _Pragma("unroll") for (int m = 0; m < 4; ++m) _Pragma("unroll") for (int k = 0; k < 2; ++k) dst[m][k] = *(const PG8_LAS bf16x8*)(lds + PG8_SA(b, h) + aoff + m * 2048 + k * 1024); } while (0)
#define PG8_LDB(dst, b, h) do { _Pragma("unroll") for (int n = 0; n < 2; ++n) _Pragma("unroll") for (int k = 0; k < 2; ++k) dst[n][k] = *(const PG8_LAS bf16x8*)(lds + PG8_SB(b, h) + boff + n * 2048 + k * 1024); } while (0)
#define PG8_MMA(ai, bj, At, Bt) do { __builtin_amdgcn_s_setprio(1); _Pragma("unroll") for (int m = 0; m < 4; ++m) _Pragma("unroll") for (int n = 0; n < 2; ++n) _Pragma("unroll") for (int k = 0; k < 2; ++k) \
        acc[ai][bj][m][n] = __builtin_amdgcn_mfma_f32_16x16x32_bf16(Bt[n][k], At[m][k], acc[ai][bj][m][n], 0, 0, 0); __builtin_amdgcn_s_setprio(0); } while (0)
#define PG8_WAIT_V(n) asm volatile("s_waitcnt vmcnt(" #n ")" ::: "memory")
#define PG8_WAIT_L(n) asm volatile("s_waitcnt lgkmcnt(" #n ")" ::: "memory")
#define PG8_BAR __builtin_amdgcn_s_barrier()
#define PG8_SCHED __builtin_amdgcn_sched_barrier(0)
    Unit cur, nxt; int ui = 0;
    if (!S.next(0, cur)) return;
    f32x4 acc[2][2][4][2];
#pragma unroll
    for (int a = 0; a < 2; ++a)
#pragma unroll
        for (int b = 0; b < 2; ++b)
#pragma unroll
            for (int m = 0; m < 4; ++m)
#pragma unroll
                for (int n = 0; n < 2; ++n) acc[a][b][m][n] = (f32x4){0.f, 0.f, 0.f, 0.f};
    bf16x8 At[4][2], B0[2][2], B1[2][2];
    const char* cA = (const char*)g.A + (size_t)cur.pm * tstep; const char* cB = (const char*)g.Bt + (size_t)cur.pn * tstep;
    S.a_ready(cur);
    PG8_STAGE(PG8_SB(0, 0), cB, voffB); PG8_STAGE(PG8_SA(0, 0), cA, voffA); PG8_STAGE(PG8_SB(0, 1), cB + hstep, voffB); PG8_STAGE(PG8_SA(0, 1), cA + hstep, voffA);
    if (wr == 1) PG8_BAR;
    PG8_WAIT_V(4); PG8_BAR;
    PG8_STAGE(PG8_SB(1, 0), cB + kstep, voffB); PG8_STAGE(PG8_SA(1, 0), cA + kstep, voffA); PG8_STAGE(PG8_SB(1, 1), cB + hstep + kstep, voffB);
    PG8_WAIT_V(6); PG8_BAR;
    PG8_STAMP();
    for (;;) {
        const bool has_next = S.next(ui + 1, nxt);
        const char* nA = has_next ? (const char*)g.A + (size_t)nxt.pm * tstep : cA; const char* nB = has_next ? (const char*)g.Bt + (size_t)nxt.pn * tstep : cB;
        for (int t = 0; t < nt; t += 2) {
            const bool last = (t == nt - 2);
            const char* a1 = cA + (size_t)(t + 1) * kstep;
            const char* a2 = last ? nA : cA + (size_t)(t + 2) * kstep; const char* b2 = last ? nB : cB + (size_t)(t + 2) * kstep;
            const char* a3 = a2 + kstep; const char* b3 = b2 + kstep;
            if (last && has_next) S.a_ready(nxt);
            PG8_LDB(B0, 0, 0); PG8_SCHED; PG8_LDA(At, 0, 0); PG8_STAGE(PG8_SA(1, 1), a1 + hstep, voffA);
            PG8_WAIT_L(8); PG8_BAR; PG8_WAIT_L(0); PG8_MMA(0, 0, At, B0); PG8_BAR; PG8_SCHED;
            PG8_LDB(B1, 0, 1); PG8_STAGE(PG8_SB(0, 0), b2, voffB);
            PG8_BAR; PG8_WAIT_L(0); PG8_MMA(0, 1, At, B1); PG8_BAR;
            PG8_LDA(At, 0, 1); PG8_STAGE(PG8_SA(0, 0), a2, voffA);
            PG8_BAR; PG8_WAIT_L(0); PG8_MMA(1, 0, At, B0); PG8_BAR; PG8_SCHED;
            PG8_STAGE(PG8_SB(0, 1), b2 + hstep, voffB);
            PG8_WAIT_V(6); PG8_BAR; PG8_MMA(1, 1, At, B1); PG8_BAR;
            PG8_LDB(B0, 1, 0); PG8_SCHED; PG8_LDA(At, 1, 0); PG8_STAGE(PG8_SA(0, 1), a2 + hstep, voffA);
            PG8_WAIT_L(8); PG8_BAR; PG8_WAIT_L(0); PG8_MMA(0, 0, At, B0); PG8_BAR; PG8_SCHED;
            PG8_LDB(B1, 1, 1); PG8_STAGE(PG8_SB(1, 0), b3, voffB);
            PG8_BAR; PG8_WAIT_L(0); PG8_MMA(0, 1, At, B1); PG8_BAR;
            PG8_LDA(At, 1, 1); PG8_STAGE(PG8_SA(1, 0), a3, voffA);
            PG8_BAR; PG8_WAIT_L(0); PG8_MMA(1, 0, At, B0); PG8_BAR; PG8_SCHED;
            PG8_STAGE(PG8_SB(1, 1), b3 + hstep, voffB);
            PG8_WAIT_V(6); PG8_BAR; PG8_MMA(1, 1, At, B1); PG8_BAR;
        }
        PG8_STAMP();
        if constexpr (!Epi::AFTER_DRAIN) { E(acc, cur, wr, wc, fr, fq); S.done(cur); }
        PG8_STAMP();
        if (!has_next) break;
#pragma unroll
        for (int a = 0; a < 2; ++a)
#pragma unroll
            for (int b = 0; b < 2; ++b)
#pragma unroll
                for (int m = 0; m < 4; ++m)
#pragma unroll
                    for (int n = 0; n < 2; ++n) acc[a][b][m][n] = (f32x4){0.f, 0.f, 0.f, 0.f};
        cur = nxt; cA = nA; cB = nB; ++ui;
    }
    PG8_WAIT_V(0);
    if (wr == 0) PG8_BAR;
    PG8_BAR;
    if constexpr (Epi::AFTER_DRAIN) { E.fused(acc, cur, wr, wc, fr, fq, lds, wid, lane); S.done(cur); }
    PG8_STAMP();
    if (STAMP && wid == 0) { stamps[lane] = lane < nts ? (((unsigned long long)(unsigned)ts_hi << 32) | (unsigned)ts_lo) : 0ull;
        if (lane == 62) stamps[62] = rt_entry; if (lane == 63) stamps[63] = (unsigned long long)wall_clock64(); }
#undef PG8_STAMP
#undef PG8_SA
#undef PG8_SB
#undef PG8_STAGE
#undef PG8_LDA
#undef PG8_LDB
#undef PG8_MMA
#undef PG8_WAIT_V
#undef PG8_WAIT_L
#undef PG8_BAR
#undef PG8_SCHED
}
}
namespace att {
constexpr int D = 128;
constexpr float THR = 8.f;
constexpr bool WSKIP = false;
constexpr float SCALE = 0.08838834764831845f;
constexpr int NW = 8, QBLK = 32, KVBLK = 64, QB = NW * QBLK;
constexpr int SHM_V = KVBLK * D * 2, SHM_K = KVBLK * D * 2;
using bf16 = __hip_bfloat16;
typedef short bf16x8 __attribute__((ext_vector_type(8)));
typedef short s16x4 __attribute__((ext_vector_type(4)));
typedef float f32x16 __attribute__((ext_vector_type(16)));
typedef float f32x4 __attribute__((ext_vector_type(4)));
typedef unsigned u32x4 __attribute__((ext_vector_type(4)));
template <class A, class Bt> struct same_t { static constexpr bool v = false; };
template <class A> struct same_t<A, A> { static constexpr bool v = true; };

#define KSWZ(row, colB) ((row) * 256 + ((colB) ^ (((row) & 7) << 4)))
#define SBAR() __builtin_amdgcn_sched_barrier(0)
__device__ __forceinline__ int v_st(int k, int c) { const int kk = (k & ~0xC) | ((k & 4) << 1) | ((k & 8) >> 1); return ((kk >> 3) * 4 + (c >> 5)) * 512 + ((kk & 7) * 32 + (c & 31)) * 2; }
__device__ __forceinline__ int v_rd_base(int lane) { return ((lane & 3) << 3) | (((lane >> 2) & 3) << 6) | (((lane >> 4) & 1) << 5) | (((lane >> 5) & 1) << 8); }
constexpr int v_rd_off(int d0, int ks, int half) { return d0 * 512 + ks * 4096 + half * 2048; }
__device__ __forceinline__ int crow(int r, int hi) { return (r & 3) + 8 * (r >> 2) + 4 * hi; }
__device__ __forceinline__ unsigned cvtpk(float lo, float hi) {
    unsigned r; asm volatile("v_cvt_pk_bf16_f32 %0, %1, %2" : "=v"(r) : "v"(lo), "v"(hi)); return r;
}
__device__ __forceinline__ bf16x8 pack8(f32x4 a, f32x4 b) {
    u32x4 w = {cvtpk(a[0], a[1]), cvtpk(a[2], a[3]), cvtpk(b[0], b[1]), cvtpk(b[2], b[3])};
    return *reinterpret_cast<bf16x8*>(&w);
}
template <class T> __device__ __forceinline__ bf16x8 load8(const T* p) {
    if constexpr (same_t<T, float>::v) { return pack8(*(const f32x4*)p, *(const f32x4*)(p + 4)); }
    else { return *reinterpret_cast<const bf16x8*>(p); }
}
__device__ __forceinline__ void mask_tile(f32x16& p0, f32x16& p1, int dq, unsigned W) {
    const float NEG = -__builtin_inff();
#pragma unroll
    for (int r = 0; r < 16; ++r) {
        const int c = (r & 3) + 8 * (r >> 2);
        if ((unsigned)(dq - c) >= W) p0[r] = NEG;
        if ((unsigned)(dq - c - 32) >= W) p1[r] = NEG;
    }
}
__device__ __forceinline__ void partialSM(f32x16& p0, f32x16& p1, float& m_reg, float& mn, float& alpha) {
    float pmax = p0[0]; for (int r = 1; r < 16; ++r) pmax = fmaxf(pmax, p0[r]); for (int r = 0; r < 16; ++r) pmax = fmaxf(pmax, p1[r]);
    { auto rr = __builtin_amdgcn_permlane32_swap(__float_as_uint(pmax), __float_as_uint(pmax), false, false);
      pmax = fmaxf(__uint_as_float(rr[0]), __uint_as_float(rr[1])); }
    constexpr float C2 = 1.4426950408889634f * SCALE;
    if (__builtin_expect(__all((pmax - m_reg) * SCALE <= THR), 1)) { mn = m_reg; alpha = 1.f; }
    else { mn = fmaxf(m_reg, pmax); alpha = __builtin_amdgcn_exp2f((m_reg - mn) * C2); m_reg = mn; }
    const float mnL = -mn * C2;
    for (int r = 0; r < 16; ++r) p0[r] = fmaf(p0[r], C2, mnL); for (int r = 0; r < 16; ++r) p1[r] = fmaf(p1[r], C2, mnL);
    for (int r = 0; r < 16; ++r) p0[r] = __builtin_amdgcn_exp2f(p0[r]);
}
__device__ __forceinline__ void finishSM(f32x16& p0, f32x16& p1, float alpha, float& l_reg, bf16x8& pa0, bf16x8& pa1, bf16x8& pa2, bf16x8& pa3) {
    for (int r = 0; r < 16; ++r) p1[r] = __builtin_amdgcn_exp2f(p1[r]);
    float ps = 0; for (int r = 0; r < 16; ++r) ps += p0[r]; for (int r = 0; r < 16; ++r) ps += p1[r];
    { auto rr = __builtin_amdgcn_permlane32_swap(__float_as_uint(ps), __float_as_uint(ps), false, false);
      ps = __uint_as_float(rr[0]) + __uint_as_float(rr[1]); }
    l_reg = l_reg * alpha + ps;
#define PK4(P, B_, OUT) do { unsigned a0 = cvtpk(P[B_+0], P[B_+1]), a1 = cvtpk(P[B_+2], P[B_+3]);                          \
        unsigned b0 = cvtpk(P[B_+4], P[B_+5]), b1 = cvtpk(P[B_+6], P[B_+7]);                                             \
        auto r0 = __builtin_amdgcn_permlane32_swap(a0, b0, false, false); auto r1 = __builtin_amdgcn_permlane32_swap(a1, b1, false, false); \
        u32x4 w = {r0[0], r1[0], r0[1], r1[1]}; OUT = *reinterpret_cast<bf16x8*>(&w); } while (0)
    PK4(p0, 0, pa0); PK4(p0, 8, pa1); PK4(p1, 0, pa2); PK4(p1, 8, pa3);
#undef PK4
}
template <int KB, bool SK>
__device__ __forceinline__ void qkt(f32x16& p0, f32x16& p1, const char* K_lds, int r32, int hi, const bf16x8* qr, bool act) {
    if (SK && !act) { const float NEG = -__builtin_inff();
#pragma unroll
        for (int r = 0; r < 16; ++r) { p0[r] = NEG; p1[r] = NEG; } return; }
    p0 = f32x16{}; p1 = f32x16{};
    const char* kb[4];
#pragma unroll
    for (int dd = 0; dd < 4; ++dd) kb[dd] = K_lds + KB * SHM_K + KSWZ(r32, (dd * 16 + hi * 8) * 2);
#pragma unroll
    for (int d0 = 0; d0 < 8; ++d0) { const char* a = kb[d0 & 3] + (d0 >> 2) * 128;
        bf16x8 b0 = *reinterpret_cast<const bf16x8*>(a);
        bf16x8 b1 = *reinterpret_cast<const bf16x8*>(a + 32 * 256);
        p0 = __builtin_amdgcn_mfma_f32_32x32x16_bf16(b0, qr[d0], p0, 0, 0, 0);
        p1 = __builtin_amdgcn_mfma_f32_32x32x16_bf16(b1, qr[d0], p1, 0, 0, 0); }
}
template <int VB, bool SK>
__device__ __forceinline__ void pv_tile(f32x16* o, int vb0, bf16x8 pa0, bf16x8 pa1, bf16x8 pa2, bf16x8 pa3, bool act) {
    if (SK && !act) return;
#define TRRD(dst, off) asm volatile("ds_read_b64_tr_b16 %0, %1 offset:%2" : "=&v"(dst) : "v"(vb0), "i"(off) : "memory")
#define PV_D0(d0) do { s16x4 l0, l1, l2, l3, h0, h1, h2, h3; constexpr int b_ = VB * SHM_V + v_rd_off(d0, 0, 0);     \
        TRRD(l0, b_); TRRD(h0, b_ + 2048); TRRD(l1, b_ + 4096); TRRD(h1, b_ + 6144); TRRD(l2, b_ + 8192); TRRD(h2, b_ + 10240); TRRD(l3, b_ + 12288); TRRD(h3, b_ + 14336); \
        asm volatile("s_waitcnt lgkmcnt(0)" ::: "memory"); SBAR();                 \
        o[d0] = __builtin_amdgcn_mfma_f32_32x32x16_bf16(pa0, (bf16x8){l0[0], l0[1], l0[2], l0[3], h0[0], h0[1], h0[2], h0[3]}, o[d0], 0, 0, 0);   \
        o[d0] = __builtin_amdgcn_mfma_f32_32x32x16_bf16(pa1, (bf16x8){l1[0], l1[1], l1[2], l1[3], h1[0], h1[1], h1[2], h1[3]}, o[d0], 0, 0, 0);   \
        o[d0] = __builtin_amdgcn_mfma_f32_32x32x16_bf16(pa2, (bf16x8){l2[0], l2[1], l2[2], l2[3], h2[0], h2[1], h2[2], h2[3]}, o[d0], 0, 0, 0);   \
        o[d0] = __builtin_amdgcn_mfma_f32_32x32x16_bf16(pa3, (bf16x8){l3[0], l3[1], l3[2], l3[3], h3[0], h3[1], h3[2], h3[3]}, o[d0], 0, 0, 0); } while (0)
    PV_D0(0); PV_D0(1); PV_D0(2); PV_D0(3);
#undef PV_D0
#undef TRRD
}

template <class TIn, class TOut> struct BlockRef { const TIn* Q; const TIn* K; const TIn* V; TOut* O; int P0; };
template <class TIn> struct Seam {
    bf16x8 qr[8];
    bf16x8 st_v0, st_v1, st_k0, st_k1; f32x4 sf0, sf1, sf2, sf3;
    f32x4 tq[16];
};
__device__ __forceinline__ int swa_jlo(int P0, int W) { const int lowk = P0 - W + 1; return lowk > 0 ? lowk / KVBLK : 0; }
#define ROW(p, k0, rr) ((p) + (size_t)((k0) + (rr)) * D + sc)
#define VMW() asm volatile("s_waitcnt vmcnt(0)" ::: "memory")
#define VMWN(n) asm volatile("s_waitcnt vmcnt(%0)" :: "i"(n) : "memory")
#define SLOAD_H(Kp, Vp, k0) do { S.st_v0 = load8<TIn>(ROW(Vp, k0, sr)); S.st_v1 = load8<TIn>(ROW(Vp, k0, 32 + sr));              \
                         S.st_k0 = load8<TIn>(ROW(Kp, k0, sr)); S.st_k1 = load8<TIn>(ROW(Kp, k0, 32 + sr)); } while (0)
#define SWRITE_HK(bf) do { *(bf16x8*)(K_lds + (bf) * SHM_K + kws) = S.st_k0; *(bf16x8*)(K_lds + (bf) * SHM_K + kws + 32 * 256) = S.st_k1; } while (0)
#define SWRITE_HV(bf) do { *(bf16x8*)(V_lds + (bf) * SHM_V + vst0) = S.st_v0; *(bf16x8*)(V_lds + (bf) * SHM_V + vst1) = S.st_v1; } while (0)
#define SWRITE_H(bf) do { SWRITE_HV(bf); SWRITE_HK(bf); } while (0)
#define SLOAD_F(p, k0) do { S.sf0 = *(const f32x4*)ROW(p, k0, sr); S.sf1 = *(const f32x4*)(ROW(p, k0, sr) + 4);                \
                            S.sf2 = *(const f32x4*)ROW(p, k0, 32 + sr); S.sf3 = *(const f32x4*)(ROW(p, k0, 32 + sr) + 4); } while (0)
#define SWRITE_KF(bf) do { *(bf16x8*)(K_lds + (bf) * SHM_K + kws) = pack8(S.sf0, S.sf1); *(bf16x8*)(K_lds + (bf) * SHM_K + kws + 32 * 256) = pack8(S.sf2, S.sf3); } while (0)
#define SWRITE_VF(bf) do { *(bf16x8*)(V_lds + (bf) * SHM_V + vst0) = pack8(S.sf0, S.sf1); *(bf16x8*)(V_lds + (bf) * SHM_V + vst1) = pack8(S.sf2, S.sf3); } while (0)
template <class TIn, class TOut>
__device__ __forceinline__ void causal_swa_prime(const BlockRef<TIn, TOut>& cur, int W, char* lds, Seam<TIn>& S) {
    constexpr bool F32 = same_t<TIn, float>::v;
    const int tid = threadIdx.x, wid = __builtin_amdgcn_readfirstlane(tid >> 6), lane = tid & 63, r32 = lane & 31, hi = lane >> 5;
    const int sr = tid >> 4, sc = (tid & 15) * 8, kws = KSWZ(sr, sc * 2); char* K_lds = lds + 2 * SHM_V;
    const int kb0 = swa_jlo(cur.P0, W) * KVBLK;
    for (int d0 = 0; d0 < 8; ++d0) S.qr[d0] = load8<TIn>(cur.Q + (size_t)(wid * QBLK + r32) * D + d0 * 16 + hi * 8);
    if constexpr (F32) { SLOAD_F((const float*)cur.K, kb0); VMW(); SWRITE_KF(0); SBAR(); SLOAD_F((const float*)cur.V, kb0); }
    else { SLOAD_H(cur.K, cur.V, kb0); VMW(); SWRITE_HK(0); }
    __syncthreads();
}
template <class TIn, class TOut>
__device__ __forceinline__ void causal_swa_block(const BlockRef<TIn, TOut>& cur, const BlockRef<TIn, TOut>& nxt, int skv, int W, char* lds, Seam<TIn>& S) {
    constexpr bool F32 = same_t<TIn, float>::v;
    const int tid = threadIdx.x, wid = __builtin_amdgcn_readfirstlane(tid >> 6), lane = tid & 63, r32 = lane & 31, hi = lane >> 5;
    const int j_lo = swa_jlo(cur.P0, W);
    int j_hi = (cur.P0 + QB - 1) / KVBLK + 1; if (j_hi > skv / KVBLK) j_hi = skv / KVBLK;
    const int NT = j_hi - j_lo;
    const int kbn = swa_jlo(nxt.P0, W) * KVBLK;
    const int qlo = cur.P0 + wid * QBLK, qm = qlo + r32 - 4 * hi;
    char* V_lds = lds; char* K_lds = lds + 2 * SHM_V;
    float* ws = (float*)(lds + 2 * SHM_V + 2 * SHM_K) + wid * 64; float* li_l = ws, * al_l = ws + 32;
    float m_reg = -1e30f, l_reg = 0; f32x16 o[4] = {};
    const int sr = tid >> 4, sc = (tid & 15) * 8, vst0 = v_st(sr, sc), vst1 = v_st(32 + sr, sc), kws = KSWZ(sr, sc * 2);
    const int vb0 = (int)(uintptr_t)V_lds + v_rd_base(lane);
    const TIn* Kh = cur.K; const TIn* Vh = cur.V;
#define RESC(a) do { if (__any((a) < 1.f)) { if (hi == 0) al_l[r32] = (a); asm volatile("s_waitcnt lgkmcnt(0)" ::: "memory");              \
                     for (int d_ = 0; d_ < 4; ++d_) for (int r = 0; r < 16; ++r) o[d_][r] *= al_l[crow(r, hi)]; } } while (0)
#define KBASE(t) ((j_lo + (t)) * KVBLK)
#define ACT(t) (KBASE(t) <= qlo + QBLK - 1 && KBASE(t) + KVBLK - 1 >= qlo - W + 1)
#define MASKT(P0_, P1_, t) do { const int kb_ = KBASE(t); if ((!SK || ACT(t)) && (kb_ + KVBLK - 1 > qlo || kb_ <= qlo + QBLK - 1 - W)) mask_tile(P0_, P1_, qm - kb_, (unsigned)W); } while (0)
    constexpr int NQL = F32 ? 16 : 8;
    constexpr bool SK = WSKIP && !F32;
#define SEAM_K0() do { VMWN(NQL); if constexpr (F32) { SWRITE_KF(0); SBAR(); SLOAD_F((const float*)nxt.V, kbn); } else { SWRITE_HK(0); } SBAR(); } while (0)
    f32x16 pA0, pA1, pB0, pB1; float mnA, mnB, alA, alB; bf16x8 pa0, pa1, pa2, pa3;
    if constexpr (F32) { VMW(); SWRITE_VF(0); SBAR(); } else { SWRITE_HV(0); SBAR(); }
    if (NT > 1) { if constexpr (F32) SLOAD_F((const float*)Kh, KBASE(1)); else SLOAD_H(Kh, Vh, KBASE(1)); }
    SBAR(); qkt<0, SK>(pA0, pA1, K_lds, r32, hi, S.qr, ACT(0));
    if constexpr (F32) { if (NT > 1) { VMW(); SWRITE_KF(1); SBAR(); SLOAD_F((const float*)Vh, KBASE(1)); } }
    MASKT(pA0, pA1, 0); partialSM(pA0, pA1, m_reg, mnA, alA);
    if (NT > 1) { VMW(); if constexpr (F32) { SWRITE_VF(1); SBAR(); if (NT > 2) SLOAD_F((const float*)Kh, KBASE(2)); } else SWRITE_H(1); }
    __syncthreads();
#define HALF_STEP(PX0, PX1, mnX, alX, PY0, PY1, alY, t, KB, VB, SB) do {                                                      \
        SBAR(); qkt<KB, SK>(PX0, PX1, K_lds, r32, hi, S.qr, ACT(t));                                             \
        finishSM(PY0, PY1, alY, l_reg, pa0, pa1, pa2, pa3); SBAR();                                                           \
        if ((t) + 1 < NT) { if constexpr (F32) { VMW(); SWRITE_KF(SB); SBAR(); SLOAD_F((const float*)Vh, KBASE((t) + 1)); }  \
                            else { SLOAD_H(Kh, Vh, KBASE((t) + 1)); } SBAR(); }                                               \
        pv_tile<VB, SK>(o, vb0, pa0, pa1, pa2, pa3, ACT((t) - 1)); MASKT(PX0, PX1, (t)); partialSM(PX0, PX1, m_reg, mnX, alX);                                        \
        __syncthreads();                                                                                                      \
        if ((t) + 1 < NT) { VMW(); if constexpr (F32) { SWRITE_VF(SB); SBAR(); if ((t) + 2 < NT) SLOAD_F((const float*)Kh, KBASE((t) + 2)); } \
                            else { SWRITE_H(SB); } }                                                                          \
        RESC(alX); __syncthreads(); } while (0)
    for (int t = 1; t + 1 < NT; t += 2) {
        HALF_STEP(pB0, pB1, mnB, alB, pA0, pA1, alA, t, 1, 0, 0);
        HALF_STEP(pA0, pA1, mnA, alA, pB0, pB1, alB, t + 1, 0, 1, 1);
    }
    const bool even = (NT & 1) == 0;
    if (even) { SBAR(); qkt<1, SK>(pB0, pB1, K_lds, r32, hi, S.qr, ACT(NT - 1)); SBAR(); }
#define QROW(e) (nxt.Q + (size_t)(wid * QBLK + r32) * D + ((e) >> 1) * 16 + hi * 8 + ((e) & 1) * 4)
    if constexpr (F32) { SLOAD_F((const float*)nxt.K, kbn); SBAR();
#pragma unroll
        for (int e = 0; e < 8; ++e) S.tq[e] = *(const f32x4*)QROW(e); }
    else { SLOAD_H(nxt.K, nxt.V, kbn); SBAR();
#pragma unroll
        for (int d0 = 0; d0 < 8; ++d0) S.qr[d0] = load8<TIn>(nxt.Q + (size_t)(wid * QBLK + r32) * D + d0 * 16 + hi * 8); }
    SBAR();
    finishSM(pA0, pA1, alA, l_reg, pa0, pa1, pa2, pa3); SBAR();
    if constexpr (F32) {
#pragma unroll
        for (int e = 8; e < 16; ++e) S.tq[e] = *(const f32x4*)QROW(e); SBAR(); }
#undef QROW
    pv_tile<0, SK>(o, vb0, pa0, pa1, pa2, pa3, ACT(even ? NT - 2 : NT - 1));
    if (even) { MASKT(pB0, pB1, NT - 1); partialSM(pB0, pB1, m_reg, mnB, alB); __syncthreads(); RESC(alB);
        finishSM(pB0, pB1, alB, l_reg, pa0, pa1, pa2, pa3); SBAR(); pv_tile<1, SK>(o, vb0, pa0, pa1, pa2, pa3, ACT(NT - 1)); }
    SBAR(); SEAM_K0();
    if (hi == 0) li_l[r32] = l_reg; asm volatile("s_waitcnt lgkmcnt(0)" ::: "memory");
    float rli[16];
#pragma unroll
    for (int r = 0; r < 16; ++r) rli[r] = __builtin_amdgcn_rcpf(li_l[crow(r, hi)]);
    TOut* Ow = cur.O + (size_t)(wid * QBLK) * D;
#pragma unroll
    for (int r = 0; r < 16; ++r) { const int orow = crow(r, hi);
#pragma unroll
        for (int d0 = 0; d0 < 4; ++d0) { const float v = o[d0][r] * rli[r];
            if constexpr (same_t<TOut, float>::v) { Ow[(size_t)orow * D + d0 * 32 + r32] = v; }
            else { const float vn = __shfl_xor(v, 1);
                   if ((r32 & 1) == 0) *(unsigned*)(Ow + (size_t)orow * D + d0 * 32 + r32) = cvtpk(v, vn); } } }
    if constexpr (F32) {
#pragma unroll
        for (int d0 = 0; d0 < 8; ++d0) S.qr[d0] = pack8(S.tq[2 * d0], S.tq[2 * d0 + 1]); }
    __syncthreads();
#undef RESC
#undef KBASE
#undef ACT
#undef MASKT
#undef SEAM_K0
#undef HALF_STEP
}
#undef ROW
#undef VMW
#undef VMWN
#undef SLOAD_H
#undef SWRITE_HK
#undef SWRITE_HV
#undef SWRITE_H
#undef SLOAD_F
#undef SWRITE_KF
#undef SWRITE_VF
}
namespace att {
#define A2_LAS __attribute__((address_space(3)))
struct Blk2 { const bf16* Q; const bf16* K; const bf16* V0; const bf16* V1; bf16* O0; bf16* O1; int P0; float* stash; bf16* comb; float lam; };
template <int EPI>
__device__ __forceinline__ void attn_block_v256(const Blk2& c, char* lds) {
    const int tid = threadIdx.x, wid = __builtin_amdgcn_readfirstlane(tid >> 6), lane = tid & 63, r32 = lane & 31, hi = lane >> 5;
    const int NT = c.P0 / KVBLK + 4;
    const int qlo = c.P0 + wid * QBLK, qm = qlo + r32 - 4 * hi;
    char* K_lds = lds; char* V_lds = lds + 2 * SHM_K;
    float* wsf = (float*)(lds + 4 * SHM_V + 2 * SHM_K) + wid * 64; float* li_l = wsf; float* al_l = wsf + 32;
    const int vb0 = (int)(uintptr_t)V_lds + v_rd_base(lane);
    const char* kbs[4];
#pragma unroll
    for (int dd = 0; dd < 4; ++dd) kbs[dd] = K_lds + KSWZ(r32, (dd * 16 + hi * 8) * 2);
    unsigned koff[2];
#pragma unroll
    for (int j = 0; j < 2; ++j) { const int q = (2 * wid + j) * 64 + lane, row = q >> 4, slot = q & 15; koff[j] = (unsigned)(row * 256 + ((slot ^ (row & 7)) << 4)); }
    unsigned voff;
    { const int kk = 8 * wid + ((lane & 31) >> 2), k = (kk & ~0xC) | ((kk & 4) << 1) | ((kk & 8) >> 1); voff = (unsigned)(k * 256 + (lane >> 5) * 64 + (lane & 3) * 16); }
    bf16x8 qr[8];
#pragma unroll
    for (int d0 = 0; d0 < 8; ++d0) qr[d0] = load8<bf16>(c.Q + (size_t)(wid * QBLK + r32) * D + d0 * 16 + hi * 8);
#define A2_DMA(gp, lp) __builtin_amdgcn_global_load_lds((const unsigned*)(gp), (A2_LAS unsigned*)(lp), 16, 0, 0)
#define A2_STAGE(k0, bf) do { const char* kp_ = (const char*)c.K + (size_t)(k0) * (D * 2); const char* v0_ = (const char*)c.V0 + (size_t)(k0) * (D * 2); const char* v1_ = (const char*)c.V1 + (size_t)(k0) * (D * 2); \
        char* kl_ = K_lds + (bf) * SHM_K + wid * 2048; char* vl_ = V_lds + (bf) * (2 * SHM_V) + wid * 2048; \
        A2_DMA(kp_ + koff[0], kl_); A2_DMA(kp_ + koff[1], kl_ + 1024); \
        A2_DMA(v0_ + voff, vl_); A2_DMA(v0_ + voff + 128, vl_ + 1024); A2_DMA(v1_ + voff, vl_ + SHM_V); A2_DMA(v1_ + voff + 128, vl_ + SHM_V + 1024); } while (0)
#define A2_VMW() asm volatile("s_waitcnt vmcnt(0)" ::: "memory")
#define A2_RESC(a) do { if (__any((a) < 1.f)) { if (hi == 0) al_l[r32] = (a); asm volatile("s_waitcnt lgkmcnt(0)" ::: "memory"); \
                        for (int d_ = 0; d_ < 8; ++d_) for (int r = 0; r < 16; ++r) o[d_][r] *= al_l[crow(r, hi)]; } } while (0)
    A2_STAGE(0, 0); A2_VMW();
    __syncthreads();
    float m_reg = -1e30f, l_reg = 0.f; f32x16 o[8] = {};
    f32x16 p0, p1; float mn, alpha; bf16x8 pa0, pa1, pa2, pa3;
#define A2_QKT(KB) do { p0 = f32x16{}; p1 = f32x16{}; _Pragma("unroll") for (int d0 = 0; d0 < 8; ++d0) { const char* a_ = kbs[d0 & 3] + (KB) * SHM_K + (d0 >> 2) * 128; \
        const bf16x8 b0_ = *reinterpret_cast<const bf16x8*>(a_); const bf16x8 b1_ = *reinterpret_cast<const bf16x8*>(a_ + 32 * 256); \
        p0 = __builtin_amdgcn_mfma_f32_32x32x16_bf16(b0_, qr[d0], p0, 0, 0, 0); p1 = __builtin_amdgcn_mfma_f32_32x32x16_bf16(b1_, qr[d0], p1, 0, 0, 0); } } while (0)
#define A2_STEP(t, BUF) do { \
        if ((t) + 1 < NT) { A2_STAGE(((t) + 1) * KVBLK, (BUF) ^ 1); } \
        if ((t) * KVBLK <= qlo + QBLK - 1) {     \
        SBAR(); A2_QKT(BUF); SBAR(); \
        { const int kb_ = (t) * KVBLK; if (kb_ + KVBLK - 1 > qlo) mask_tile(p0, p1, qm - kb_, (unsigned)0x40000000); } \
        partialSM(p0, p1, m_reg, mn, alpha); \
        finishSM(p0, p1, alpha, l_reg, pa0, pa1, pa2, pa3); SBAR(); \
        A2_RESC(alpha); \
        pv_tile<0, false>(o, vb0 + (BUF) * (2 * SHM_V), pa0, pa1, pa2, pa3, true); \
        pv_tile<1, false>(o + 4, vb0 + (BUF) * (2 * SHM_V), pa0, pa1, pa2, pa3, true); } \
        A2_VMW(); __syncthreads(); } while (0)
    for (int t = 0; t < NT; t += 2) { A2_STEP(t, 0); A2_STEP(t + 1, 1); }
    if (hi == 0) li_l[r32] = l_reg; asm volatile("s_waitcnt lgkmcnt(0)" ::: "memory");
    if (EPI == 0) {
    float rli[16];
#pragma unroll
    for (int r = 0; r < 16; ++r) rli[r] = __builtin_amdgcn_rcpf(li_l[crow(r, hi)]);
#pragma unroll
    for (int r = 0; r < 16; ++r) { const int orow = wid * QBLK + crow(r, hi);
#pragma unroll
        for (int d0 = 0; d0 < 8; ++d0) { const float v = o[d0][r] * rli[r]; const float vn = __shfl_xor(v, 1);
            bf16* Ob = (d0 < 4) ? c.O0 : c.O1;
            if ((r32 & 1) == 0) *(unsigned*)(Ob + (size_t)orow * D + (d0 & 3) * 32 + r32) = cvtpk(v, vn); } }
    } else if (EPI == 1) {
        int tid1 = threadIdx.x; asm volatile("" : "+v"(tid1)); const unsigned toff1 = (unsigned)tid1 * 16u;
#pragma unroll
        for (int q = 0; q < 4; ++q) {
            float rl[4];
#pragma unroll
            for (int j = 0; j < 4; ++j) rl[j] = __builtin_amdgcn_rcpf(li_l[crow(4 * q + j, hi)]);
#pragma unroll
            for (int d0 = 0; d0 < 8; ++d0) { char* sbs = (char*)c.stash + (size_t)(d0 * 4 + q) * 8192;
                *(f32x4*)(sbs + toff1) = (f32x4){o[d0][4 * q] * rl[0], o[d0][4 * q + 1] * rl[1], o[d0][4 * q + 2] * rl[2], o[d0][4 * q + 3] * rl[3]}; }
        }
    } else {
        int tid2 = threadIdx.x; asm volatile("" : "+v"(tid2));
        const int lane2 = tid2 & 63;
        char* tl = lds + 2 * SHM_K + (tid2 >> 6) * 8192;
#pragma unroll
        for (int q = 0; q < 4; ++q) {
            f32x4 sv[8];
#pragma unroll
            for (int d0 = 0; d0 < 8; ++d0) { const char* sbs = (const char*)c.stash + (size_t)(d0 * 4 + q) * 8192; sv[d0] = *(const f32x4*)(sbs + (unsigned)tid2 * 16u); }
#pragma unroll
            for (int j = 0; j < 4; ++j) { const int r = 4 * q + j;
                const float rl = c.lam * __builtin_amdgcn_rcpf(li_l[crow(r, hi)]);
                float dv[8]; float ss = 0.f;
#pragma unroll
                for (int d0 = 0; d0 < 8; ++d0) { dv[d0] = sv[d0][j] - o[d0][r] * rl; ss += dv[d0] * dv[d0]; }
                ss += __shfl_xor(ss, 1); ss += __shfl_xor(ss, 2); ss += __shfl_xor(ss, 4); ss += __shfl_xor(ss, 8); ss += __shfl_xor(ss, 16);
                const float rs = rsqrtf(ss * (1.f / 256.f) + 1e-6f);
                const int lrow = crow(r, hi) - 16 * (q >> 1);
#pragma unroll
                for (int d0 = 0; d0 < 8; ++d0) *(unsigned short*)(tl + lrow * 512 + (d0 * 32 + (lane2 & 31)) * 2) = (unsigned short)cvtpk(dv[d0] * rs, 0.f); }
            if (q & 1) {
                asm volatile("s_waitcnt lgkmcnt(0)" ::: "memory");
                const unsigned loff = (unsigned)((lane2 >> 5) * 4096 + (lane2 & 31) * 16);
#pragma unroll
                for (int it = 0; it < 8; ++it) {
                    const u32x4 w = *(const u32x4*)(tl + (lane2 >> 5) * 512 + (lane2 & 31) * 16 + it * 1024);
                    char* ob = (char*)c.comb + (size_t)(wid * QBLK + 16 * (q >> 1) + 2 * it) * 4096;
                    *(u32x4*)(ob + loff) = w; }
                asm volatile("s_waitcnt lgkmcnt(0)" ::: "memory");
            }
        }
    }
    __syncthreads();
#undef A2_VMW
#undef A2_DMA
#undef A2_STAGE
#undef A2_RESC
#undef A2_STEP
#undef A2_QKT
}
}

#define XB_TMO      128
#define XB_XCNT(j)  (256  + 64 * (j))
#define XB_XSUB(j)  (1280 + 64 * (j))
#define XB_XGEN(j)  (2304 + 64 * (j))
#define XB_TOP      3328
#define XB_TOPGEN   3392
#define XCD_BAR_WORDS 3456
#define XB_SPIN_CAP (1u << 18)
#define LAS __attribute__((address_space(3)))

__device__ __forceinline__ unsigned xb_ld(unsigned* p)              { return __hip_atomic_load(p, __ATOMIC_RELAXED, __HIP_MEMORY_SCOPE_AGENT); }
__device__ __forceinline__ unsigned xb_add(unsigned* p, unsigned v) { return __hip_atomic_fetch_add(p, v, __ATOMIC_RELAXED, __HIP_MEMORY_SCOPE_AGENT); }
__device__ __forceinline__ unsigned xb_xcc_id() { return (unsigned)__builtin_amdgcn_s_getreg((3 << 11) | 20) & 0xFu; }
#define XB_SPIN(cond, bar) do { unsigned _sp = 0; while (cond) { __builtin_amdgcn_s_sleep(1); \
    if ((++_sp & 255u) == 0u) { if (xb_ld(&(bar)[XB_TMO])) break; if (_sp > XB_SPIN_CAP) { atomicAdd(&(bar)[XB_TMO], 1u); break; } } } } while (0)

struct XcdBarrier {
    unsigned* bar; unsigned x;
    volatile LAS unsigned* st;
};

__device__ __forceinline__ XcdBarrier xcd_barrier_post(unsigned* bar, volatile LAS unsigned* st) {
    XcdBarrier b; b.bar = bar; b.x = xb_xcc_id(); b.st = st;
    if (threadIdx.x == 0) (void)xb_add(&bar[XB_XCNT(b.x)], 1u);
    return b;
}
__device__ __forceinline__ void xcd_barrier_complete(unsigned* bar, unsigned x, unsigned& nloc, unsigned& nx) {
    const unsigned G = gridDim.x * gridDim.y * gridDim.z;
    unsigned sum, cnt, mine, sp = 0u;
    for (;;) {
        sum = 0u; cnt = 0u; mine = 0u;
#pragma unroll
        for (unsigned j = 0; j < 16; ++j) { const unsigned c = xb_ld(&bar[XB_XCNT(j)]); sum += c; cnt += (c > 0u) ? 1u : 0u; mine = (j == x) ? c : mine; }
        if (sum == G) break;
        __builtin_amdgcn_s_sleep(1);
        if ((++sp & 255u) == 0u) { if (xb_ld(&bar[XB_TMO])) break; if (sp > XB_SPIN_CAP) { atomicAdd(&bar[XB_TMO], 1u); break; } }
    }
    nloc = mine > 0u ? mine : 1u; nx = cnt > 0u ? cnt : 1u;
}

__device__ __forceinline__ void xcd_barrier(const XcdBarrier& b) {
    asm volatile("s_waitcnt vmcnt(0)" ::: "memory");
    __syncthreads();
    if (threadIdx.x == 0) {
        unsigned* bar = b.bar;
        __builtin_amdgcn_s_waitcnt(0);
        unsigned nloc = b.st[0], nx = b.st[1];
        if (nloc == 0u) { xcd_barrier_complete(bar, b.x, nloc, nx); b.st[0] = nloc; b.st[1] = nx; }
        const unsigned old = xb_add(&bar[XB_XSUB(b.x)], 1u);
        const unsigned gen = old / nloc;
        if (old + 1u == (gen + 1u) * nloc) {
            __builtin_amdgcn_fence(__ATOMIC_RELEASE, "agent");
            asm volatile("s_waitcnt vmcnt(0)" ::: "memory");
            const unsigned og = xb_add(&bar[XB_TOP], 1u);
            const unsigned tg = og / nx;
            if (og + 1u == (tg + 1u) * nx) xb_add(&bar[XB_TOPGEN], 1u);
            else XB_SPIN(xb_ld(&bar[XB_TOPGEN]) == tg, bar);
            __builtin_amdgcn_fence(__ATOMIC_ACQUIRE, "agent");
            xb_add(&bar[XB_XGEN(b.x)], 1u);
            asm volatile("s_waitcnt vmcnt(0)" ::: "memory");
        } else {
            XB_SPIN(xb_ld(&bar[XB_XGEN(b.x)]) == gen, bar);
            __builtin_amdgcn_fence(__ATOMIC_ACQUIRE, "agent");
            asm volatile("s_waitcnt vmcnt(0)" ::: "memory");
        }
    }
    __syncthreads();
}

#undef LAS

namespace cg = cooperative_groups;
#ifndef REP_GEMM
#define REP_GEMM 1
#endif
#ifndef REP_GU
#define REP_GU REP_GEMM
#endif
#ifndef REP_DN
#define REP_DN REP_GEMM
#endif
#ifndef REP_P3
#define REP_P3 1
#endif
#ifndef REP_ATT
#define REP_ATT 1
#endif
#ifndef REP_CONV
#define REP_CONV 1
#endif
typedef unsigned short u16;
typedef float f32x4v __attribute__((ext_vector_type(4)));
typedef unsigned u32x4v __attribute__((ext_vector_type(4)));
typedef unsigned u32x2v __attribute__((ext_vector_type(2)));

constexpr int T_TOK = 16384, DM = 2048, DFF = 5632, SEQ = 4096, NBATCH = 4;
constexpr float EPS = 1e-6f;
constexpr float LAMBDA_INIT = 0.35550906759096934f;
constexpr size_t MiB = (size_t)1 << 20;
constexpr size_t WS_WPOOL = 0, WS_WGU = 2 * MiB, WS_WDN = 46 * MiB, WS_WQKV = 68 * MiB, WS_WO = 92 * MiB, WS_MISC = 100 * MiB,
                 WS_A = 101 * MiB, WS_B = 293 * MiB, WS_C = 357 * MiB, WS_END = 485 * MiB;
constexpr size_t MISC_RSTD = 0, MISC_COS = 64 * 1024, MISC_SIN = 320 * 1024, MISC_BAR = 640 * 1024, BAR_BYTES = 16 * 1024, MISC_RSTDX = 704 * 1024;
constexpr int LDS_TOTAL = 131072;
constexpr int NPHASE = 14;

struct Params {
    const float* x; const float* norm_mix_pre; const float* norm_mix_post; const float* norm_ffn_pre; const float* norm_ffn_post;
    const float* w_pool; const float* pool_scale; const float* kv_norm; const float* w_kv; const float* w_q;
    const float* lq1; const float* lk1; const float* lq2; const float* lk2; const float* subln; const float* w_o;
    const float* w_gate; const float* w_up; const float* w_down;
    float* out; unsigned char* ws;
    int ph_lo, ph_hi;
};

__device__ __forceinline__ unsigned pk_bf16(float lo, float hi) { unsigned r; asm volatile("v_cvt_pk_bf16_f32 %0, %1, %2" : "=v"(r) : "v"(lo), "v"(hi)); return r; }
__device__ __forceinline__ float bf_lo(unsigned w) { return __uint_as_float(w << 16); }
__device__ __forceinline__ float bf_hi(unsigned w) { return __uint_as_float(w & 0xffff0000u); }
__device__ __forceinline__ float wave_sum(float v) {
#pragma unroll
    for (int o = 32; o >= 1; o >>= 1) v += __shfl_xor(v, o);
    return v;
}

struct ConvJob { const float* src; int ld; int c0; int k0; const float* rgain; int rmask; const float* cgain; float scal; u16* dst; int Kdst; };

__device__ __forceinline__ void conv_load(const ConvJob& j, float (&v)[32]) {
    const int tid = threadIdx.x, w = tid >> 6, lane = tid & 63;
    const float* sp = j.src + (size_t)(j.k0 + w * 16 + (lane >> 5)) * j.ld + j.c0 + 4 * (lane & 31);
#pragma unroll
    for (int q = 0; q < 8; ++q) { const f32x4v t = __builtin_nontemporal_load((const f32x4v*)(sp + (size_t)(2 * q) * j.ld)); v[4 * q] = t.x; v[4 * q + 1] = t.y; v[4 * q + 2] = t.z; v[4 * q + 3] = t.w; }
}
__device__ __forceinline__ void conv_store(const ConvJob& j, const float (&v)[32], unsigned char* lds) {
    const int tid = threadIdx.x, w = tid >> 6, lane = tid & 63, l4 = lane & 31, kh = lane >> 5;
    float cg[4] = {j.scal, j.scal, j.scal, j.scal};
    if (j.cgain) { const float* cp = j.cgain + j.c0 + 4 * l4; cg[0] *= cp[0]; cg[1] *= cp[1]; cg[2] *= cp[2]; cg[3] *= cp[3]; }
#pragma unroll
    for (int q = 0; q < 8; ++q) {
        const int kl = w * 16 + 2 * q + kh;
        const float rg = j.rgain ? j.rgain[(j.k0 + kl) & j.rmask] : 1.f;
#pragma unroll
        for (int jj = 0; jj < 4; ++jj) {
            const unsigned b = pk_bf16(v[4 * q + jj] * (cg[jj] * rg), 0.f);
            *(u16*)(lds + (jj * 32 + l4) * 260 + kl * 2) = (u16)b;
        }
    }
    __syncthreads();
#pragma unroll
    for (int i = 0; i < 4; ++i) {
        const int id = tid + 512 * i, n = id >> 4, c = id & 15, slot = (n & 3) * 32 + (n >> 2);
        const unsigned* lp = (const unsigned*)(lds + slot * 260 + c * 16);
        u32x4v o; o.x = lp[0]; o.y = lp[1]; o.z = lp[2]; o.w = lp[3];
        *(u32x4v*)(j.dst + (size_t)n * j.Kdst + j.k0 + c * 8) = o;
    }
    __syncthreads();
}

__device__ __forceinline__ ConvJob conv_ffn_job(const Params& p, int l, int t) {
    ConvJob j; j.rmask = -1; j.cgain = nullptr; j.scal = 1.f;
    if (t < 1408) { const int nb = t % 88, kt = t / 88, pn = nb >> 1, which = nb & 1;
        j.src = (which ? p.w_up : p.w_gate) + (size_t)l * DM * DFF; j.ld = DFF; j.c0 = pn * 128; j.k0 = kt * 128; j.rgain = p.norm_ffn_pre + l * DM;
        j.dst = (u16*)(p.ws + WS_WGU) + (size_t)nb * 128 * DM; j.Kdst = DM; }
    else { t -= 1408; const int nb = t % 16, kt = t / 16;
        j.src = p.w_down + (size_t)l * DFF * DM; j.ld = DM; j.c0 = nb * 128; j.k0 = kt * 128; j.rgain = nullptr;
        j.dst = (u16*)(p.ws + WS_WDN) + (size_t)nb * 128 * DFF; j.Kdst = DFF; }
    return j;
}
__device__ __forceinline__ ConvJob conv_misc_job(const Params& p, int t) {
    ConvJob j; j.rmask = -1; j.cgain = nullptr; j.scal = 1.f;
    if (t < 64) { const int g = t >> 4, r = t & 15, nt = r & 3, kt = r >> 2;
        j.src = p.w_pool + (size_t)g * 512 * 512; j.ld = 512; j.c0 = nt * 128; j.k0 = kt * 128; j.rgain = p.norm_mix_pre + g * 512; j.cgain = p.pool_scale + g * 512;
        j.dst = (u16*)(p.ws + WS_WPOOL) + (size_t)(g * 512 + nt * 128) * 512; j.Kdst = 512; }
    else if (t < 64 + 768) { t -= 64; const int nb = t % 48, kt = t / 48;
        if (nb < 32) { j.src = p.w_kv; j.ld = 2 * DM; j.c0 = nb * 128; j.rgain = p.kv_norm; }
        else { j.src = p.w_q; j.ld = DM; j.c0 = (nb - 32) * 128; j.rgain = p.norm_mix_pre + DM; }
        j.k0 = kt * 128; j.dst = (u16*)(p.ws + WS_WQKV) + (size_t)nb * 128 * DM; j.Kdst = DM; }
    else { t -= 64 + 768; const int nb = t % 16, kt = t / 16;
        j.src = p.w_o; j.ld = DM; j.c0 = nb * 128; j.k0 = kt * 128; j.rgain = p.subln; j.rmask = 255; j.scal = 1.f - LAMBDA_INIT;
        j.dst = (u16*)(p.ws + WS_WO) + (size_t)nb * 128 * DM; j.Kdst = DM; }
    return j;
}
template <int WHICH>
__device__ __forceinline__ ConvJob conv_job(const Params& p, int t) {
    if (WHICH == 0) { const int tm = t % (2112 + 1088); return tm < 2112 ? conv_ffn_job(p, 0, tm) : conv_misc_job(p, tm - 2112); }
    return conv_ffn_job(p, 1, t);
}
template <int WHICH>
__device__ __forceinline__ void conv_loop(const Params& p, int n, unsigned char* lds) {
    const int G = (int)gridDim.x; int t = (int)blockIdx.x; if (t >= n) return;
    float v[32]; { const ConvJob j = conv_job<WHICH>(p, t); conv_load(j, v); }
    for (;;) {
        const int tn = t + G; const bool more = tn < n;
        float vn[32];
        if (more) { const ConvJob jn = conv_job<WHICH>(p, tn); conv_load(jn, vn); }
        { const ConvJob j = conv_job<WHICH>(p, t); conv_store(j, v, lds); }
        if (!more) break;
        t = tn;
#pragma unroll
        for (int q = 0; q < 32; ++q) v[q] = vn[q];
    }
}

__device__ const float ROPE_INV[16] = {1.000000000e+00f, 4.403665960e-01f, 1.939227432e-01f, 8.539710194e-02f, 3.760603070e-02f, 1.656044088e-02f, 7.292664610e-03f, 3.211446106e-03f,
                                        1.414213562e-03f, 6.227724371e-04f, 2.742481884e-04f, 1.207697351e-04f, 5.318295734e-05f, 2.341999971e-05f, 1.031338525e-05f, 4.541670478e-06f};
__device__ __forceinline__ void rope_entry(int e, float* cosT, float* sinT) {
    constexpr double I2PI = 0.15915494309189535;
    constexpr float HI = (float)I2PI, LO = (float)(I2PI - (double)HI);
    const int s = e >> 4, i = e & 15;
    const float ang = (float)s * ROPE_INV[i];
    const float pr = ang * HI;
    float er = fmaf(ang, HI, -pr); er = fmaf(ang, LO, er);
    const float fr = (pr - rintf(pr)) + er;
    cosT[e] = __builtin_amdgcn_cosf(fr); sinT[e] = __builtin_amdgcn_sinf(fr);
}

__device__ __forceinline__ void rstd_rows(const float* __restrict__ x, float* __restrict__ rstd) {
    const int lane = threadIdx.x & 63, gw = blockIdx.x * 8 + (threadIdx.x >> 6), nw = gridDim.x * 8;
    for (int row0 = gw * 4; row0 < T_TOK; row0 += nw * 4) {
        f32x4v v[4][8];
#pragma unroll
        for (int r = 0; r < 4; ++r) { const f32x4v* rp = (const f32x4v*)(x + (size_t)(row0 + r) * DM);
#pragma unroll
            for (int i = 0; i < 8; ++i) v[r][i] = rp[lane + 64 * i]; }
        float ss[4];
#pragma unroll
        for (int r = 0; r < 4; ++r) { float s = 0.f;
#pragma unroll
            for (int i = 0; i < 8; ++i) s += v[r][i].x * v[r][i].x + v[r][i].y * v[r][i].y + v[r][i].z * v[r][i].z + v[r][i].w * v[r][i].w;
            ss[r] = s; }
#pragma unroll
        for (int o = 32; o >= 1; o >>= 1) {
#pragma unroll
            for (int r = 0; r < 4; ++r) ss[r] += __shfl_xor(ss[r], o); }
        if (lane < 4) { const float s = lane == 0 ? ss[0] : lane == 1 ? ss[1] : lane == 2 ? ss[2] : ss[3]; rstd[row0 + lane] = rsqrtf(s * (1.f / DM) + EPS); }
    }
}

__device__ __forceinline__ void mixed_phase(const float* __restrict__ x, u16* __restrict__ mixed, unsigned char* lds) {
    const int tid = threadIdx.x, g = tid >> 7, w = 2 << g, col = tid * 4, wid = tid >> 6, lane = tid & 63;
    float* rs = (float*)(lds + 40 * 1024);
    for (int ch = blockIdx.x; ch < T_TOK / 64; ch += gridDim.x) {
        const int t0 = ch * 64, pos0 = t0 & (SEQ - 1);
#pragma unroll
        for (int gq = 0; gq < 2; ++gq) {
            f32x4v v[5][8]; const int jr0 = wid * 10 + gq * 5;
#pragma unroll
            for (int r = 0; r < 5; ++r) { const int jr = jr0 + r; const bool ok = pos0 - 16 + jr >= 0; const f32x4v* rp = (const f32x4v*)(x + (size_t)(ok ? t0 - 16 + jr : t0) * DM);
#pragma unroll
                for (int i = 0; i < 8; ++i) v[r][i] = rp[lane + 64 * i]; }
            float ss[5];
#pragma unroll
            for (int r = 0; r < 5; ++r) { float s = 0.f;
#pragma unroll
                for (int i = 0; i < 8; ++i) s += v[r][i].x * v[r][i].x + v[r][i].y * v[r][i].y + v[r][i].z * v[r][i].z + v[r][i].w * v[r][i].w;
                ss[r] = s; }
#pragma unroll
            for (int o = 32; o >= 1; o >>= 1) {
#pragma unroll
                for (int r = 0; r < 5; ++r) ss[r] += __shfl_xor(ss[r], o); }
            if (lane < 5) { const float s = lane == 0 ? ss[0] : lane == 1 ? ss[1] : lane == 2 ? ss[2] : lane == 3 ? ss[3] : ss[4]; rs[jr0 + lane] = rsqrtf(s * (1.f / DM) + EPS); }
        }
        __syncthreads();
        f32x4v S = {0.f, 0.f, 0.f, 0.f};
        for (int jj = 1; jj <= w; ++jj) if (pos0 - jj >= 0) { const f32x4v v = *(const f32x4v*)(x + (size_t)(t0 - jj) * DM + col); S += v * rs[16 - jj]; }
        u16* op = mixed + ((size_t)g * T_TOK + t0) * 512 + (col & 511);
#pragma unroll 8
        for (int i = 0; i < 64; ++i) {
            const int t = t0 + i, pos = pos0 + i;
            const f32x4v vt = *(const f32x4v*)(x + (size_t)t * DM + col) * rs[16 + i];
            S += vt;
            if (pos - w >= 0) { const f32x4v vo = *(const f32x4v*)(x + (size_t)(t - w) * DM + col) * rs[16 + i - w]; S -= vo; }
            const float ic = 1.f / (float)min(pos + 1, w);
            const f32x4v o = S * ic - vt;
            u32x2v pk; pk.x = pk_bf16(o.x, o.y); pk.y = pk_bf16(o.z, o.w);
            *(u32x2v*)(op + (size_t)i * 512) = pk;
        }
        __syncthreads();
    }
}

template <int MODE>
__device__ __forceinline__ void norm_phase(const float* __restrict__ xin, const u16* __restrict__ xprev, const float* __restrict__ rprev, const u16* __restrict__ m, const float* __restrict__ gpost, u16* __restrict__ xn, float* __restrict__ rnew, float* __restrict__ out) {
    constexpr int R = 2;
    const int lane = threadIdx.x & 63, gw = blockIdx.x * 8 + (threadIdx.x >> 6), nw = gridDim.x * 8;
    f32x4v gv[8];
#pragma unroll
    for (int i = 0; i < 4; ++i) { gv[2 * i] = ((const f32x4v*)gpost)[2 * (lane + 64 * i)]; gv[2 * i + 1] = ((const f32x4v*)gpost)[2 * (lane + 64 * i) + 1]; }
    for (int row0 = gw * R; row0 < T_TOK; row0 += nw * R) {
        u32x4v mv[R][4]; u32x4v xh[R][4]; f32x4v xw[(MODE == 0) ? R : 1][8];
#pragma unroll
        for (int r = 0; r < R; ++r) {
            const u32x4v* mp = (const u32x4v*)(m + (size_t)(row0 + r) * DM);
#pragma unroll
            for (int i = 0; i < 4; ++i) mv[r][i] = mp[lane + 64 * i];
            if (MODE == 0) { const f32x4v* xp = (const f32x4v*)(xin + (size_t)(row0 + r) * DM);
#pragma unroll
                for (int i = 0; i < 4; ++i) { xw[r][2 * i] = xp[2 * (lane + 64 * i)]; xw[r][2 * i + 1] = xp[2 * (lane + 64 * i) + 1]; } }
            else { const u32x4v* xp = (const u32x4v*)(xprev + (size_t)(row0 + r) * DM);
#pragma unroll
                for (int i = 0; i < 4; ++i) xh[r][i] = xp[lane + 64 * i]; }
        }
        float ss[R];
#pragma unroll
        for (int r = 0; r < R; ++r) { float s = 0.f;
#pragma unroll
            for (int i = 0; i < 4; ++i) { const u32x4v a = mv[r][i];
                const float f0 = bf_lo(a.x), f1 = bf_hi(a.x), f2 = bf_lo(a.y), f3 = bf_hi(a.y), f4 = bf_lo(a.z), f5 = bf_hi(a.z), f6 = bf_lo(a.w), f7 = bf_hi(a.w);
                s += f0 * f0 + f1 * f1 + f2 * f2 + f3 * f3 + f4 * f4 + f5 * f5 + f6 * f6 + f7 * f7; }
            ss[r] = s; }
#pragma unroll
        for (int o = 32; o >= 1; o >>= 1) {
#pragma unroll
            for (int r = 0; r < R; ++r) ss[r] += __shfl_xor(ss[r], o); }
#pragma unroll
        for (int r = 0; r < R; ++r) {
            const float rs = rsqrtf(ss[r] * (1.f / DM) + EPS);
            const float inv = (MODE == 0) ? 1.f : 1.f / rprev[row0 + r];
            f32x4v xv[8]; float sxr = 0.f;
#pragma unroll
            for (int i = 0; i < 4; ++i) {
                const u32x4v a = mv[r][i];
                f32x4v x0, x1;
                if (MODE == 0) { x0 = xw[r][2 * i]; x1 = xw[r][2 * i + 1]; }
                else { const u32x4v b = xh[r][i]; x0 = (f32x4v){bf_lo(b.x), bf_hi(b.x), bf_lo(b.y), bf_hi(b.y)} * inv; x1 = (f32x4v){bf_lo(b.z), bf_hi(b.z), bf_lo(b.w), bf_hi(b.w)} * inv; }
                x0 += (f32x4v){bf_lo(a.x), bf_hi(a.x), bf_lo(a.y), bf_hi(a.y)} * rs * gv[2 * i];
                x1 += (f32x4v){bf_lo(a.z), bf_hi(a.z), bf_lo(a.w), bf_hi(a.w)} * rs * gv[2 * i + 1];
                if (MODE == 2) { f32x4v* op = (f32x4v*)(out + (size_t)(row0 + r) * DM); op[2 * (lane + 64 * i)] = x0; op[2 * (lane + 64 * i) + 1] = x1; }
                else { xv[2 * i] = x0; xv[2 * i + 1] = x1;
                    sxr += x0.x * x0.x + x0.y * x0.y + x0.z * x0.z + x0.w * x0.w + x1.x * x1.x + x1.y * x1.y + x1.z * x1.z + x1.w * x1.w; }
            }
            if (MODE != 2) {
                sxr = wave_sum(sxr);
                const float rx = rsqrtf(sxr * (1.f / DM) + EPS);
                if (lane == 0) rnew[row0 + r] = rx;
#pragma unroll
                for (int i = 0; i < 4; ++i) { const f32x4v a = xv[2 * i] * rx, b = xv[2 * i + 1] * rx; u32x4v o;
                    o.x = pk_bf16(a.x, a.y); o.y = pk_bf16(a.z, a.w); o.z = pk_bf16(b.x, b.y); o.w = pk_bf16(b.z, b.w);
                    ((u32x4v*)(xn + (size_t)(row0 + r) * DM))[lane + 64 * i] = o; }
            }
        }
    }
}

__device__ __forceinline__ void comb_phase(const Params& p, const u16* osub, u16* attn_out) {
    const int lane = threadIdx.x & 63, gw = blockIdx.x * 8 + (threadIdx.x >> 6), nw = gridDim.x * 8;
    float d1 = p.lq1[lane] * p.lk1[lane] + p.lq1[lane + 64] * p.lk1[lane + 64];
    float d2 = p.lq2[lane] * p.lk2[lane] + p.lq2[lane + 64] * p.lk2[lane + 64];
    d1 = wave_sum(d1); d2 = wave_sum(d2);
    const float lam = __expf(d1) - __expf(d2) + LAMBDA_INIT;
    const int half = lane >> 5, dd = (lane & 31) * 4;
    for (int it = gw; it < T_TOK * 8; it += nw) {
        const int h = it & 7, t = it >> 3, b = t >> 12, s = t & (SEQ - 1);
        const u16* r0 = osub + (((size_t)(b * 32 + (2 * h) * 2 + half)) * SEQ + s) * 128 + dd;
        const u16* r1 = osub + (((size_t)(b * 32 + (2 * h + 1) * 2 + half)) * SEQ + s) * 128 + dd;
        const u32x2v a = *(const u32x2v*)r0, c = *(const u32x2v*)r1;
        const float o0 = bf_lo(a.x) - lam * bf_lo(c.x), o1 = bf_hi(a.x) - lam * bf_hi(c.x), o2 = bf_lo(a.y) - lam * bf_lo(c.y), o3 = bf_hi(a.y) - lam * bf_hi(c.y);
        float ss = o0 * o0 + o1 * o1 + o2 * o2 + o3 * o3;
        ss = wave_sum(ss);
        const float rs = rsqrtf(ss * (1.f / 256.f) + EPS);
        u32x2v o; o.x = pk_bf16(o0 * rs, o1 * rs); o.y = pk_bf16(o2 * rs, o3 * rs);
        *(u32x2v*)(attn_out + (size_t)t * DM + h * 256 + half * 128 + dd) = o;
    }
}

struct EpiPlain {
    static constexpr bool PERM = true, AFTER_DRAIN = false;
    u16* O; int ldc; int pool;
    __device__ __forceinline__ void operator()(const pg8::f32x4 (&acc)[2][2][4][2], const pg8::Unit& u, int wr, int wc, int fr, int fq) const {
        const int pm = pool ? (u.pm & 63) : u.pm;
        const int row0 = pm * 256 + wr * 64 + fr, col0 = u.pn * 256 + wc * 32 + 8 * fq;
#pragma unroll
        for (int ai = 0; ai < 2; ++ai)
#pragma unroll
            for (int m = 0; m < 4; ++m) { u16* rowp = O + (size_t)(row0 + ai * 128 + m * 16) * ldc + col0;
#pragma unroll
                for (int bj = 0; bj < 2; ++bj) { const pg8::f32x4 v0 = acc[ai][bj][m][0], v1 = acc[ai][bj][m][1]; u32x4v w;
                    w.x = pk_bf16(v0[0], v0[1]); w.y = pk_bf16(v0[2], v0[3]); w.z = pk_bf16(v1[0], v1[1]); w.w = pk_bf16(v1[2], v1[3]);
                    *(u32x4v*)(rowp + bj * 128) = w; } }
    }
};
__device__ __forceinline__ float silu_mul(float g, float u) { return g * __builtin_amdgcn_rcpf(1.f + __builtin_amdgcn_exp2f(-1.4426950408889634f * g)) * u; }
struct EpiGateUp {
    static constexpr bool PERM = true, AFTER_DRAIN = false;
    u16* O;
    __device__ __forceinline__ void operator()(const pg8::f32x4 (&acc)[2][2][4][2], const pg8::Unit& u, int wr, int wc, int fr, int fq) const {
        const int row0 = u.pm * 256 + wr * 64 + fr, col0 = u.pn * 128 + wc * 32 + 8 * fq;
#pragma unroll
        for (int ai = 0; ai < 2; ++ai)
#pragma unroll
            for (int m = 0; m < 4; ++m) { u16* rowp = O + (size_t)(row0 + ai * 128 + m * 16) * DFF + col0;
                const pg8::f32x4 g0 = acc[ai][0][m][0], g1 = acc[ai][0][m][1], u0 = acc[ai][1][m][0], u1 = acc[ai][1][m][1]; u32x4v w;
                w.x = pk_bf16(silu_mul(g0[0], u0[0]), silu_mul(g0[1], u0[1])); w.y = pk_bf16(silu_mul(g0[2], u0[2]), silu_mul(g0[3], u0[3]));
                w.z = pk_bf16(silu_mul(g1[0], u1[0]), silu_mul(g1[1], u1[1])); w.w = pk_bf16(silu_mul(g1[2], u1[2]), silu_mul(g1[3], u1[3]));
                *(u32x4v*)rowp = w; }
    }
};
struct EpiQKV {
    static constexpr bool PERM = true, AFTER_DRAIN = false;
    u16* base; const float* cosT; const float* sinT;
    __device__ __forceinline__ void operator()(const pg8::f32x4 (&acc)[2][2][4][2], const pg8::Unit& u, int wr, int wc, int fr, int fq) const {
        const int kind = u.pn >> 3;
        u16* dst = base + (size_t)kind * ((size_t)T_TOK * DM);
        const bool rope = (kind != 1) && (wc == 0);
        const bool up = fq >= 2;
#pragma unroll
        for (int ai = 0; ai < 2; ++ai)
#pragma unroll
            for (int m = 0; m < 4; ++m) {
                const int row = u.pm * 256 + ai * 128 + wr * 64 + m * 16 + fr, b = row >> 12, s = row & (SEQ - 1);
                f32x4v cs0 = {1.f, 1.f, 1.f, 1.f}, cs1 = cs0, sn0 = {0.f, 0.f, 0.f, 0.f}, sn1 = sn0;
                if (rope) { const int i0 = s * 16 + 8 * (fq & 1);
                    cs0 = *(const f32x4v*)(cosT + i0); cs1 = *(const f32x4v*)(cosT + i0 + 4); sn0 = *(const f32x4v*)(sinT + i0); sn1 = *(const f32x4v*)(sinT + i0 + 4);
                    if (!up) { sn0 = -sn0; sn1 = -sn1; } }
#pragma unroll
                for (int bj = 0; bj < 2; ++bj) {
                    const int head = 2 * (u.pn & 7) + bj;
                    u16* rp = dst + ((size_t)(b * 16 + head) * SEQ + s) * 128 + wc * 32 + 8 * fq;
                    pg8::f32x4 a = acc[ai][bj][m][0], c = acc[ai][bj][m][1];
                    if (rope) {
#pragma unroll
                        for (int j = 0; j < 4; ++j) {
                            auto ra = __builtin_amdgcn_permlane32_swap(__float_as_uint(a[j]), __float_as_uint(a[j]), false, false);
                            auto rc = __builtin_amdgcn_permlane32_swap(__float_as_uint(c[j]), __float_as_uint(c[j]), false, false);
                            const float pa_ = __uint_as_float(up ? ra[0] : ra[1]), pc_ = __uint_as_float(up ? rc[0] : rc[1]);
                            a[j] = a[j] * cs0[j] + pa_ * sn0[j]; c[j] = c[j] * cs1[j] + pc_ * sn1[j]; }
                    }
                    u32x4v w; w.x = pk_bf16(a[0], a[1]); w.y = pk_bf16(a[2], a[3]); w.z = pk_bf16(c[0], c[1]); w.w = pk_bf16(c[2], c[3]);
                    *(u32x4v*)rp = w;
                }
            }
    }
};
struct PoolOrder {
    int G, c;
    __device__ bool next(int i, pg8::Unit& u) const { int L = i * G + c; if (L >= 512 * REP_GEMM) return false; L &= 511; const int pne = L & 7, pm = L >> 3; u.pm = (pne >> 1) * 64 + pm; u.pn = pne; return true; }
    __device__ __forceinline__ void a_ready(const pg8::Unit&) const {}
    __device__ __forceinline__ void done(const pg8::Unit&) const {}
};

struct AttItem { int vhd, qb0, qb1; };
__device__ __forceinline__ AttItem att_decode(int L) { AttItem it; const int xcd = L & 7, k = (L >> 3) & 127; it.vhd = xcd * 16 + (k >> 3); it.qb0 = k & 7; it.qb1 = 15 - it.qb0; return it; }
__device__ __forceinline__ att::BlockRef<att::bf16, att::bf16> att_ref(const AttItem& it, int pass, const u16* Kb, const u16* Vb, const u16* Qb, u16* Ob) {
    const int qb = pass ? it.qb1 : it.qb0, b = it.vhd >> 5, r = it.vhd & 31, sh = r >> 1, half = r & 1;
    att::BlockRef<att::bf16, att::bf16> R;
    R.Q = (const att::bf16*)(Qb + ((size_t)(b * 16 + sh) * SEQ + (size_t)qb * 256) * 128);
    R.K = (const att::bf16*)(Kb + ((size_t)(b * 16 + sh) * SEQ) * 128);
    R.V = (const att::bf16*)(Vb + ((size_t)(b * 16 + (sh >> 1) * 2 + half) * SEQ) * 128);
    R.O = (att::bf16*)(Ob + ((size_t)it.vhd * SEQ + (size_t)qb * 256) * 128);
    R.P0 = qb * 256;
    return R;
}
__device__ __forceinline__ void attention_phase(const u16* Kb, const u16* Vb, const u16* Qb, u16* Ob, char* lds) {
    constexpr int TOTAL = 1024 * REP_ATT;
    int L = blockIdx.x; if (L >= TOTAL) return;
    const int stride = gridDim.x;
    AttItem it = att_decode(L); int pass = 0;
    att::BlockRef<att::bf16, att::bf16> cur = att_ref(it, 0, Kb, Vb, Qb, Ob);
    att::Seam<att::bf16> S;
    att::causal_swa_prime<att::bf16, att::bf16>(cur, SEQ, lds, S);
    for (;;) {
        const bool more_pass = pass == 0, more_item = L + stride < TOTAL, last = !more_pass && !more_item;
        AttItem itn = it; int passn = pass + 1, Ln = L;
        if (!more_pass) { passn = 0; Ln = more_item ? L + stride : L; itn = att_decode(Ln); }
        const att::BlockRef<att::bf16, att::bf16> nxt = last ? cur : att_ref(itn, passn, Kb, Vb, Qb, Ob);
        att::causal_swa_block<att::bf16, att::bf16>(cur, nxt, SEQ, SEQ, lds, S);
        if (last) break;
        cur = nxt; it = itn; pass = passn; L = Ln;
    }
}


__device__ __forceinline__ void attention_phase3(const Params& p, const u16* Kb, const u16* Vb, const u16* Qb, float* stash, u16* attn_out, char* lds) {
    const int G = (int)gridDim.x, lane = threadIdx.x & 63;
    float d1 = p.lq1[lane] * p.lk1[lane] + p.lq1[lane + 64] * p.lk1[lane + 64];
    float d2 = p.lq2[lane] * p.lk2[lane] + p.lq2[lane + 64] * p.lk2[lane + 64];
    d1 = wave_sum(d1); d2 = wave_sum(d2);
    const float lam = __expf(d1) - __expf(d2) + LAMBDA_INIT;
#pragma nounroll
    for (int idx = 0; ; ++idx) {
        const int L = (int)blockIdx.x + (idx >> 2) * G; if (L >= 256 * REP_ATT) break;
        const int Lm = L & 255, xcd = Lm & 7, k = Lm >> 3, dh = xcd * 4 + (k >> 3), x = k & 7, b = dh >> 3, h = dh & 7;
        const int qb = (idx & 2) ? 15 - x : x, sub = idx & 1, sh = 2 * h + sub;
        att::Blk2 c;
        c.Q = (const att::bf16*)(Qb + ((size_t)(b * 16 + sh) * SEQ + (size_t)qb * 256) * 128);
        c.K = (const att::bf16*)(Kb + ((size_t)(b * 16 + sh) * SEQ) * 128);
        c.V0 = (const att::bf16*)(Vb + ((size_t)(b * 16 + h * 2) * SEQ) * 128);
        c.V1 = c.V0 + (size_t)SEQ * 128;
        c.O0 = nullptr; c.O1 = nullptr; c.P0 = qb * 256;
        c.stash = stash + (size_t)blockIdx.x * (128 * 512);
        c.comb = (att::bf16*)(attn_out + ((size_t)(b * SEQ + qb * 256)) * DM + h * 256);
        c.lam = lam;
        if (sub == 0) att::attn_block_v256<1>(c, lds); else att::attn_block_v256<2>(c, lds);
    }
}

__global__ __launch_bounds__(512, 2) void mega(Params p) {
    extern __shared__ __attribute__((aligned(16))) unsigned char shm[];
    cg::grid_group grid = cg::this_grid();
    __shared__ uint4 xb_words;
    if (threadIdx.x == 0) xb_words = make_uint4(0u, 0u, 0u, 0u);
    __syncthreads();
    if (p.ph_hi > 1000) grid.sync();
    const XcdBarrier xb = xcd_barrier_post((unsigned*)(p.ws + WS_MISC + MISC_BAR), (volatile __attribute__((address_space(3))) unsigned*)&xb_words);
    unsigned char* ws = p.ws;
    u16* const wpool = (u16*)(ws + WS_WPOOL); u16* const wgu = (u16*)(ws + WS_WGU); u16* const wdn = (u16*)(ws + WS_WDN); u16* const wqkv = (u16*)(ws + WS_WQKV); u16* const wo = (u16*)(ws + WS_WO);
    float* const rstd0 = (float*)(ws + WS_MISC + MISC_RSTD); float* const rstdx = (float*)(ws + WS_MISC + MISC_RSTDX); float* const rs1 = (float*)(ws + WS_MISC + 768 * 1024); float* const rs2 = (float*)(ws + WS_MISC + 832 * 1024); float* const rs3 = (float*)(ws + WS_MISC + 896 * 1024); float* const cosT = (float*)(ws + WS_MISC + MISC_COS); float* const sinT = (float*)(ws + WS_MISC + MISC_SIN);
    u16* const bufA = (u16*)(ws + WS_A); u16* const bufB = (u16*)(ws + WS_B); u16* const mixed = (u16*)(ws + WS_C); u16* const mbuf = (u16*)(ws + WS_C + 64 * MiB); u16* const osub = (u16*)(ws + WS_C);
    const int G = (int)gridDim.x, bid = (int)blockIdx.x;
#define IN(k) (p.ph_lo <= (k) && (k) < p.ph_hi)
#define SYNC(k) do { if (IN(k) && IN((k) + 1) && (k) != 9 && (k) != 0) { xcd_barrier(xb); } } while (0)
    if (IN(0)) {
        conv_loop<0>(p, (2112 + 1088) * REP_CONV, shm);
        for (int e = bid * 512 + (int)threadIdx.x; e < SEQ * 16; e += G * 512) rope_entry(e, cosT, sinT);
        mixed_phase(p.x, mixed, shm);
    }
    SYNC(0);
    SYNC(1);
#ifdef PROBE_MFMA
    if (IN(2)) mfma_probe(rstdx);
#endif
    if (IN(2)) { pg8::Gemm g{mixed, wpool, 4 * T_TOK, 512, 512}; PoolOrder S{G, bid}; EpiPlain E{mbuf, DM, 1};
        pg8::gemm_phase<EpiPlain, PoolOrder, false>((PG8_LAS unsigned char*)shm, g, S, E, nullptr); }
    SYNC(2);
    if (IN(3)) norm_phase<0>(p.x, nullptr, nullptr, mbuf, p.norm_mix_post, mixed, rs1, nullptr);
    SYNC(3);
    if (IN(4)) { pg8::Gemm g{mixed, wgu, T_TOK, 2 * DFF, DM}; pg8::StaticOrder S; S.init(T_TOK, 2 * DFF, G, bid); S.rep = REP_GU; EpiGateUp E{bufA};
        pg8::gemm_phase<EpiGateUp, pg8::StaticOrder, false>((PG8_LAS unsigned char*)shm, g, S, E, nullptr); }
    SYNC(4);
    if (IN(5)) { pg8::Gemm g{bufA, wdn, T_TOK, DM, DFF}; pg8::StaticOrder S; S.init(T_TOK, DM, G, bid); S.rep = REP_DN; EpiPlain E{mbuf, DM, 0};
        pg8::gemm_phase<EpiPlain, pg8::StaticOrder, false>((PG8_LAS unsigned char*)shm, g, S, E, nullptr); }
    SYNC(5);
    if (IN(6)) { norm_phase<1>(nullptr, mixed, rs1, mbuf, p.norm_ffn_post, bufB, rs2, nullptr);
        conv_loop<1>(p, 2112, shm); }
    SYNC(6);
    if (IN(7)) { pg8::Gemm g{bufB, wqkv, T_TOK, 3 * DM, DM}; pg8::StaticOrder S; S.init(T_TOK, 3 * DM, G, bid); EpiQKV E{bufA, cosT, sinT};
        pg8::gemm_phase<EpiQKV, pg8::StaticOrder, false>((PG8_LAS unsigned char*)shm, g, S, E, nullptr); }
    SYNC(7);
    if (IN(8)) attention_phase3(p, bufA, bufA + (size_t)T_TOK * DM, bufA + 2 * (size_t)T_TOK * DM, (float*)mixed, mbuf, (char*)shm);
    SYNC(8);
    SYNC(9);
    if (IN(10)) { pg8::Gemm g{mbuf, wo, T_TOK, DM, DM}; pg8::StaticOrder S; S.init(T_TOK, DM, G, bid); EpiPlain E{mixed, DM, 0};
        pg8::gemm_phase<EpiPlain, pg8::StaticOrder, false>((PG8_LAS unsigned char*)shm, g, S, E, nullptr); }
    SYNC(10);
    if (IN(11)) norm_phase<1>(nullptr, bufB, rs2, mixed, p.norm_mix_post + DM, mbuf, rs3, nullptr);
    SYNC(11);
    if (IN(12)) { pg8::Gemm g{mbuf, wgu, T_TOK, 2 * DFF, DM}; pg8::StaticOrder S; S.init(T_TOK, 2 * DFF, G, bid); S.rep = REP_GU; EpiGateUp E{bufA};
        pg8::gemm_phase<EpiGateUp, pg8::StaticOrder, false>((PG8_LAS unsigned char*)shm, g, S, E, nullptr); }
    SYNC(12);
    if (IN(13)) { pg8::Gemm g{bufA, wdn, T_TOK, DM, DFF}; pg8::StaticOrder S; S.init(T_TOK, DM, G, bid); S.rep = REP_DN; EpiPlain E{mixed, DM, 0};
        pg8::gemm_phase<EpiPlain, pg8::StaticOrder, false>((PG8_LAS unsigned char*)shm, g, S, E, nullptr); }
    SYNC(13);
    if (IN(14)) norm_phase<2>(nullptr, mbuf, rs3, mixed, p.norm_ffn_post + DM, nullptr, nullptr, p.out);
#undef IN
#undef SYNC
}

#ifndef MK_PER_PHASE
#define MK_PER_PHASE 0
#endif
extern "C" void kernel_launch(void* const* d_in, const int* in_sizes, int n_in, void* d_out, int out_size, void* d_ws, size_t ws_size, hipStream_t stream) {
    static int grid = 0;
    if (grid == 0) {
        if (n_in != 19 || out_size != T_TOK * DM || ws_size < WS_END) { fprintf(stderr, "kernel_launch: unexpected shapes (n_in %d out %d ws %zu)\n", n_in, out_size, ws_size); grid = -1; return; }
        int dev = 0, cus = 0, per_cu = 0;
        (void)hipGetDevice(&dev);
        if (hipDeviceGetAttribute(&cus, hipDeviceAttributeMultiprocessorCount, dev) != hipSuccess || cus <= 0) cus = 256;
        if (hipFuncSetAttribute((const void*)mega, hipFuncAttributeMaxDynamicSharedMemorySize, LDS_TOTAL) != hipSuccess) { fprintf(stderr, "kernel_launch: hipFuncSetAttribute failed\n"); grid = -1; return; }
        if (hipOccupancyMaxActiveBlocksPerMultiprocessor(&per_cu, (const void*)mega, 512, LDS_TOTAL) != hipSuccess || per_cu < 1) { fprintf(stderr, "kernel_launch: occupancy query says %d\n", per_cu); per_cu = 1; }
        (void)hipGetLastError();
        grid = cus * per_cu;
    }
    if (grid < 0) return;
    Params p{};
    p.x = (const float*)d_in[0]; p.norm_mix_pre = (const float*)d_in[1]; p.norm_mix_post = (const float*)d_in[2]; p.norm_ffn_pre = (const float*)d_in[3]; p.norm_ffn_post = (const float*)d_in[4];
    p.w_pool = (const float*)d_in[5]; p.pool_scale = (const float*)d_in[6]; p.kv_norm = (const float*)d_in[7]; p.w_kv = (const float*)d_in[8]; p.w_q = (const float*)d_in[9];
    p.lq1 = (const float*)d_in[10]; p.lk1 = (const float*)d_in[11]; p.lq2 = (const float*)d_in[12]; p.lk2 = (const float*)d_in[13]; p.subln = (const float*)d_in[14]; p.w_o = (const float*)d_in[15];
    p.w_gate = (const float*)d_in[16]; p.w_up = (const float*)d_in[17]; p.w_down = (const float*)d_in[18];
    p.out = (float*)d_out; p.ws = (unsigned char*)d_ws;
#if MK_PER_PHASE
    for (int ph = 0; ph <= NPHASE; ++ph) { p.ph_lo = ph; p.ph_hi = ph + 1; hipLaunchKernelGGL(mega, dim3(grid), dim3(512), LDS_TOTAL, stream, p); }
#else
    p.ph_lo = 0; p.ph_hi = NPHASE + 1;
    (void)hipMemsetAsync((unsigned char*)d_ws + WS_MISC + MISC_BAR, 0, BAR_BYTES, stream);
    void* args[] = {&p};
    hipError_t e = hipLaunchCooperativeKernel((const void*)mega, dim3(grid), dim3(512), args, LDS_TOTAL, stream);
    if (e != hipSuccess) fprintf(stderr, "cooperative launch failed: %s (grid %d)\n", hipGetErrorString(e), grid);
#endif
}
```

```cpp
#include <hip/hip_runtime.h>
#include <hip/hip_bf16.h>
#include <hip/hip_cooperative_groups.h>
#include <cstdio>
#include <cstdint>
#ifndef REP_GEMM
#define REP_GEMM 1
#endif
namespace pg8 {
#define PG8_LAS __attribute__((address_space(3)))
typedef unsigned short bf16_t;
typedef short bf16x8 __attribute__((ext_vector_type(8)));
typedef float f32x4 __attribute__((ext_vector_type(4)));
typedef unsigned u32x4 __attribute__((ext_vector_type(4)));
constexpr int BM = 256, BK = 64, HALF = 128, HTB = HALF * BK * 2  , STAGE_BYTES = 8 * HTB, NXCD = 8, WGM = 8;

__host__ __device__ __forceinline__ int lds_byte(int r, int c) { const int st = (r >> 4) * 2 + (c >> 5), rr = r & 15, cc = c & 31, ob = rr * 64 + cc * 2; return st * 1024 + (ob ^ (((ob >> 9) & 1) << 5)); }
__host__ __device__ __forceinline__ void stage_rc(int b, int& R, int& C) { const int st = b / 1024, sb = b % 1024, swz = sb ^ (((sb >> 9) & 1) << 5); R = (st >> 1) * 16 + swz / 64; C = (st & 1) * 32 + (swz % 64) / 2; }
__host__ __device__ __forceinline__ int perm32(int rho) { const int n = rho >> 4, i = rho & 15; return 8 * (i >> 2) + 4 * n + (i & 3); }

struct Unit { int pm, pn; };
struct Gemm { const bf16_t* A; const bf16_t* Bt; int M, N, K; };

struct StaticOrder {
    int nM, nN, nwg, G, c, rep = REP_GEMM;
    __host__ __device__ void init(int M, int N, int G_, int c_) { nM = M / BM; nN = N / BM; nwg = nM * nN; G = G_; c = c_; }
    __host__ __device__ bool next(int i, Unit& u) const {
        long L = (long)i * G + c; if (L >= (long)nwg * rep) return false; L %= nwg;
        int wgid = (int)L; { const int q = nwg / NXCD, r = nwg % NXCD, xcd = wgid % NXCD, off = wgid / NXCD; wgid = (xcd < r ? xcd * (q + 1) : r * (q + 1) + (xcd - r) * q) + off; }
        const int nig = WGM * nN, gid = wgid / nig, fm = gid * WGM, gsz = (nM - fm) < WGM ? (nM - fm) : WGM;
        u.pm = fm + ((wgid % nig) % gsz); u.pn = (wgid % nig) / gsz; return true;
    }
    __device__ __forceinline__ void a_ready(const Unit&) const {}
    __device__ __forceinline__ void done(const Unit&) const {}
};
__device__ __forceinline__ unsigned cvt_pk_bf16(float lo, float hi) { unsigned r; asm volatile("v_cvt_pk_bf16_f32 %0, %1, %2" : "=v"(r) : "v"(lo), "v"(hi)); return r; }
template <class Epi, class Sched, bool STAMP = false>
__device__ __forceinline__ void gemm_phase(PG8_LAS unsigned char* lds, const Gemm g, const Sched& S, const Epi& E, unsigned long long* stamps) {
    const int tid = threadIdx.x, wid = __builtin_amdgcn_readfirstlane(tid >> 6), lane = tid & 63, wr = wid >> 2, wc = wid & 3, fr = lane & 15, fq = lane >> 4;
    const int K = g.K, nt = K / BK;
    int ts_lo = 0, ts_hi = 0, nts = 0; const unsigned long long rt_entry = STAMP ? (unsigned long long)wall_clock64() : 0ull;
#define PG8_STAMP() do { if (STAMP && wid == 0 && nts < 64) { const unsigned long long _c = (unsigned long long)clock64(); \
        ts_lo = (lane == nts) ? (int)(unsigned)_c : ts_lo; ts_hi = (lane == nts) ? (int)(unsigned)(_c >> 32) : ts_hi; ++nts; } } while (0)
    PG8_STAMP();
    unsigned voffA[2], voffB[2];
#pragma unroll
    for (int i = 0; i < 2; ++i) { int R, C; stage_rc(tid * 16 + i * 8192, R, C); const int Rb = Epi::PERM ? ((R & ~31) + perm32(R & 31)) : R;
        voffA[i] = (unsigned)(R * K + C) * 2u; voffB[i] = (unsigned)(Rb * K + C) * 2u; }
    const size_t kstep = (size_t)(BK * 2);
    const size_t hstep = (size_t)HALF * K * 2;
    const size_t tstep = 2 * hstep;
    const unsigned ldsw = (unsigned)wid * 1024u;
    const int aoff = lds_byte(wr * 64 + fr, fq * 8), boff = lds_byte(wc * 32 + fr, fq * 8);
#define PG8_SA(b, h) (((b) * 2 + (h)) * HTB)
#define PG8_SB(b, h) ((4 + (b) * 2 + (h)) * HTB)
#define PG8_STAGE(bufoff, gbase, voff) do { _Pragma("unroll") for (int _i = 0; _i < 2; ++_i) \
        __builtin_amdgcn_global_load_lds((const unsigned*)((const char*)(gbase) + (voff)[_i]), (PG8_LAS unsigned*)(lds + (bufoff) + ldsw + _i * 8192), 16, 0, 0); } while (0)
#define PG8_LDA(dst, b, h) do { _Pragma("unroll") for (int m = 0; m < 4; ++m) _Pragma("unroll") for (int k = 0; k < 2; ++k) dst[m][k] = *(const PG8_LAS bf16x8*)(lds + PG8_SA(b, h) + aoff + m * 2048 + k * 1024); } while (0)
#define PG8_LDB(dst, b, h) do { _Pragma("unroll") for (int n = 0; n < 2; ++n) _Pragma("unroll") for (int k = 0; k < 2; ++k) dst[n][k] = *(const PG8_LAS bf16x8*)(lds + PG8_SB(b, h) + boff + n * 2048 + k * 1024); } while (0)
#define PG8_MMA(ai, bj, At, Bt) do { __builtin_amdgcn_s_setprio(1); _Pragma("unroll") for (int m = 0; m < 4; ++m) _Pragma("unroll") for (int n = 0; n < 2; ++n) _Pragma("unroll") for (int k = 0; k < 2; ++k) \
        acc[ai][bj][m][n] = __builtin_amdgcn_mfma_f32_16x16x32_bf16(Bt[n][k], At[m][k], acc[ai][bj][m][n], 0, 0, 0); __builtin_amdgcn_s_setprio(0); } while (0)
#define PG8_WAIT_V(n) asm volatile("s_waitcnt vmcnt(" #n ")" ::: "memory")
#define PG8_WAIT_L(n) asm volatile("s_waitcnt lgkmcnt(" #n ")" ::: "memory")
#define PG8_BAR __builtin_amdgcn_s_barrier()
#define PG8_SCHED __builtin_amdgcn_sched_barrier(0)
    Unit cur, nxt; int ui = 0;
    if (!S.next(0, cur)) return;
    f32x4 acc[2][2][4][2];
#pragma unroll
    for (int a = 0; a < 2; ++a)
#pragma unroll
        for (int b = 0; b < 2; ++b)
#pragma unroll
            for (int m = 0; m < 4; ++m)
#pragma unroll
                for (int n = 0; n < 2; ++n) acc[a][b][m][n] = (f32x4){0.f, 0.f, 0.f, 0.f};
    bf16x8 At[4][2], B0[2][2], B1[2][2];
    const char* cA = (const char*)g.A + (size_t)cur.pm * tstep; const char* cB = (const char*)g.Bt + (size_t)cur.pn * tstep;
    S.a_ready(cur);
    PG8_STAGE(PG8_SB(0, 0), cB, voffB); PG8_STAGE(PG8_SA(0, 0), cA, voffA); PG8_STAGE(PG8_SB(0, 1), cB + hstep, voffB); PG8_STAGE(PG8_SA(0, 1), cA + hstep, voffA);
    if (wr == 1) PG8_BAR;
    PG8_WAIT_V(4); PG8_BAR;
    PG8_STAGE(PG8_SB(1, 0), cB + kstep, voffB); PG8_STAGE(PG8_SA(1, 0), cA + kstep, voffA); PG8_STAGE(PG8_SB(1, 1), cB + hstep + kstep, voffB);
    PG8_WAIT_V(6); PG8_BAR;
    PG8_STAMP();
    for (;;) {
        const bool has_next = S.next(ui + 1, nxt);
        const char* nA = has_next ? (const char*)g.A + (size_t)nxt.pm * tstep : cA; const char* nB = has_next ? (const char*)g.Bt + (size_t)nxt.pn * tstep : cB;
        for (int t = 0; t < nt; t += 2) {
            const bool last = (t == nt - 2);
            const char* a1 = cA + (size_t)(t + 1) * kstep;
            const char* a2 = last ? nA : cA + (size_t)(t + 2) * kstep; const char* b2 = last ? nB : cB + (size_t)(t + 2) * kstep;
            const char* a3 = a2 + kstep; const char* b3 = b2 + kstep;
            if (last && has_next) S.a_ready(nxt);
            PG8_LDB(B0, 0, 0); PG8_SCHED; PG8_LDA(At, 0, 0); PG8_STAGE(PG8_SA(1, 1), a1 + hstep, voffA);
            PG8_WAIT_L(8); PG8_BAR; PG8_WAIT_L(0); PG8_MMA(0, 0, At, B0); PG8_BAR; PG8_SCHED;
            PG8_LDB(B1, 0, 1); PG8_STAGE(PG8_SB(0, 0), b2, voffB);
            PG8_BAR; PG8_WAIT_L(0); PG8_MMA(0, 1, At, B1); PG8_BAR;
            PG8_LDA(At, 0, 1); PG8_STAGE(PG8_SA(0, 0), a2, voffA);
            PG8_BAR; PG8_WAIT_L(0); PG8_MMA(1, 0, At, B0); PG8_BAR; PG8_SCHED;
            PG8_STAGE(PG8_SB(0, 1), b2 + hstep, voffB);
            PG8_WAIT_V(6); PG8_BAR; PG8_MMA(1, 1, At, B1); PG8_BAR;
            PG8_LDB(B0, 1, 0); PG8_SCHED; PG8_LDA(At, 1, 0); PG8_STAGE(PG8_SA(0, 1), a2 + hstep, voffA);
            PG8_WAIT_L(8); PG8_BAR; PG8_WAIT_L(0); PG8_MMA(0, 0, At, B0); PG8_BAR; PG8_SCHED;
            PG8_LDB(B1, 1, 1); PG8_STAGE(PG8_SB(1, 0), b3, voffB);
            PG8_BAR; PG8_WAIT_L(0); PG8_MMA(0, 1, At, B1); PG8_BAR;
            PG8_LDA(At, 1, 1); PG8_STAGE(PG8_SA(1, 0), a3, voffA);
            PG8_BAR; PG8_WAIT_L(0); PG8_MMA(1, 0, At, B0); PG8_BAR; PG8_SCHED;
            PG8_STAGE(PG8_SB(1, 1), b3 + hstep, voffB);
            PG8_WAIT_V(6); PG8_BAR; PG8_MMA(1, 1, At, B1); PG8_BAR;
        }
        PG8_STAMP();
        if constexpr (!Epi::AFTER_DRAIN) { E(acc, cur, wr, wc, fr, fq); S.done(cur); }
        PG8_STAMP();
        if (!has_next) break;
#pragma unroll
        for (int a = 0; a < 2; ++a)
#pragma unroll
            for (int b = 0; b < 2; ++b)
#pragma unroll
                for (int m = 0; m < 4; ++m)
#pragma unroll
                    for (int n = 0; n < 2; ++n) acc[a][b][m][n] = (f32x4){0.f, 0.f, 0.f, 0.f};
        cur = nxt; cA = nA; cB = nB; ++ui;
    }
    PG8_WAIT_V(0);
    if (wr == 0) PG8_BAR;
    PG8_BAR;
    if constexpr (Epi::AFTER_DRAIN) { E.fused(acc, cur, wr, wc, fr, fq, lds, wid, lane); S.done(cur); }
    PG8_STAMP();
    if (STAMP && wid == 0) { stamps[lane] = lane < nts ? (((unsigned long long)(unsigned)ts_hi << 32) | (unsigned)ts_lo) : 0ull;
        if (lane == 62) stamps[62] = rt_entry; if (lane == 63) stamps[63] = (unsigned long long)wall_clock64(); }
#undef PG8_STAMP
#undef PG8_SA
#undef PG8_SB
#undef PG8_STAGE
#undef PG8_LDA
#undef PG8_LDB
#undef PG8_MMA
#undef PG8_WAIT_V
#undef PG8_WAIT_L
#undef PG8_BAR
#undef PG8_SCHED
}
}
namespace att {
constexpr int D = 128;
constexpr float THR = 8.f;
constexpr bool WSKIP = false;
constexpr float SCALE = 0.08838834764831845f;
constexpr int NW = 8, QBLK = 32, KVBLK = 64, QB = NW * QBLK;
constexpr int SHM_V = KVBLK * D * 2, SHM_K = KVBLK * D * 2;
using bf16 = __hip_bfloat16;
typedef short bf16x8 __attribute__((ext_vector_type(8)));
typedef short s16x4 __attribute__((ext_vector_type(4)));
typedef float f32x16 __attribute__((ext_vector_type(16)));
typedef float f32x4 __attribute__((ext_vector_type(4)));
typedef unsigned u32x4 __attribute__((ext_vector_type(4)));
template <class A, class Bt> struct same_t { static constexpr bool v = false; };
template <class A> struct same_t<A, A> { static constexpr bool v = true; };

#define KSWZ(row, colB) ((row) * 256 + ((colB) ^ (((row) & 7) << 4)))
#define SBAR() __builtin_amdgcn_sched_barrier(0)
__device__ __forceinline__ int v_st(int k, int c) { const int kk = (k & ~0xC) | ((k & 4) << 1) | ((k & 8) >> 1); return ((kk >> 3) * 4 + (c >> 5)) * 512 + ((kk & 7) * 32 + (c & 31)) * 2; }
__device__ __forceinline__ int v_rd_base(int lane) { return ((lane & 3) << 3) | (((lane >> 2) & 3) << 6) | (((lane >> 4) & 1) << 5) | (((lane >> 5) & 1) << 8); }
constexpr int v_rd_off(int d0, int ks, int half) { return d0 * 512 + ks * 4096 + half * 2048; }
__device__ __forceinline__ int crow(int r, int hi) { return (r & 3) + 8 * (r >> 2) + 4 * hi; }
__device__ __forceinline__ unsigned cvtpk(float lo, float hi) {
    unsigned r; asm volatile("v_cvt_pk_bf16_f32 %0, %1, %2" : "=v"(r) : "v"(lo), "v"(hi)); return r;
}
__device__ __forceinline__ bf16x8 pack8(f32x4 a, f32x4 b) {
    u32x4 w = {cvtpk(a[0], a[1]), cvtpk(a[2], a[3]), cvtpk(b[0], b[1]), cvtpk(b[2], b[3])};
    return *reinterpret_cast<bf16x8*>(&w);
}
template <class T> __device__ __forceinline__ bf16x8 load8(const T* p) {
    if constexpr (same_t<T, float>::v) { return pack8(*(const f32x4*)p, *(const f32x4*)(p + 4)); }
    else { return *reinterpret_cast<const bf16x8*>(p); }
}
__device__ __forceinline__ void mask_tile(f32x16& p0, f32x16& p1, int dq, unsigned W) {
    const float NEG = -__builtin_inff();
#pragma unroll
    for (int r = 0; r < 16; ++r) {
        const int c = (r & 3) + 8 * (r >> 2);
        if ((unsigned)(dq - c) >= W) p0[r] = NEG;
        if ((unsigned)(dq - c - 32) >= W) p1[r] = NEG;
    }
}
__device__ __forceinline__ void partialSM(f32x16& p0, f32x16& p1, float& m_reg, float& mn, float& alpha) {
    float pmax = p0[0]; for (int r = 1; r < 16; ++r) pmax = fmaxf(pmax, p0[r]); for (int r = 0; r < 16; ++r) pmax = fmaxf(pmax, p1[r]);
    { auto rr = __builtin_amdgcn_permlane32_swap(__float_as_uint(pmax), __float_as_uint(pmax), false, false);
      pmax = fmaxf(__uint_as_float(rr[0]), __uint_as_float(rr[1])); }
    constexpr float C2 = 1.4426950408889634f * SCALE;
    if (__builtin_expect(__all((pmax - m_reg) * SCALE <= THR), 1)) { mn = m_reg; alpha = 1.f; }
    else { mn = fmaxf(m_reg, pmax); alpha = __builtin_amdgcn_exp2f((m_reg - mn) * C2); m_reg = mn; }
    const float mnL = -mn * C2;
    for (int r = 0; r < 16; ++r) p0[r] = fmaf(p0[r], C2, mnL); for (int r = 0; r < 16; ++r) p1[r] = fmaf(p1[r], C2, mnL);
    for (int r = 0; r < 16; ++r) p0[r] = __builtin_amdgcn_exp2f(p0[r]);
}
__device__ __forceinline__ void finishSM(f32x16& p0, f32x16& p1, float alpha, float& l_reg, bf16x8& pa0, bf16x8& pa1, bf16x8& pa2, bf16x8& pa3) {
    for (int r = 0; r < 16; ++r) p1[r] = __builtin_amdgcn_exp2f(p1[r]);
    float ps = 0; for (int r = 0; r < 16; ++r) ps += p0[r]; for (int r = 0; r < 16; ++r) ps += p1[r];
    { auto rr = __builtin_amdgcn_permlane32_swap(__float_as_uint(ps), __float_as_uint(ps), false, false);
      ps = __uint_as_float(rr[0]) + __uint_as_float(rr[1]); }
    l_reg = l_reg * alpha + ps;
#define PK4(P, B_, OUT) do { unsigned a0 = cvtpk(P[B_+0], P[B_+1]), a1 = cvtpk(P[B_+2], P[B_+3]);                          \
        unsigned b0 = cvtpk(P[B_+4], P[B_+5]), b1 = cvtpk(P[B_+6], P[B_+7]);                                             \
        auto r0 = __builtin_amdgcn_permlane32_swap(a0, b0, false, false); auto r1 = __builtin_amdgcn_permlane32_swap(a1, b1, false, false); \
        u32x4 w = {r0[0], r1[0], r0[1], r1[1]}; OUT = *reinterpret_cast<bf16x8*>(&w); } while (0)
    PK4(p0, 0, pa0); PK4(p0, 8, pa1); PK4(p1, 0, pa2); PK4(p1, 8, pa3);
#undef PK4
}
template <int KB, bool SK>
__device__ __forceinline__ void qkt(f32x16& p0, f32x16& p1, const char* K_lds, int r32, int hi, const bf16x8* qr, bool act) {
    if (SK && !act) { const float NEG = -__builtin_inff();
#pragma unroll
        for (int r = 0; r < 16; ++r) { p0[r] = NEG; p1[r] = NEG; } return; }
    p0 = f32x16{}; p1 = f32x16{};
    const char* kb[4];
#pragma unroll
    for (int dd = 0; dd < 4; ++dd) kb[dd] = K_lds + KB * SHM_K + KSWZ(r32, (dd * 16 + hi * 8) * 2);
#pragma unroll
    for (int d0 = 0; d0 < 8; ++d0) { const char* a = kb[d0 & 3] + (d0 >> 2) * 128;
        bf16x8 b0 = *reinterpret_cast<const bf16x8*>(a);
        bf16x8 b1 = *reinterpret_cast<const bf16x8*>(a + 32 * 256);
        p0 = __builtin_amdgcn_mfma_f32_32x32x16_bf16(b0, qr[d0], p0, 0, 0, 0);
        p1 = __builtin_amdgcn_mfma_f32_32x32x16_bf16(b1, qr[d0], p1, 0, 0, 0); }
}
template <int VB, bool SK>
__device__ __forceinline__ void pv_tile(f32x16* o, int vb0, bf16x8 pa0, bf16x8 pa1, bf16x8 pa2, bf16x8 pa3, bool act) {
    if (SK && !act) return;
#define TRRD(dst, off) asm volatile("ds_read_b64_tr_b16 %0, %1 offset:%2" : "=&v"(dst) : "v"(vb0), "i"(off) : "memory")
#define PV_D0(d0) do { s16x4 l0, l1, l2, l3, h0, h1, h2, h3; constexpr int b_ = VB * SHM_V + v_rd_off(d0, 0, 0);     \
        TRRD(l0, b_); TRRD(h0, b_ + 2048); TRRD(l1, b_ + 4096); TRRD(h1, b_ + 6144); TRRD(l2, b_ + 8192); TRRD(h2, b_ + 10240); TRRD(l3, b_ + 12288); TRRD(h3, b_ + 14336); \
        asm volatile("s_waitcnt lgkmcnt(0)" ::: "memory"); SBAR();                 \
        o[d0] = __builtin_amdgcn_mfma_f32_32x32x16_bf16(pa0, (bf16x8){l0[0], l0[1], l0[2], l0[3], h0[0], h0[1], h0[2], h0[3]}, o[d0], 0, 0, 0);   \
        o[d0] = __builtin_amdgcn_mfma_f32_32x32x16_bf16(pa1, (bf16x8){l1[0], l1[1], l1[2], l1[3], h1[0], h1[1], h1[2], h1[3]}, o[d0], 0, 0, 0);   \
        o[d0] = __builtin_amdgcn_mfma_f32_32x32x16_bf16(pa2, (bf16x8){l2[0], l2[1], l2[2], l2[3], h2[0], h2[1], h2[2], h2[3]}, o[d0], 0, 0, 0);   \
        o[d0] = __builtin_amdgcn_mfma_f32_32x32x16_bf16(pa3, (bf16x8){l3[0], l3[1], l3[2], l3[3], h3[0], h3[1], h3[2], h3[3]}, o[d0], 0, 0, 0); } while (0)
    PV_D0(0); PV_D0(1); PV_D0(2); PV_D0(3);
#undef PV_D0
#undef TRRD
}

template <class TIn, class TOut> struct BlockRef { const TIn* Q; const TIn* K; const TIn* V; TOut* O; int P0; };
template <class TIn> struct Seam {
    bf16x8 qr[8];
    bf16x8 st_v0, st_v1, st_k0, st_k1; f32x4 sf0, sf1, sf2, sf3;
    f32x4 tq[16];
};
__device__ __forceinline__ int swa_jlo(int P0, int W) { const int lowk = P0 - W + 1; return lowk > 0 ? lowk / KVBLK : 0; }
#define ROW(p, k0, rr) ((p) + (size_t)((k0) + (rr)) * D + sc)
#define VMW() asm volatile("s_waitcnt vmcnt(0)" ::: "memory")
#define VMWN(n) asm volatile("s_waitcnt vmcnt(%0)" :: "i"(n) : "memory")
#define SLOAD_H(Kp, Vp, k0) do { S.st_v0 = load8<TIn>(ROW(Vp, k0, sr)); S.st_v1 = load8<TIn>(ROW(Vp, k0, 32 + sr));              \
                         S.st_k0 = load8<TIn>(ROW(Kp, k0, sr)); S.st_k1 = load8<TIn>(ROW(Kp, k0, 32 + sr)); } while (0)
#define SWRITE_HK(bf) do { *(bf16x8*)(K_lds + (bf) * SHM_K + kws) = S.st_k0; *(bf16x8*)(K_lds + (bf) * SHM_K + kws + 32 * 256) = S.st_k1; } while (0)
#define SWRITE_HV(bf) do { *(bf16x8*)(V_lds + (bf) * SHM_V + vst0) = S.st_v0; *(bf16x8*)(V_lds + (bf) * SHM_V + vst1) = S.st_v1; } while (0)
#define SWRITE_H(bf) do { SWRITE_HV(bf); SWRITE_HK(bf); } while (0)
#define SLOAD_F(p, k0) do { S.sf0 = *(const f32x4*)ROW(p, k0, sr); S.sf1 = *(const f32x4*)(ROW(p, k0, sr) + 4);                \
                            S.sf2 = *(const f32x4*)ROW(p, k0, 32 + sr); S.sf3 = *(const f32x4*)(ROW(p, k0, 32 + sr) + 4); } while (0)
#define SWRITE_KF(bf) do { *(bf16x8*)(K_lds + (bf) * SHM_K + kws) = pack8(S.sf0, S.sf1); *(bf16x8*)(K_lds + (bf) * SHM_K + kws + 32 * 256) = pack8(S.sf2, S.sf3); } while (0)
#define SWRITE_VF(bf) do { *(bf16x8*)(V_lds + (bf) * SHM_V + vst0) = pack8(S.sf0, S.sf1); *(bf16x8*)(V_lds + (bf) * SHM_V + vst1) = pack8(S.sf2, S.sf3); } while (0)
template <class TIn, class TOut>
__device__ __forceinline__ void causal_swa_prime(const BlockRef<TIn, TOut>& cur, int W, char* lds, Seam<TIn>& S) {
    constexpr bool F32 = same_t<TIn, float>::v;
    const int tid = threadIdx.x, wid = __builtin_amdgcn_readfirstlane(tid >> 6), lane = tid & 63, r32 = lane & 31, hi = lane >> 5;
    const int sr = tid >> 4, sc = (tid & 15) * 8, kws = KSWZ(sr, sc * 2); char* K_lds = lds + 2 * SHM_V;
    const int kb0 = swa_jlo(cur.P0, W) * KVBLK;
    for (int d0 = 0; d0 < 8; ++d0) S.qr[d0] = load8<TIn>(cur.Q + (size_t)(wid * QBLK + r32) * D + d0 * 16 + hi * 8);
    if constexpr (F32) { SLOAD_F((const float*)cur.K, kb0); VMW(); SWRITE_KF(0); SBAR(); SLOAD_F((const float*)cur.V, kb0); }
    else { SLOAD_H(cur.K, cur.V, kb0); VMW(); SWRITE_HK(0); }
    __syncthreads();
}
template <class TIn, class TOut>
__device__ __forceinline__ void causal_swa_block(const BlockRef<TIn, TOut>& cur, const BlockRef<TIn, TOut>& nxt, int skv, int W, char* lds, Seam<TIn>& S) {
    constexpr bool F32 = same_t<TIn, float>::v;
    const int tid = threadIdx.x, wid = __builtin_amdgcn_readfirstlane(tid >> 6), lane = tid & 63, r32 = lane & 31, hi = lane >> 5;
    const int j_lo = swa_jlo(cur.P0, W);
    int j_hi = (cur.P0 + QB - 1) / KVBLK + 1; if (j_hi > skv / KVBLK) j_hi = skv / KVBLK;
    const int NT = j_hi - j_lo;
    const int kbn = swa_jlo(nxt.P0, W) * KVBLK;
    const int qlo = cur.P0 + wid * QBLK, qm = qlo + r32 - 4 * hi;
    char* V_lds = lds; char* K_lds = lds + 2 * SHM_V;
    float* ws = (float*)(lds + 2 * SHM_V + 2 * SHM_K) + wid * 64; float* li_l = ws, * al_l = ws + 32;
    float m_reg = -1e30f, l_reg = 0; f32x16 o[4] = {};
    const int sr = tid >> 4, sc = (tid & 15) * 8, vst0 = v_st(sr, sc), vst1 = v_st(32 + sr, sc), kws = KSWZ(sr, sc * 2);
    const int vb0 = (int)(uintptr_t)V_lds + v_rd_base(lane);
    const TIn* Kh = cur.K; const TIn* Vh = cur.V;
#define RESC(a) do { if (__any((a) < 1.f)) { if (hi == 0) al_l[r32] = (a); asm volatile("s_waitcnt lgkmcnt(0)" ::: "memory");              \
                     for (int d_ = 0; d_ < 4; ++d_) for (int r = 0; r < 16; ++r) o[d_][r] *= al_l[crow(r, hi)]; } } while (0)
#define KBASE(t) ((j_lo + (t)) * KVBLK)
#define ACT(t) (KBASE(t) <= qlo + QBLK - 1 && KBASE(t) + KVBLK - 1 >= qlo - W + 1)
#define MASKT(P0_, P1_, t) do { const int kb_ = KBASE(t); if ((!SK || ACT(t)) && (kb_ + KVBLK - 1 > qlo || kb_ <= qlo + QBLK - 1 - W)) mask_tile(P0_, P1_, qm - kb_, (unsigned)W); } while (0)
    constexpr int NQL = F32 ? 16 : 8;
    constexpr bool SK = WSKIP && !F32;
#define SEAM_K0() do { VMWN(NQL); if constexpr (F32) { SWRITE_KF(0); SBAR(); SLOAD_F((const float*)nxt.V, kbn); } else { SWRITE_HK(0); } SBAR(); } while (0)
    f32x16 pA0, pA1, pB0, pB1; float mnA, mnB, alA, alB; bf16x8 pa0, pa1, pa2, pa3;
    if constexpr (F32) { VMW(); SWRITE_VF(0); SBAR(); } else { SWRITE_HV(0); SBAR(); }
    if (NT > 1) { if constexpr (F32) SLOAD_F((const float*)Kh, KBASE(1)); else SLOAD_H(Kh, Vh, KBASE(1)); }
    SBAR(); qkt<0, SK>(pA0, pA1, K_lds, r32, hi, S.qr, ACT(0));
    if constexpr (F32) { if (NT > 1) { VMW(); SWRITE_KF(1); SBAR(); SLOAD_F((const float*)Vh, KBASE(1)); } }
    MASKT(pA0, pA1, 0); partialSM(pA0, pA1, m_reg, mnA, alA);
    if (NT > 1) { VMW(); if constexpr (F32) { SWRITE_VF(1); SBAR(); if (NT > 2) SLOAD_F((const float*)Kh, KBASE(2)); } else SWRITE_H(1); }
    __syncthreads();
#define HALF_STEP(PX0, PX1, mnX, alX, PY0, PY1, alY, t, KB, VB, SB) do {                                                      \
        SBAR(); qkt<KB, SK>(PX0, PX1, K_lds, r32, hi, S.qr, ACT(t));                                             \
        finishSM(PY0, PY1, alY, l_reg, pa0, pa1, pa2, pa3); SBAR();                                                           \
        if ((t) + 1 < NT) { if constexpr (F32) { VMW(); SWRITE_KF(SB); SBAR(); SLOAD_F((const float*)Vh, KBASE((t) + 1)); }  \
                            else { SLOAD_H(Kh, Vh, KBASE((t) + 1)); } SBAR(); }                                               \
        pv_tile<VB, SK>(o, vb0, pa0, pa1, pa2, pa3, ACT((t) - 1)); MASKT(PX0, PX1, (t)); partialSM(PX0, PX1, m_reg, mnX, alX);                                        \
        __syncthreads();                                                                                                      \
        if ((t) + 1 < NT) { VMW(); if constexpr (F32) { SWRITE_VF(SB); SBAR(); if ((t) + 2 < NT) SLOAD_F((const float*)Kh, KBASE((t) + 2)); } \
                            else { SWRITE_H(SB); } }                                                                          \
        RESC(alX); __syncthreads(); } while (0)
    for (int t = 1; t + 1 < NT; t += 2) {
        HALF_STEP(pB0, pB1, mnB, alB, pA0, pA1, alA, t, 1, 0, 0);
        HALF_STEP(pA0, pA1, mnA, alA, pB0, pB1, alB, t + 1, 0, 1, 1);
    }
    const bool even = (NT & 1) == 0;
    if (even) { SBAR(); qkt<1, SK>(pB0, pB1, K_lds, r32, hi, S.qr, ACT(NT - 1)); SBAR(); }
#define QROW(e) (nxt.Q + (size_t)(wid * QBLK + r32) * D + ((e) >> 1) * 16 + hi * 8 + ((e) & 1) * 4)
    if constexpr (F32) { SLOAD_F((const float*)nxt.K, kbn); SBAR();
#pragma unroll
        for (int e = 0; e < 8; ++e) S.tq[e] = *(const f32x4*)QROW(e); }
    else { SLOAD_H(nxt.K, nxt.V, kbn); SBAR();
#pragma unroll
        for (int d0 = 0; d0 < 8; ++d0) S.qr[d0] = load8<TIn>(nxt.Q + (size_t)(wid * QBLK + r32) * D + d0 * 16 + hi * 8); }
    SBAR();
    finishSM(pA0, pA1, alA, l_reg, pa0, pa1, pa2, pa3); SBAR();
    if constexpr (F32) {
#pragma unroll
        for (int e = 8; e < 16; ++e) S.tq[e] = *(const f32x4*)QROW(e); SBAR(); }
#undef QROW
    pv_tile<0, SK>(o, vb0, pa0, pa1, pa2, pa3, ACT(even ? NT - 2 : NT - 1));
    if (even) { MASKT(pB0, pB1, NT - 1); partialSM(pB0, pB1, m_reg, mnB, alB); __syncthreads(); RESC(alB);
        finishSM(pB0, pB1, alB, l_reg, pa0, pa1, pa2, pa3); SBAR(); pv_tile<1, SK>(o, vb0, pa0, pa1, pa2, pa3, ACT(NT - 1)); }
    SBAR(); SEAM_K0();
    if (hi == 0) li_l[r32] = l_reg; asm volatile("s_waitcnt lgkmcnt(0)" ::: "memory");
    float rli[16];
#pragma unroll
    for (int r = 0; r < 16; ++r) rli[r] = __builtin_amdgcn_rcpf(li_l[crow(r, hi)]);
    TOut* Ow = cur.O + (size_t)(wid * QBLK) * D;
#pragma unroll
    for (int r = 0; r < 16; ++r) { const int orow = crow(r, hi);
#pragma unroll
        for (int d0 = 0; d0 < 4; ++d0) { const float v = o[d0][r] * rli[r];
            if constexpr (same_t<TOut, float>::v) { Ow[(size_t)orow * D + d0 * 32 + r32] = v; }
            else { const float vn = __shfl_xor(v, 1);
                   if ((r32 & 1) == 0) *(unsigned*)(Ow + (size_t)orow * D + d0 * 32 + r32) = cvtpk(v, vn); } } }
    if constexpr (F32) {
#pragma unroll
        for (int d0 = 0; d0 < 8; ++d0) S.qr[d0] = pack8(S.tq[2 * d0], S.tq[2 * d0 + 1]); }
    __syncthreads();
#undef RESC
#undef KBASE
#undef ACT
#undef MASKT
#undef SEAM_K0
#undef HALF_STEP
}
#undef ROW
#undef VMW
#undef VMWN
#undef SLOAD_H
#undef SWRITE_HK
#undef SWRITE_HV
#undef SWRITE_H
#undef SLOAD_F
#undef SWRITE_KF
#undef SWRITE_VF
}
namespace att {
#define A2_LAS __attribute__((address_space(3)))
struct Blk2 { const bf16* Q; const bf16* K; const bf16* V0; const bf16* V1; bf16* O0; bf16* O1; int P0; float* stash; bf16* comb; float lam; };
template <int EPI>
__device__ __forceinline__ void attn_block_v256(const Blk2& c, char* lds) {
    const int tid = threadIdx.x, wid = __builtin_amdgcn_readfirstlane(tid >> 6), lane = tid & 63, r32 = lane & 31, hi = lane >> 5;
    const int NT = c.P0 / KVBLK + 4;
    const int qlo = c.P0 + wid * QBLK, qm = qlo + r32 - 4 * hi;
    char* K_lds = lds; char* V_lds = lds + 2 * SHM_K;
    float* wsf = (float*)(lds + 4 * SHM_V + 2 * SHM_K) + wid * 64; float* li_l = wsf; float* al_l = wsf + 32;
    const int vb0 = (int)(uintptr_t)V_lds + v_rd_base(lane);
    const char* kbs[4];
#pragma unroll
    for (int dd = 0; dd < 4; ++dd) kbs[dd] = K_lds + KSWZ(r32, (dd * 16 + hi * 8) * 2);
    unsigned koff[2];
#pragma unroll
    for (int j = 0; j < 2; ++j) { const int q = (2 * wid + j) * 64 + lane, row = q >> 4, slot = q & 15; koff[j] = (unsigned)(row * 256 + ((slot ^ (row & 7)) << 4)); }
    unsigned voff;
    { const int kk = 8 * wid + ((lane & 31) >> 2), k = (kk & ~0xC) | ((kk & 4) << 1) | ((kk & 8) >> 1); voff = (unsigned)(k * 256 + (lane >> 5) * 64 + (lane & 3) * 16); }
    bf16x8 qr[8];
#pragma unroll
    for (int d0 = 0; d0 < 8; ++d0) qr[d0] = load8<bf16>(c.Q + (size_t)(wid * QBLK + r32) * D + d0 * 16 + hi * 8);
#define A2_DMA(gp, lp) __builtin_amdgcn_global_load_lds((const unsigned*)(gp), (A2_LAS unsigned*)(lp), 16, 0, 0)
#define A2_STAGE(k0, bf) do { const char* kp_ = (const char*)c.K + (size_t)(k0) * (D * 2); const char* v0_ = (const char*)c.V0 + (size_t)(k0) * (D * 2); const char* v1_ = (const char*)c.V1 + (size_t)(k0) * (D * 2); \
        char* kl_ = K_lds + (bf) * SHM_K + wid * 2048; char* vl_ = V_lds + (bf) * (2 * SHM_V) + wid * 2048; \
        A2_DMA(kp_ + koff[0], kl_); A2_DMA(kp_ + koff[1], kl_ + 1024); \
        A2_DMA(v0_ + voff, vl_); A2_DMA(v0_ + voff + 128, vl_ + 1024); A2_DMA(v1_ + voff, vl_ + SHM_V); A2_DMA(v1_ + voff + 128, vl_ + SHM_V + 1024); } while (0)
#define A2_VMW() asm volatile("s_waitcnt vmcnt(0)" ::: "memory")
#define A2_RESC(a) do { if (__any((a) < 1.f)) { if (hi == 0) al_l[r32] = (a); asm volatile("s_waitcnt lgkmcnt(0)" ::: "memory"); \
                        for (int d_ = 0; d_ < 8; ++d_) for (int r = 0; r < 16; ++r) o[d_][r] *= al_l[crow(r, hi)]; } } while (0)
    A2_STAGE(0, 0); A2_VMW();
    __syncthreads();
    float m_reg = -1e30f, l_reg = 0.f; f32x16 o[8] = {};
    f32x16 p0, p1; float mn, alpha; bf16x8 pa0, pa1, pa2, pa3;
#define A2_QKT(KB) do { p0 = f32x16{}; p1 = f32x16{}; _Pragma("unroll") for (int d0 = 0; d0 < 8; ++d0) { const char* a_ = kbs[d0 & 3] + (KB) * SHM_K + (d0 >> 2) * 128; \
        const bf16x8 b0_ = *reinterpret_cast<const bf16x8*>(a_); const bf16x8 b1_ = *reinterpret_cast<const bf16x8*>(a_ + 32 * 256); \
        p0 = __builtin_amdgcn_mfma_f32_32x32x16_bf16(b0_, qr[d0], p0, 0, 0, 0); p1 = __builtin_amdgcn_mfma_f32_32x32x16_bf16(b1_, qr[d0], p1, 0, 0, 0); } } while (0)
#define A2_STEP(t, BUF) do { \
        if ((t) + 1 < NT) { A2_STAGE(((t) + 1) * KVBLK, (BUF) ^ 1); } \
        if ((t) * KVBLK <= qlo + QBLK - 1) {     \
        SBAR(); A2_QKT(BUF); SBAR(); \
        { const int kb_ = (t) * KVBLK; if (kb_ + KVBLK - 1 > qlo) mask_tile(p0, p1, qm - kb_, (unsigned)0x40000000); } \
        partialSM(p0, p1, m_reg, mn, alpha); \
        finishSM(p0, p1, alpha, l_reg, pa0, pa1, pa2, pa3); SBAR(); \
        A2_RESC(alpha); \
        pv_tile<0, false>(o, vb0 + (BUF) * (2 * SHM_V), pa0, pa1, pa2, pa3, true); \
        pv_tile<1, false>(o + 4, vb0 + (BUF) * (2 * SHM_V), pa0, pa1, pa2, pa3, true); } \
        A2_VMW(); __syncthreads(); } while (0)
    for (int t = 0; t < NT; t += 2) { A2_STEP(t, 0); A2_STEP(t + 1, 1); }
    if (hi == 0) li_l[r32] = l_reg; asm volatile("s_waitcnt lgkmcnt(0)" ::: "memory");
    if (EPI == 0) {
    float rli[16];
#pragma unroll
    for (int r = 0; r < 16; ++r) rli[r] = __builtin_amdgcn_rcpf(li_l[crow(r, hi)]);
#pragma unroll
    for (int r = 0; r < 16; ++r) { const int orow = wid * QBLK + crow(r, hi);
#pragma unroll
        for (int d0 = 0; d0 < 8; ++d0) { const float v = o[d0][r] * rli[r]; const float vn = __shfl_xor(v, 1);
            bf16* Ob = (d0 < 4) ? c.O0 : c.O1;
            if ((r32 & 1) == 0) *(unsigned*)(Ob + (size_t)orow * D + (d0 & 3) * 32 + r32) = cvtpk(v, vn); } }
    } else if (EPI == 1) {
        int tid1 = threadIdx.x; asm volatile("" : "+v"(tid1)); const unsigned toff1 = (unsigned)tid1 * 16u;
#pragma unroll
        for (int q = 0; q < 4; ++q) {
            float rl[4];
#pragma unroll
            for (int j = 0; j < 4; ++j) rl[j] = __builtin_amdgcn_rcpf(li_l[crow(4 * q + j, hi)]);
#pragma unroll
            for (int d0 = 0; d0 < 8; ++d0) { char* sbs = (char*)c.stash + (size_t)(d0 * 4 + q) * 8192;
                *(f32x4*)(sbs + toff1) = (f32x4){o[d0][4 * q] * rl[0], o[d0][4 * q + 1] * rl[1], o[d0][4 * q + 2] * rl[2], o[d0][4 * q + 3] * rl[3]}; }
        }
    } else {
        int tid2 = threadIdx.x; asm volatile("" : "+v"(tid2));
        const int lane2 = tid2 & 63;
        char* tl = lds + 2 * SHM_K + (tid2 >> 6) * 8192;
#pragma unroll
        for (int q = 0; q < 4; ++q) {
            f32x4 sv[8];
#pragma unroll
            for (int d0 = 0; d0 < 8; ++d0) { const char* sbs = (const char*)c.stash + (size_t)(d0 * 4 + q) * 8192; sv[d0] = *(const f32x4*)(sbs + (unsigned)tid2 * 16u); }
#pragma unroll
            for (int j = 0; j < 4; ++j) { const int r = 4 * q + j;
                const float rl = c.lam * __builtin_amdgcn_rcpf(li_l[crow(r, hi)]);
                float dv[8]; float ss = 0.f;
#pragma unroll
                for (int d0 = 0; d0 < 8; ++d0) { dv[d0] = sv[d0][j] - o[d0][r] * rl; ss += dv[d0] * dv[d0]; }
                ss += __shfl_xor(ss, 1); ss += __shfl_xor(ss, 2); ss += __shfl_xor(ss, 4); ss += __shfl_xor(ss, 8); ss += __shfl_xor(ss, 16);
                const float rs = rsqrtf(ss * (1.f / 256.f) + 1e-6f);
                const int lrow = crow(r, hi) - 16 * (q >> 1);
#pragma unroll
                for (int d0 = 0; d0 < 8; ++d0) *(unsigned short*)(tl + lrow * 512 + (d0 * 32 + (lane2 & 31)) * 2) = (unsigned short)cvtpk(dv[d0] * rs, 0.f); }
            if (q & 1) {
                asm volatile("s_waitcnt lgkmcnt(0)" ::: "memory");
                const unsigned loff = (unsigned)((lane2 >> 5) * 4096 + (lane2 & 31) * 16);
#pragma unroll
                for (int it = 0; it < 8; ++it) {
                    const u32x4 w = *(const u32x4*)(tl + (lane2 >> 5) * 512 + (lane2 & 31) * 16 + it * 1024);
                    char* ob = (char*)c.comb + (size_t)(wid * QBLK + 16 * (q >> 1) + 2 * it) * 4096;
                    *(u32x4*)(ob + loff) = w; }
                asm volatile("s_waitcnt lgkmcnt(0)" ::: "memory");
            }
        }
    }
    __syncthreads();
#undef A2_VMW
#undef A2_DMA
#undef A2_STAGE
#undef A2_RESC
#undef A2_STEP
#undef A2_QKT
}
}

#define XB_TMO      128
#define XB_XCNT(j)  (256  + 64 * (j))
#define XB_XSUB(j)  (1280 + 64 * (j))
#define XB_XGEN(j)  (2304 + 64 * (j))
#define XB_TOP      3328
#define XB_TOPGEN   3392
#define XCD_BAR_WORDS 3456
#define XB_SPIN_CAP (1u << 18)
#define LAS __attribute__((address_space(3)))

__device__ __forceinline__ unsigned xb_ld(unsigned* p)              { return __hip_atomic_load(p, __ATOMIC_RELAXED, __HIP_MEMORY_SCOPE_AGENT); }
__device__ __forceinline__ unsigned xb_add(unsigned* p, unsigned v) { return __hip_atomic_fetch_add(p, v, __ATOMIC_RELAXED, __HIP_MEMORY_SCOPE_AGENT); }
__device__ __forceinline__ unsigned xb_xcc_id() { return (unsigned)__builtin_amdgcn_s_getreg((3 << 11) | 20) & 0xFu; }
#define XB_SPIN(cond, bar) do { unsigned _sp = 0; while (cond) { __builtin_amdgcn_s_sleep(1); \
    if ((++_sp & 255u) == 0u) { if (xb_ld(&(bar)[XB_TMO])) break; if (_sp > XB_SPIN_CAP) { atomicAdd(&(bar)[XB_TMO], 1u); break; } } } } while (0)

struct XcdBarrier {
    unsigned* bar; unsigned x;
    volatile LAS unsigned* st;
};

__device__ __forceinline__ XcdBarrier xcd_barrier_post(unsigned* bar, volatile LAS unsigned* st) {
    XcdBarrier b; b.bar = bar; b.x = xb_xcc_id(); b.st = st;
    if (threadIdx.x == 0) (void)xb_add(&bar[XB_XCNT(b.x)], 1u);
    return b;
}
__device__ __forceinline__ void xcd_barrier_complete(unsigned* bar, unsigned x, unsigned& nloc, unsigned& nx) {
    const unsigned G = gridDim.x * gridDim.y * gridDim.z;
    unsigned sum, cnt, mine, sp = 0u;
    for (;;) {
        sum = 0u; cnt = 0u; mine = 0u;
#pragma unroll
        for (unsigned j = 0; j < 16; ++j) { const unsigned c = xb_ld(&bar[XB_XCNT(j)]); sum += c; cnt += (c > 0u) ? 1u : 0u; mine = (j == x) ? c : mine; }
        if (sum == G) break;
        __builtin_amdgcn_s_sleep(1);
        if ((++sp & 255u) == 0u) { if (xb_ld(&bar[XB_TMO])) break; if (sp > XB_SPIN_CAP) { atomicAdd(&bar[XB_TMO], 1u); break; } }
    }
    nloc = mine > 0u ? mine : 1u; nx = cnt > 0u ? cnt : 1u;
}

__device__ __forceinline__ void xcd_barrier(const XcdBarrier& b) {
    asm volatile("s_waitcnt vmcnt(0)" ::: "memory");
    __syncthreads();
    if (threadIdx.x == 0) {
        unsigned* bar = b.bar;
        __builtin_amdgcn_s_waitcnt(0);
        unsigned nloc = b.st[0], nx = b.st[1];
        if (nloc == 0u) { xcd_barrier_complete(bar, b.x, nloc, nx); b.st[0] = nloc; b.st[1] = nx; }
        const unsigned old = xb_add(&bar[XB_XSUB(b.x)], 1u);
        const unsigned gen = old / nloc;
        if (old + 1u == (gen + 1u) * nloc) {
            __builtin_amdgcn_fence(__ATOMIC_RELEASE, "agent");
            asm volatile("s_waitcnt vmcnt(0)" ::: "memory");
            const unsigned og = xb_add(&bar[XB_TOP], 1u);
            const unsigned tg = og / nx;
            if (og + 1u == (tg + 1u) * nx) xb_add(&bar[XB_TOPGEN], 1u);
            else XB_SPIN(xb_ld(&bar[XB_TOPGEN]) == tg, bar);
            __builtin_amdgcn_fence(__ATOMIC_ACQUIRE, "agent");
            xb_add(&bar[XB_XGEN(b.x)], 1u);
            asm volatile("s_waitcnt vmcnt(0)" ::: "memory");
        } else {
            XB_SPIN(xb_ld(&bar[XB_XGEN(b.x)]) == gen, bar);
            __builtin_amdgcn_fence(__ATOMIC_ACQUIRE, "agent");
            asm volatile("s_waitcnt vmcnt(0)" ::: "memory");
        }
    }
    __syncthreads();
}

#undef LAS

namespace cg = cooperative_groups;
#ifndef REP_GEMM
#define REP_GEMM 1
#endif
#ifndef REP_GU
#define REP_GU REP_GEMM
#endif
#ifndef REP_DN
#define REP_DN REP_GEMM
#endif
#ifndef REP_P3
#define REP_P3 1
#endif
#ifndef REP_ATT
#define REP_ATT 1
#endif
#ifndef REP_CONV
#define REP_CONV 1
#endif
typedef unsigned short u16;
typedef float f32x4v __attribute__((ext_vector_type(4)));
typedef unsigned u32x4v __attribute__((ext_vector_type(4)));
typedef unsigned u32x2v __attribute__((ext_vector_type(2)));

constexpr int T_TOK = 16384, DM = 2048, DFF = 5632, SEQ = 4096, NBATCH = 4;
constexpr float EPS = 1e-6f;
constexpr float LAMBDA_INIT = 0.35550906759096934f;
constexpr size_t MiB = (size_t)1 << 20;
constexpr size_t WS_WPOOL = 0, WS_WGU = 2 * MiB, WS_WDN = 46 * MiB, WS_WQKV = 68 * MiB, WS_WO = 92 * MiB, WS_MISC = 100 * MiB,
                 WS_A = 101 * MiB, WS_B = 293 * MiB, WS_C = 357 * MiB, WS_END = 485 * MiB;
constexpr size_t MISC_RSTD = 0, MISC_COS = 64 * 1024, MISC_SIN = 320 * 1024, MISC_BAR = 640 * 1024, BAR_BYTES = 16 * 1024, MISC_RSTDX = 704 * 1024;
constexpr int LDS_TOTAL = 131072;
constexpr int NPHASE = 14;

struct Params {
    const float* x; const float* norm_mix_pre; const float* norm_mix_post; const float* norm_ffn_pre; const float* norm_ffn_post;
    const float* w_pool; const float* pool_scale; const float* kv_norm; const float* w_kv; const float* w_q;
    const float* lq1; const float* lk1; const float* lq2; const float* lk2; const float* subln; const float* w_o;
    const float* w_gate; const float* w_up; const float* w_down;
    float* out; unsigned char* ws;
    int ph_lo, ph_hi;
};

__device__ __forceinline__ unsigned pk_bf16(float lo, float hi) { unsigned r; asm volatile("v_cvt_pk_bf16_f32 %0, %1, %2" : "=v"(r) : "v"(lo), "v"(hi)); return r; }
__device__ __forceinline__ float bf_lo(unsigned w) { return __uint_as_float(w << 16); }
__device__ __forceinline__ float bf_hi(unsigned w) { return __uint_as_float(w & 0xffff0000u); }
__device__ __forceinline__ float wave_sum(float v) {
#pragma unroll
    for (int o = 32; o >= 1; o >>= 1) v += __shfl_xor(v, o);
    return v;
}

struct ConvJob { const float* src; int ld; int c0; int k0; const float* rgain; int rmask; const float* cgain; float scal; u16* dst; int Kdst; };

__device__ __forceinline__ void conv_load(const ConvJob& j, float (&v)[32]) {
    const int tid = threadIdx.x, w = tid >> 6, lane = tid & 63;
    const float* sp = j.src + (size_t)(j.k0 + w * 16 + (lane >> 5) * 8) * j.ld + j.c0 + 4 * (lane & 31);
#pragma unroll
    for (int q = 0; q < 8; ++q) { const f32x4v t = __builtin_nontemporal_load((const f32x4v*)(sp + (size_t)q * j.ld)); v[4 * q] = t.x; v[4 * q + 1] = t.y; v[4 * q + 2] = t.z; v[4 * q + 3] = t.w; }
}
__device__ __forceinline__ void conv_store(const ConvJob& j, const float (&v)[32], unsigned char* lds) {
    const int tid = threadIdx.x, w = tid >> 6, lane = tid & 63, l4 = lane & 31, kh = lane >> 5;
    float cg[4] = {j.scal, j.scal, j.scal, j.scal};
    if (j.cgain) { const float* cp = j.cgain + j.c0 + 4 * l4; cg[0] *= cp[0]; cg[1] *= cp[1]; cg[2] *= cp[2]; cg[3] *= cp[3]; }
#pragma unroll
    for (int q = 0; q < 8; q += 2) {
        const int kl = w * 16 + kh * 8 + q;
        const float rg0 = j.rgain ? j.rgain[(j.k0 + kl) & j.rmask] : 1.f, rg1 = j.rgain ? j.rgain[(j.k0 + kl + 1) & j.rmask] : 1.f;
#pragma unroll
        for (int jj = 0; jj < 4; ++jj)
            *(unsigned*)(lds + (jj * 32 + l4) * 260 + kl * 2) = pk_bf16(v[4 * q + jj] * (cg[jj] * rg0), v[4 * (q + 1) + jj] * (cg[jj] * rg1));
    }
    __syncthreads();
#pragma unroll
    for (int i = 0; i < 4; ++i) {
        const int id = tid + 512 * i, n = id >> 4, c = id & 15, slot = (n & 3) * 32 + (n >> 2);
        const unsigned* lp = (const unsigned*)(lds + slot * 260 + c * 16);
        u32x4v o; o.x = lp[0]; o.y = lp[1]; o.z = lp[2]; o.w = lp[3];
        *(u32x4v*)(j.dst + (size_t)n * j.Kdst + j.k0 + c * 8) = o;
    }
    __syncthreads();
}

__device__ __forceinline__ ConvJob conv_ffn_job(const Params& p, int l, int t) {
    ConvJob j; j.rmask = -1; j.cgain = nullptr; j.scal = 1.f;
    if (t < 1408) { const int nb = t % 88, kt = t / 88, pn = nb >> 1, which = nb & 1;
        j.src = (which ? p.w_up : p.w_gate) + (size_t)l * DM * DFF; j.ld = DFF; j.c0 = pn * 128; j.k0 = kt * 128; j.rgain = p.norm_ffn_pre + l * DM;
        j.dst = (u16*)(p.ws + WS_WGU) + (size_t)nb * 128 * DM; j.Kdst = DM; }
    else { t -= 1408; const int nb = t % 16, kt = t / 16;
        j.src = p.w_down + (size_t)l * DFF * DM; j.ld = DM; j.c0 = nb * 128; j.k0 = kt * 128; j.rgain = nullptr;
        j.dst = (u16*)(p.ws + WS_WDN) + (size_t)nb * 128 * DFF; j.Kdst = DFF; }
    return j;
}
__device__ __forceinline__ ConvJob conv_misc_job(const Params& p, int t) {
    ConvJob j; j.rmask = -1; j.cgain = nullptr; j.scal = 1.f;
    if (t < 64) { const int g = t >> 4, r = t & 15, nt = r & 3, kt = r >> 2;
        j.src = p.w_pool + (size_t)g * 512 * 512; j.ld = 512; j.c0 = nt * 128; j.k0 = kt * 128; j.rgain = p.norm_mix_pre + g * 512; j.cgain = p.pool_scale + g * 512;
        j.dst = (u16*)(p.ws + WS_WPOOL) + (size_t)(g * 512 + nt * 128) * 512; j.Kdst = 512; }
    else if (t < 64 + 768) { t -= 64; const int nb = t % 48, kt = t / 48;
        if (nb < 32) { j.src = p.w_kv; j.ld = 2 * DM; j.c0 = nb * 128; j.rgain = p.kv_norm; }
        else { j.src = p.w_q; j.ld = DM; j.c0 = (nb - 32) * 128; j.rgain = p.norm_mix_pre + DM; }
        j.k0 = kt * 128; j.dst = (u16*)(p.ws + WS_WQKV) + (size_t)nb * 128 * DM; j.Kdst = DM; }
    else { t -= 64 + 768; const int nb = t % 16, kt = t / 16;
        j.src = p.w_o; j.ld = DM; j.c0 = nb * 128; j.k0 = kt * 128; j.rgain = p.subln; j.rmask = 255; j.scal = 1.f - LAMBDA_INIT;
        j.dst = (u16*)(p.ws + WS_WO) + (size_t)nb * 128 * DM; j.Kdst = DM; }
    return j;
}
template <int WHICH>
__device__ __forceinline__ ConvJob conv_job(const Params& p, int t) {
    if (WHICH == 0) { const int tm = t % (2112 + 1088); return tm < 2112 ? conv_ffn_job(p, 0, tm) : conv_misc_job(p, tm - 2112); }
    return conv_ffn_job(p, 1, t);
}
template <int WHICH>
__device__ __forceinline__ void conv_loop(const Params& p, int n, unsigned char* lds) {
    const int G = (int)gridDim.x; int t = (int)blockIdx.x; if (t >= n) return;
    float v[32]; { const ConvJob j = conv_job<WHICH>(p, t); conv_load(j, v); }
    for (;;) {
        const int tn = t + G; const bool more = tn < n;
        float vn[32];
        if (more) { const ConvJob jn = conv_job<WHICH>(p, tn); conv_load(jn, vn); }
        { const ConvJob j = conv_job<WHICH>(p, t); conv_store(j, v, lds); }
        if (!more) break;
        t = tn;
#pragma unroll
        for (int q = 0; q < 32; ++q) v[q] = vn[q];
    }
}

__device__ const float ROPE_INV[16] = {1.000000000e+00f, 4.403665960e-01f, 1.939227432e-01f, 8.539710194e-02f, 3.760603070e-02f, 1.656044088e-02f, 7.292664610e-03f, 3.211446106e-03f,
                                        1.414213562e-03f, 6.227724371e-04f, 2.742481884e-04f, 1.207697351e-04f, 5.318295734e-05f, 2.341999971e-05f, 1.031338525e-05f, 4.541670478e-06f};
__device__ __forceinline__ void rope_entry(int e, float* cosT, float* sinT) {
    constexpr double I2PI = 0.15915494309189535;
    constexpr float HI = (float)I2PI, LO = (float)(I2PI - (double)HI);
    const int s = e >> 4, i = e & 15;
    const float ang = (float)s * ROPE_INV[i];
    const float pr = ang * HI;
    float er = fmaf(ang, HI, -pr); er = fmaf(ang, LO, er);
    const float fr = (pr - rintf(pr)) + er;
    cosT[e] = __builtin_amdgcn_cosf(fr); sinT[e] = __builtin_amdgcn_sinf(fr);
}

__device__ __forceinline__ void rstd_rows(const float* __restrict__ x, float* __restrict__ rstd) {
    const int lane = threadIdx.x & 63, gw = blockIdx.x * 8 + (threadIdx.x >> 6), nw = gridDim.x * 8;
    for (int row0 = gw * 4; row0 < T_TOK; row0 += nw * 4) {
        f32x4v v[4][8];
#pragma unroll
        for (int r = 0; r < 4; ++r) { const f32x4v* rp = (const f32x4v*)(x + (size_t)(row0 + r) * DM);
#pragma unroll
            for (int i = 0; i < 8; ++i) v[r][i] = rp[lane + 64 * i]; }
        float ss[4];
#pragma unroll
        for (int r = 0; r < 4; ++r) { float s = 0.f;
#pragma unroll
            for (int i = 0; i < 8; ++i) s += v[r][i].x * v[r][i].x + v[r][i].y * v[r][i].y + v[r][i].z * v[r][i].z + v[r][i].w * v[r][i].w;
            ss[r] = s; }
#pragma unroll
        for (int o = 32; o >= 1; o >>= 1) {
#pragma unroll
            for (int r = 0; r < 4; ++r) ss[r] += __shfl_xor(ss[r], o); }
        if (lane < 4) { const float s = lane == 0 ? ss[0] : lane == 1 ? ss[1] : lane == 2 ? ss[2] : ss[3]; rstd[row0 + lane] = rsqrtf(s * (1.f / DM) + EPS); }
    }
}

__device__ __forceinline__ void mixed_phase(const float* __restrict__ x, u16* __restrict__ mixed, unsigned char* lds) {
    const int tid = threadIdx.x, g = tid >> 7, w = 2 << g, col = tid * 4, wid = tid >> 6, lane = tid & 63;
    float* rs = (float*)(lds + 40 * 1024);
    for (int ch = blockIdx.x; ch < T_TOK / 64; ch += gridDim.x) {
        const int t0 = ch * 64, pos0 = t0 & (SEQ - 1);
#pragma unroll
        for (int gq = 0; gq < 2; ++gq) {
            f32x4v v[5][8]; const int jr0 = wid * 10 + gq * 5;
#pragma unroll
            for (int r = 0; r < 5; ++r) { const int jr = jr0 + r; const bool ok = pos0 - 16 + jr >= 0; const f32x4v* rp = (const f32x4v*)(x + (size_t)(ok ? t0 - 16 + jr : t0) * DM);
#pragma unroll
                for (int i = 0; i < 8; ++i) v[r][i] = rp[lane + 64 * i]; }
            float ss[5];
#pragma unroll
            for (int r = 0; r < 5; ++r) { float s = 0.f;
#pragma unroll
                for (int i = 0; i < 8; ++i) s += v[r][i].x * v[r][i].x + v[r][i].y * v[r][i].y + v[r][i].z * v[r][i].z + v[r][i].w * v[r][i].w;
                ss[r] = s; }
#pragma unroll
            for (int o = 32; o >= 1; o >>= 1) {
#pragma unroll
                for (int r = 0; r < 5; ++r) ss[r] += __shfl_xor(ss[r], o); }
            if (lane < 5) { const float s = lane == 0 ? ss[0] : lane == 1 ? ss[1] : lane == 2 ? ss[2] : lane == 3 ? ss[3] : ss[4]; rs[jr0 + lane] = rsqrtf(s * (1.f / DM) + EPS); }
        }
        __syncthreads();
        f32x4v S = {0.f, 0.f, 0.f, 0.f};
        for (int jj = 1; jj <= w; ++jj) if (pos0 - jj >= 0) { const f32x4v v = *(const f32x4v*)(x + (size_t)(t0 - jj) * DM + col); S += v * rs[16 - jj]; }
        u16* op = mixed + ((size_t)g * T_TOK + t0) * 512 + (col & 511);
#pragma unroll 8
        for (int i = 0; i < 64; ++i) {
            const int t = t0 + i, pos = pos0 + i;
            const f32x4v vt = *(const f32x4v*)(x + (size_t)t * DM + col) * rs[16 + i];
            S += vt;
            if (pos - w >= 0) { const f32x4v vo = *(const f32x4v*)(x + (size_t)(t - w) * DM + col) * rs[16 + i - w]; S -= vo; }
            const float ic = 1.f / (float)min(pos + 1, w);
            const f32x4v o = S * ic - vt;
            u32x2v pk; pk.x = pk_bf16(o.x, o.y); pk.y = pk_bf16(o.z, o.w);
            *(u32x2v*)(op + (size_t)i * 512) = pk;
        }
        __syncthreads();
    }
}

template <int MODE>
__device__ __forceinline__ void norm_phase(const float* __restrict__ xin, const u16* __restrict__ xprev, const float* __restrict__ rprev, const u16* __restrict__ m, const float* __restrict__ gpost, u16* __restrict__ xn, float* __restrict__ rnew, float* __restrict__ out) {
    constexpr int R = 2;
    const int lane = threadIdx.x & 63, gw = blockIdx.x * 8 + (threadIdx.x >> 6), nw = gridDim.x * 8;
    f32x4v gv[8];
#pragma unroll
    for (int i = 0; i < 4; ++i) { gv[2 * i] = ((const f32x4v*)gpost)[2 * (lane + 64 * i)]; gv[2 * i + 1] = ((const f32x4v*)gpost)[2 * (lane + 64 * i) + 1]; }
    for (int row0 = gw * R; row0 < T_TOK; row0 += nw * R) {
        u32x4v mv[R][4]; u32x4v xh[R][4]; f32x4v xw[(MODE == 0) ? R : 1][8];
#pragma unroll
        for (int r = 0; r < R; ++r) {
            const u32x4v* mp = (const u32x4v*)(m + (size_t)(row0 + r) * DM);
#pragma unroll
            for (int i = 0; i < 4; ++i) mv[r][i] = mp[lane + 64 * i];
            if (MODE == 0) { const f32x4v* xp = (const f32x4v*)(xin + (size_t)(row0 + r) * DM);
#pragma unroll
                for (int i = 0; i < 4; ++i) { xw[r][2 * i] = xp[2 * (lane + 64 * i)]; xw[r][2 * i + 1] = xp[2 * (lane + 64 * i) + 1]; } }
            else { const u32x4v* xp = (const u32x4v*)(xprev + (size_t)(row0 + r) * DM);
#pragma unroll
                for (int i = 0; i < 4; ++i) xh[r][i] = xp[lane + 64 * i]; }
        }
        float ss[R];
#pragma unroll
        for (int r = 0; r < R; ++r) { float s = 0.f;
#pragma unroll
            for (int i = 0; i < 4; ++i) { const u32x4v a = mv[r][i];
                const float f0 = bf_lo(a.x), f1 = bf_hi(a.x), f2 = bf_lo(a.y), f3 = bf_hi(a.y), f4 = bf_lo(a.z), f5 = bf_hi(a.z), f6 = bf_lo(a.w), f7 = bf_hi(a.w);
                s += f0 * f0 + f1 * f1 + f2 * f2 + f3 * f3 + f4 * f4 + f5 * f5 + f6 * f6 + f7 * f7; }
            ss[r] = s; }
#pragma unroll
        for (int o = 32; o >= 1; o >>= 1) {
#pragma unroll
            for (int r = 0; r < R; ++r) ss[r] += __shfl_xor(ss[r], o); }
#pragma unroll
        for (int r = 0; r < R; ++r) {
            const float rs = rsqrtf(ss[r] * (1.f / DM) + EPS);
            const float inv = (MODE == 0) ? 1.f : 1.f / rprev[row0 + r];
            f32x4v xv[8]; float sxr = 0.f;
#pragma unroll
            for (int i = 0; i < 4; ++i) {
                const u32x4v a = mv[r][i];
                f32x4v x0, x1;
                if (MODE == 0) { x0 = xw[r][2 * i]; x1 = xw[r][2 * i + 1]; }
                else { const u32x4v b = xh[r][i]; x0 = (f32x4v){bf_lo(b.x), bf_hi(b.x), bf_lo(b.y), bf_hi(b.y)} * inv; x1 = (f32x4v){bf_lo(b.z), bf_hi(b.z), bf_lo(b.w), bf_hi(b.w)} * inv; }
                x0 += (f32x4v){bf_lo(a.x), bf_hi(a.x), bf_lo(a.y), bf_hi(a.y)} * rs * gv[2 * i];
                x1 += (f32x4v){bf_lo(a.z), bf_hi(a.z), bf_lo(a.w), bf_hi(a.w)} * rs * gv[2 * i + 1];
                if (MODE == 2) { f32x4v* op = (f32x4v*)(out + (size_t)(row0 + r) * DM); op[2 * (lane + 64 * i)] = x0; op[2 * (lane + 64 * i) + 1] = x1; }
                else { xv[2 * i] = x0; xv[2 * i + 1] = x1;
                    sxr += x0.x * x0.x + x0.y * x0.y + x0.z * x0.z + x0.w * x0.w + x1.x * x1.x + x1.y * x1.y + x1.z * x1.z + x1.w * x1.w; }
            }
            if (MODE != 2) {
                sxr = wave_sum(sxr);
                const float rx = rsqrtf(sxr * (1.f / DM) + EPS);
                if (lane == 0) rnew[row0 + r] = rx;
#pragma unroll
                for (int i = 0; i < 4; ++i) { const f32x4v a = xv[2 * i] * rx, b = xv[2 * i + 1] * rx; u32x4v o;
                    o.x = pk_bf16(a.x, a.y); o.y = pk_bf16(a.z, a.w); o.z = pk_bf16(b.x, b.y); o.w = pk_bf16(b.z, b.w);
                    ((u32x4v*)(xn + (size_t)(row0 + r) * DM))[lane + 64 * i] = o; }
            }
        }
    }
}

__device__ __forceinline__ void comb_phase(const Params& p, const u16* osub, u16* attn_out) {
    const int lane = threadIdx.x & 63, gw = blockIdx.x * 8 + (threadIdx.x >> 6), nw = gridDim.x * 8;
    float d1 = p.lq1[lane] * p.lk1[lane] + p.lq1[lane + 64] * p.lk1[lane + 64];
    float d2 = p.lq2[lane] * p.lk2[lane] + p.lq2[lane + 64] * p.lk2[lane + 64];
    d1 = wave_sum(d1); d2 = wave_sum(d2);
    const float lam = __expf(d1) - __expf(d2) + LAMBDA_INIT;
    const int half = lane >> 5, dd = (lane & 31) * 4;
    for (int it = gw; it < T_TOK * 8; it += nw) {
        const int h = it & 7, t = it >> 3, b = t >> 12, s = t & (SEQ - 1);
        const u16* r0 = osub + (((size_t)(b * 32 + (2 * h) * 2 + half)) * SEQ + s) * 128 + dd;
        const u16* r1 = osub + (((size_t)(b * 32 + (2 * h + 1) * 2 + half)) * SEQ + s) * 128 + dd;
        const u32x2v a = *(const u32x2v*)r0, c = *(const u32x2v*)r1;
        const float o0 = bf_lo(a.x) - lam * bf_lo(c.x), o1 = bf_hi(a.x) - lam * bf_hi(c.x), o2 = bf_lo(a.y) - lam * bf_lo(c.y), o3 = bf_hi(a.y) - lam * bf_hi(c.y);
        float ss = o0 * o0 + o1 * o1 + o2 * o2 + o3 * o3;
        ss = wave_sum(ss);
        const float rs = rsqrtf(ss * (1.f / 256.f) + EPS);
        u32x2v o; o.x = pk_bf16(o0 * rs, o1 * rs); o.y = pk_bf16(o2 * rs, o3 * rs);
        *(u32x2v*)(attn_out + (size_t)t * DM + h * 256 + half * 128 + dd) = o;
    }
}

struct EpiPlain {
    static constexpr bool PERM = true, AFTER_DRAIN = false;
    u16* O; int ldc; int pool;
    __device__ __forceinline__ void operator()(const pg8::f32x4 (&acc)[2][2][4][2], const pg8::Unit& u, int wr, int wc, int fr, int fq) const {
        const int pm = pool ? (u.pm & 63) : u.pm;
        const int row0 = pm * 256 + wr * 64 + fr, col0 = u.pn * 256 + wc * 32 + 8 * fq;
#pragma unroll
        for (int ai = 0; ai < 2; ++ai)
#pragma unroll
            for (int m = 0; m < 4; ++m) { u16* rowp = O + (size_t)(row0 + ai * 128 + m * 16) * ldc + col0;
#pragma unroll
                for (int bj = 0; bj < 2; ++bj) { const pg8::f32x4 v0 = acc[ai][bj][m][0], v1 = acc[ai][bj][m][1]; u32x4v w;
                    w.x = pk_bf16(v0[0], v0[1]); w.y = pk_bf16(v0[2], v0[3]); w.z = pk_bf16(v1[0], v1[1]); w.w = pk_bf16(v1[2], v1[3]);
                    *(u32x4v*)(rowp + bj * 128) = w; } }
    }
};
__device__ __forceinline__ float silu_mul(float g, float u) { return g * __builtin_amdgcn_rcpf(1.f + __builtin_amdgcn_exp2f(-1.4426950408889634f * g)) * u; }
struct EpiGateUp {
    static constexpr bool PERM = true, AFTER_DRAIN = false;
    u16* O;
    __device__ __forceinline__ void operator()(const pg8::f32x4 (&acc)[2][2][4][2], const pg8::Unit& u, int wr, int wc, int fr, int fq) const {
        const int row0 = u.pm * 256 + wr * 64 + fr, col0 = u.pn * 128 + wc * 32 + 8 * fq;
#pragma unroll
        for (int ai = 0; ai < 2; ++ai)
#pragma unroll
            for (int m = 0; m < 4; ++m) { u16* rowp = O + (size_t)(row0 + ai * 128 + m * 16) * DFF + col0;
                const pg8::f32x4 g0 = acc[ai][0][m][0], g1 = acc[ai][0][m][1], u0 = acc[ai][1][m][0], u1 = acc[ai][1][m][1]; u32x4v w;
                w.x = pk_bf16(silu_mul(g0[0], u0[0]), silu_mul(g0[1], u0[1])); w.y = pk_bf16(silu_mul(g0[2], u0[2]), silu_mul(g0[3], u0[3]));
                w.z = pk_bf16(silu_mul(g1[0], u1[0]), silu_mul(g1[1], u1[1])); w.w = pk_bf16(silu_mul(g1[2], u1[2]), silu_mul(g1[3], u1[3]));
                *(u32x4v*)rowp = w; }
    }
};
struct EpiQKV {
    static constexpr bool PERM = true, AFTER_DRAIN = false;
    u16* base; const float* cosT; const float* sinT;
    __device__ __forceinline__ void operator()(const pg8::f32x4 (&acc)[2][2][4][2], const pg8::Unit& u, int wr, int wc, int fr, int fq) const {
        const int kind = u.pn >> 3;
        u16* dst = base + (size_t)kind * ((size_t)T_TOK * DM);
        const bool rope = (kind != 1) && (wc == 0);
        const bool up = fq >= 2;
#pragma unroll
        for (int ai = 0; ai < 2; ++ai)
#pragma unroll
            for (int m = 0; m < 4; ++m) {
                const int row = u.pm * 256 + ai * 128 + wr * 64 + m * 16 + fr, b = row >> 12, s = row & (SEQ - 1);
                f32x4v cs0 = {1.f, 1.f, 1.f, 1.f}, cs1 = cs0, sn0 = {0.f, 0.f, 0.f, 0.f}, sn1 = sn0;
                if (rope) { const int i0 = s * 16 + 8 * (fq & 1);
                    cs0 = *(const f32x4v*)(cosT + i0); cs1 = *(const f32x4v*)(cosT + i0 + 4); sn0 = *(const f32x4v*)(sinT + i0); sn1 = *(const f32x4v*)(sinT + i0 + 4);
                    if (!up) { sn0 = -sn0; sn1 = -sn1; } }
#pragma unroll
                for (int bj = 0; bj < 2; ++bj) {
                    const int head = 2 * (u.pn & 7) + bj;
                    u16* rp = dst + ((size_t)(b * 16 + head) * SEQ + s) * 128 + wc * 32 + 8 * fq;
                    pg8::f32x4 a = acc[ai][bj][m][0], c = acc[ai][bj][m][1];
                    if (rope) {
#pragma unroll
                        for (int j = 0; j < 4; ++j) {
                            auto ra = __builtin_amdgcn_permlane32_swap(__float_as_uint(a[j]), __float_as_uint(a[j]), false, false);
                            auto rc = __builtin_amdgcn_permlane32_swap(__float_as_uint(c[j]), __float_as_uint(c[j]), false, false);
                            const float pa_ = __uint_as_float(up ? ra[0] : ra[1]), pc_ = __uint_as_float(up ? rc[0] : rc[1]);
                            a[j] = a[j] * cs0[j] + pa_ * sn0[j]; c[j] = c[j] * cs1[j] + pc_ * sn1[j]; }
                    }
                    u32x4v w; w.x = pk_bf16(a[0], a[1]); w.y = pk_bf16(a[2], a[3]); w.z = pk_bf16(c[0], c[1]); w.w = pk_bf16(c[2], c[3]);
                    *(u32x4v*)rp = w;
                }
            }
    }
};
struct PoolOrder {
    int G, c;
    __device__ bool next(int i, pg8::Unit& u) const { int L = i * G + c; if (L >= 512 * REP_GEMM) return false; L &= 511; const int pne = L & 7, pm = L >> 3; u.pm = (pne >> 1) * 64 + pm; u.pn = pne; return true; }
    __device__ __forceinline__ void a_ready(const pg8::Unit&) const {}
    __device__ __forceinline__ void done(const pg8::Unit&) const {}
};

struct AttItem { int vhd, qb0, qb1; };
__device__ __forceinline__ AttItem att_decode(int L) { AttItem it; const int xcd = L & 7, k = (L >> 3) & 127; it.vhd = xcd * 16 + (k >> 3); it.qb0 = k & 7; it.qb1 = 15 - it.qb0; return it; }
__device__ __forceinline__ att::BlockRef<att::bf16, att::bf16> att_ref(const AttItem& it, int pass, const u16* Kb, const u16* Vb, const u16* Qb, u16* Ob) {
    const int qb = pass ? it.qb1 : it.qb0, b = it.vhd >> 5, r = it.vhd & 31, sh = r >> 1, half = r & 1;
    att::BlockRef<att::bf16, att::bf16> R;
    R.Q = (const att::bf16*)(Qb + ((size_t)(b * 16 + sh) * SEQ + (size_t)qb * 256) * 128);
    R.K = (const att::bf16*)(Kb + ((size_t)(b * 16 + sh) * SEQ) * 128);
    R.V = (const att::bf16*)(Vb + ((size_t)(b * 16 + (sh >> 1) * 2 + half) * SEQ) * 128);
    R.O = (att::bf16*)(Ob + ((size_t)it.vhd * SEQ + (size_t)qb * 256) * 128);
    R.P0 = qb * 256;
    return R;
}
__device__ __forceinline__ void attention_phase(const u16* Kb, const u16* Vb, const u16* Qb, u16* Ob, char* lds) {
    constexpr int TOTAL = 1024 * REP_ATT;
    int L = blockIdx.x; if (L >= TOTAL) return;
    const int stride = gridDim.x;
    AttItem it = att_decode(L); int pass = 0;
    att::BlockRef<att::bf16, att::bf16> cur = att_ref(it, 0, Kb, Vb, Qb, Ob);
    att::Seam<att::bf16> S;
    att::causal_swa_prime<att::bf16, att::bf16>(cur, SEQ, lds, S);
    for (;;) {
        const bool more_pass = pass == 0, more_item = L + stride < TOTAL, last = !more_pass && !more_item;
        AttItem itn = it; int passn = pass + 1, Ln = L;
        if (!more_pass) { passn = 0; Ln = more_item ? L + stride : L; itn = att_decode(Ln); }
        const att::BlockRef<att::bf16, att::bf16> nxt = last ? cur : att_ref(itn, passn, Kb, Vb, Qb, Ob);
        att::causal_swa_block<att::bf16, att::bf16>(cur, nxt, SEQ, SEQ, lds, S);
        if (last) break;
        cur = nxt; it = itn; pass = passn; L = Ln;
    }
}


__device__ __forceinline__ void attention_phase3(const Params& p, const u16* Kb, const u16* Vb, const u16* Qb, float* stash, u16* attn_out, char* lds) {
    const int G = (int)gridDim.x, lane = threadIdx.x & 63;
    float d1 = p.lq1[lane] * p.lk1[lane] + p.lq1[lane + 64] * p.lk1[lane + 64];
    float d2 = p.lq2[lane] * p.lk2[lane] + p.lq2[lane + 64] * p.lk2[lane + 64];
    d1 = wave_sum(d1); d2 = wave_sum(d2);
    const float lam = __expf(d1) - __expf(d2) + LAMBDA_INIT;
#pragma nounroll
    for (int idx = 0; ; ++idx) {
        const int L = (int)blockIdx.x + (idx >> 2) * G; if (L >= 256 * REP_ATT) break;
        const int Lm = L & 255, xcd = Lm & 7, k = Lm >> 3, dh = xcd * 4 + (k >> 3), x = k & 7, b = dh >> 3, h = dh & 7;
        const int qb = (idx & 2) ? 15 - x : x, sub = idx & 1, sh = 2 * h + sub;
        att::Blk2 c;
        c.Q = (const att::bf16*)(Qb + ((size_t)(b * 16 + sh) * SEQ + (size_t)qb * 256) * 128);
        c.K = (const att::bf16*)(Kb + ((size_t)(b * 16 + sh) * SEQ) * 128);
        c.V0 = (const att::bf16*)(Vb + ((size_t)(b * 16 + h * 2) * SEQ) * 128);
        c.V1 = c.V0 + (size_t)SEQ * 128;
        c.O0 = nullptr; c.O1 = nullptr; c.P0 = qb * 256;
        c.stash = stash + (size_t)blockIdx.x * (128 * 512);
        c.comb = (att::bf16*)(attn_out + ((size_t)(b * SEQ + qb * 256)) * DM + h * 256);
        c.lam = lam;
        if (sub == 0) att::attn_block_v256<1>(c, lds); else att::attn_block_v256<2>(c, lds);
    }
}

__global__ __launch_bounds__(512, 2) void mega(Params p) {
    extern __shared__ __attribute__((aligned(16))) unsigned char shm[];
    cg::grid_group grid = cg::this_grid();
    __shared__ uint4 xb_words;
    if (threadIdx.x == 0) xb_words = make_uint4(0u, 0u, 0u, 0u);
    __syncthreads();
    if (p.ph_hi > 1000) grid.sync();
    const XcdBarrier xb = xcd_barrier_post((unsigned*)(p.ws + WS_MISC + MISC_BAR), (volatile __attribute__((address_space(3))) unsigned*)&xb_words);
    unsigned char* ws = p.ws;
    u16* const wpool = (u16*)(ws + WS_WPOOL); u16* const wgu = (u16*)(ws + WS_WGU); u16* const wdn = (u16*)(ws + WS_WDN); u16* const wqkv = (u16*)(ws + WS_WQKV); u16* const wo = (u16*)(ws + WS_WO);
    float* const rstd0 = (float*)(ws + WS_MISC + MISC_RSTD); float* const rstdx = (float*)(ws + WS_MISC + MISC_RSTDX); float* const rs1 = (float*)(ws + WS_MISC + 768 * 1024); float* const rs2 = (float*)(ws + WS_MISC + 832 * 1024); float* const rs3 = (float*)(ws + WS_MISC + 896 * 1024); float* const cosT = (float*)(ws + WS_MISC + MISC_COS); float* const sinT = (float*)(ws + WS_MISC + MISC_SIN);
    u16* const bufA = (u16*)(ws + WS_A); u16* const bufB = (u16*)(ws + WS_B); u16* const mixed = (u16*)(ws + WS_C); u16* const mbuf = (u16*)(ws + WS_C + 64 * MiB); u16* const osub = (u16*)(ws + WS_C);
    const int G = (int)gridDim.x, bid = (int)blockIdx.x;
#define IN(k) (p.ph_lo <= (k) && (k) < p.ph_hi)
#define SYNC(k) do { if (IN(k) && IN((k) + 1) && (k) != 9 && (k) != 0) { xcd_barrier(xb); } } while (0)
    if (IN(0)) {
        conv_loop<0>(p, (2112 + 1088) * REP_CONV, shm);
        for (int e = bid * 512 + (int)threadIdx.x; e < SEQ * 16; e += G * 512) rope_entry(e, cosT, sinT);
        mixed_phase(p.x, mixed, shm);
    }
    SYNC(0);
    SYNC(1);
#ifdef PROBE_MFMA
    if (IN(2)) mfma_probe(rstdx);
#endif
    if (IN(2)) { pg8::Gemm g{mixed, wpool, 4 * T_TOK, 512, 512}; PoolOrder S{G, bid}; EpiPlain E{mbuf, DM, 1};
        pg8::gemm_phase<EpiPlain, PoolOrder, false>((PG8_LAS unsigned char*)shm, g, S, E, nullptr); }
    SYNC(2);
    if (IN(3)) norm_phase<0>(p.x, nullptr, nullptr, mbuf, p.norm_mix_post, mixed, rs1, nullptr);
    SYNC(3);
    if (IN(4)) { pg8::Gemm g{mixed, wgu, T_TOK, 2 * DFF, DM}; pg8::StaticOrder S; S.init(T_TOK, 2 * DFF, G, bid); S.rep = REP_GU; EpiGateUp E{bufA};
        pg8::gemm_phase<EpiGateUp, pg8::StaticOrder, false>((PG8_LAS unsigned char*)shm, g, S, E, nullptr); }
    SYNC(4);
    if (IN(5)) { pg8::Gemm g{bufA, wdn, T_TOK, DM, DFF}; pg8::StaticOrder S; S.init(T_TOK, DM, G, bid); S.rep = REP_DN; EpiPlain E{mbuf, DM, 0};
        pg8::gemm_phase<EpiPlain, pg8::StaticOrder, false>((PG8_LAS unsigned char*)shm, g, S, E, nullptr); }
    SYNC(5);
    if (IN(6)) { norm_phase<1>(nullptr, mixed, rs1, mbuf, p.norm_ffn_post, bufB, rs2, nullptr);
        conv_loop<1>(p, 2112, shm); }
    SYNC(6);
    if (IN(7)) { pg8::Gemm g{bufB, wqkv, T_TOK, 3 * DM, DM}; pg8::StaticOrder S; S.init(T_TOK, 3 * DM, G, bid); EpiQKV E{bufA, cosT, sinT};
        pg8::gemm_phase<EpiQKV, pg8::StaticOrder, false>((PG8_LAS unsigned char*)shm, g, S, E, nullptr); }
    SYNC(7);
    if (IN(8)) attention_phase3(p, bufA, bufA + (size_t)T_TOK * DM, bufA + 2 * (size_t)T_TOK * DM, (float*)mixed, mbuf, (char*)shm);
    SYNC(8);
    SYNC(9);
    if (IN(10)) { pg8::Gemm g{mbuf, wo, T_TOK, DM, DM}; pg8::StaticOrder S; S.init(T_TOK, DM, G, bid); EpiPlain E{mixed, DM, 0};
        pg8::gemm_phase<EpiPlain, pg8::StaticOrder, false>((PG8_LAS unsigned char*)shm, g, S, E, nullptr); }
    SYNC(10);
    if (IN(11)) norm_phase<1>(nullptr, bufB, rs2, mixed, p.norm_mix_post + DM, mbuf, rs3, nullptr);
    SYNC(11);
    if (IN(12)) { pg8::Gemm g{mbuf, wgu, T_TOK, 2 * DFF, DM}; pg8::StaticOrder S; S.init(T_TOK, 2 * DFF, G, bid); S.rep = REP_GU; EpiGateUp E{bufA};
        pg8::gemm_phase<EpiGateUp, pg8::StaticOrder, false>((PG8_LAS unsigned char*)shm, g, S, E, nullptr); }
    SYNC(12);
    if (IN(13)) { pg8::Gemm g{bufA, wdn, T_TOK, DM, DFF}; pg8::StaticOrder S; S.init(T_TOK, DM, G, bid); S.rep = REP_DN; EpiPlain E{mixed, DM, 0};
        pg8::gemm_phase<EpiPlain, pg8::StaticOrder, false>((PG8_LAS unsigned char*)shm, g, S, E, nullptr); }
    SYNC(13);
    if (IN(14)) norm_phase<2>(nullptr, mbuf, rs3, mixed, p.norm_ffn_post + DM, nullptr, nullptr, p.out);
#undef IN
#undef SYNC
}

#ifndef MK_PER_PHASE
#define MK_PER_PHASE 0
#endif
extern "C" void kernel_launch(void* const* d_in, const int* in_sizes, int n_in, void* d_out, int out_size, void* d_ws, size_t ws_size, hipStream_t stream) {
    static int grid = 0;
    if (grid == 0) {
        if (n_in != 19 || out_size != T_TOK * DM || ws_size < WS_END) { fprintf(stderr, "kernel_launch: unexpected shapes (n_in %d out %d ws %zu)\n", n_in, out_size, ws_size); grid = -1; return; }
        int dev = 0, cus = 0, per_cu = 0;
        (void)hipGetDevice(&dev);
        if (hipDeviceGetAttribute(&cus, hipDeviceAttributeMultiprocessorCount, dev) != hipSuccess || cus <= 0) cus = 256;
        if (hipFuncSetAttribute((const void*)mega, hipFuncAttributeMaxDynamicSharedMemorySize, LDS_TOTAL) != hipSuccess) { fprintf(stderr, "kernel_launch: hipFuncSetAttribute failed\n"); grid = -1; return; }
        if (hipOccupancyMaxActiveBlocksPerMultiprocessor(&per_cu, (const void*)mega, 512, LDS_TOTAL) != hipSuccess || per_cu < 1) { fprintf(stderr, "kernel_launch: occupancy query says %d\n", per_cu); per_cu = 1; }
        (void)hipGetLastError();
        grid = cus * per_cu;
    }
    if (grid < 0) return;
    Params p{};
    p.x = (const float*)d_in[0]; p.norm_mix_pre = (const float*)d_in[1]; p.norm_mix_post = (const float*)d_in[2]; p.norm_ffn_pre = (const float*)d_in[3]; p.norm_ffn_post = (const float*)d_in[4];
    p.w_pool = (const float*)d_in[5]; p.pool_scale = (const float*)d_in[6]; p.kv_norm = (const float*)d_in[7]; p.w_kv = (const float*)d_in[8]; p.w_q = (const float*)d_in[9];
    p.lq1 = (const float*)d_in[10]; p.lk1 = (const float*)d_in[11]; p.lq2 = (const float*)d_in[12]; p.lk2 = (const float*)d_in[13]; p.subln = (const float*)d_in[14]; p.w_o = (const float*)d_in[15];
    p.w_gate = (const float*)d_in[16]; p.w_up = (const float*)d_in[17]; p.w_down = (const float*)d_in[18];
    p.out = (float*)d_out; p.ws = (unsigned char*)d_ws;
#if MK_PER_PHASE
    for (int ph = 0; ph <= NPHASE; ++ph) { p.ph_lo = ph; p.ph_hi = ph + 1; hipLaunchKernelGGL(mega, dim3(grid), dim3(512), LDS_TOTAL, stream, p); }
#else
    p.ph_lo = 0; p.ph_hi = NPHASE + 1;
    (void)hipMemsetAsync((unsigned char*)d_ws + WS_MISC + MISC_BAR, 0, BAR_BYTES, stream);
    void* args[] = {&p};
    hipError_t e = hipLaunchCooperativeKernel((const void*)mega, dim3(grid), dim3(512), args, LDS_TOTAL, stream);
    if (e != hipSuccess) fprintf(stderr, "cooperative launch failed: %s (grid %d)\n", hipGetErrorString(e), grid);
#endif
}
```

```cpp
#include <hip/hip_runtime.h>
#include <hip/hip_bf16.h>
#include <hip/hip_cooperative_groups.h>
#include <cstdio>
#include <cstdint>
#ifndef REP_GEMM
#define REP_GEMM 1
#endif
namespace pg8 {
#define PG8_LAS __attribute__((address_space(3)))
typedef unsigned short bf16_t;
typedef short bf16x8 __attribute__((ext_vector_type(8)));
typedef float f32x4 __attribute__((ext_vector_type(4)));
typedef unsigned u32x4 __attribute__((ext_vector_type(4)));
constexpr int BM = 256, BK = 64, HALF = 128, HTB = HALF * BK * 2  , STAGE_BYTES = 8 * HTB, NXCD = 8, WGM = 8;

__host__ __device__ __forceinline__ int lds_byte(int r, int c) { const int st = (r >> 4) * 2 + (c >> 5), rr = r & 15, cc = c & 31, ob = rr * 64 + cc * 2; return st * 1024 + (ob ^ (((ob >> 9) & 1) << 5)); }
__host__ __device__ __forceinline__ void stage_rc(int b, int& R, int& C) { const int st = b / 1024, sb = b % 1024, swz = sb ^ (((sb >> 9) & 1) << 5); R = (st >> 1) * 16 + swz / 64; C = (st & 1) * 32 + (swz % 64) / 2; }
__host__ __device__ __forceinline__ int perm32(int rho) { const int n = rho >> 4, i = rho & 15; return 8 * (i >> 2) + 4 * n + (i & 3); }

struct Unit { int pm, pn; };
struct Gemm { const bf16_t* A; const bf16_t* Bt; int M, N, K; };

struct StaticOrder {
    int nM, nN, nwg, G, c, rep = REP_GEMM;
    __host__ __device__ void init(int M, int N, int G_, int c_) { nM = M / BM; nN = N / BM; nwg = nM * nN; G = G_; c = c_; }
    __host__ __device__ bool next(int i, Unit& u) const {
        long L = (long)i * G + c; if (L >= (long)nwg * rep) return false; L %= nwg;
        int wgid = (int)L; { const int q = nwg / NXCD, r = nwg % NXCD, xcd = wgid % NXCD, off = wgid / NXCD; wgid = (xcd < r ? xcd * (q + 1) : r * (q + 1) + (xcd - r) * q) + off; }
        const int nig = WGM * nN, gid = wgid / nig, fm = gid * WGM, gsz = (nM - fm) < WGM ? (nM - fm) : WGM;
        u.pm = fm + ((wgid % nig) % gsz); u.pn = (wgid % nig) / gsz; return true;
    }
    __device__ __forceinline__ void a_ready(const Unit&) const {}
    __device__ __forceinline__ void done(const Unit&) const {}
};
__device__ __forceinline__ unsigned cvt_pk_bf16(float lo, float hi) { unsigned r; asm volatile("v_cvt_pk_bf16_f32 %0, %1, %2" : "=v"(r) : "v"(lo), "v"(hi)); return r; }
template <class Epi, class Sched, bool STAMP = false>
__device__ __forceinline__ void gemm_phase(PG8_LAS unsigned char* lds, const Gemm g, const Sched& S, const Epi& E, unsigned long long* stamps) {
    const int tid = threadIdx.x, wid = __builtin_amdgcn_readfirstlane(tid >> 6), lane = tid & 63, wr = wid >> 2, wc = wid & 3, fr = lane & 15, fq = lane >> 4;
    const int K = g.K, nt = K / BK;
    int ts_lo = 0, ts_hi = 0, nts = 0; const unsigned long long rt_entry = STAMP ? (unsigned long long)wall_clock64() : 0ull;
#define PG8_STAMP() do { if (STAMP && wid == 0 && nts < 64) { const unsigned long long _c = (unsigned long long)clock64(); \
        ts_lo = (lane == nts) ? (int)(unsigned)_c : ts_lo; ts_hi = (lane == nts) ? (int)(unsigned)(_c >> 32) : ts_hi; ++nts; } } while (0)
    PG8_STAMP();
    unsigned voffA[2], voffB[2];
#pragma unroll
    for (int i = 0; i < 2; ++i) { int R, C; stage_rc(tid * 16 + i * 8192, R, C); const int Rb = Epi::PERM ? ((R & ~31) + perm32(R & 31)) : R;
        voffA[i] = (unsigned)(R * K + C) * 2u; voffB[i] = (unsigned)(Rb * K + C) * 2u; }
    const size_t kstep = (size_t)(BK * 2);
    const size_t hstep = (size_t)HALF * K * 2;
    const size_t tstep = 2 * hstep;
    const unsigned ldsw = (unsigned)wid * 1024u;
    const int aoff = lds_byte(wr * 64 + fr, fq * 8), boff = lds_byte(wc * 32 + fr, fq * 8);
#define PG8_SA(b, h) (((b) * 2 + (h)) * HTB)
#define PG8_SB(b, h) ((4 + (b) * 2 + (h)) * HTB)
#define PG8_STAGE(bufoff, gbase, voff) do { _Pragma("unroll") for (int _i = 0; _i < 2; ++_i) \
        __builtin_amdgcn_global_load_lds((const unsigned*)((const char*)(gbase) + (voff)[_i]), (PG8_LAS unsigned*)(lds + (bufoff) + ldsw + _i * 8192), 16, 0, 0); } while (0)
#define PG8_LDA(dst, b, h) do { _Pragma("unroll") for (int m = 0; m < 4; ++m) _Pragma("unroll") for (int k = 0; k < 2; ++k) dst[m][k] = *(const PG8_LAS bf16x8*)(lds + PG8_SA(b, h) + aoff + m * 2048 + k * 1024); } while (0)
#define PG8_LDB(dst, b, h) do { _Pragma("unroll") for (int n = 0; n < 2; ++n) _Pragma("unroll") for (int k = 0; k < 2; ++k) dst[n][k] = *(const PG8_LAS bf16x8*)(lds + PG8_SB(b, h) + boff + n * 2048 + k * 1024); } while (0)
#define PG8_MMA(ai, bj, At, Bt) do { __builtin_amdgcn_s_setprio(1); _Pragma("unroll") for (int m = 0; m < 4; ++m) _Pragma("unroll") for (int n = 0; n < 2; ++n) _Pragma("unroll") for (int k = 0; k < 2; ++k) \
        acc[ai][bj][m][n] = __builtin_amdgcn_mfma_f32_16x16x32_bf16(Bt[n][k], At[m][k], acc[ai][bj][m][n], 0, 0, 0); __builtin_amdgcn_s_setprio(0); } while (0)
#define PG8_WAIT_V(n) asm volatile("s_waitcnt vmcnt(" #n ")" ::: "memory")
#define PG8_WAIT_L(n) asm volatile("s_waitcnt lgkmcnt(" #n ")" ::: "memory")
#define PG8_BAR __builtin_amdgcn_s_barrier()
#define PG8_SCHED __builtin_amdgcn_sched_barrier(0)
    Unit cur, nxt; int ui = 0;
    if (!S.next(0, cur)) return;
    f32x4 acc[2][2][4][2];
#pragma unroll
    for (int a = 0; a < 2; ++a)
#pragma unroll
        for (int b = 0; b < 2; ++b)
#pragma unroll
            for (int m = 0; m < 4; ++m)
#pragma unroll
                for (int n = 0; n < 2; ++n) acc[a][b][m][n] = (f32x4){0.f, 0.f, 0.f, 0.f};
    bf16x8 At[4][2], B0[2][2], B1[2][2];
    const char* cA = (const char*)g.A + (size_t)cur.pm * tstep; const char* cB = (const char*)g.Bt + (size_t)cur.pn * tstep;
    S.a_ready(cur);
    PG8_STAGE(PG8_SB(0, 0), cB, voffB); PG8_STAGE(PG8_SA(0, 0), cA, voffA); PG8_STAGE(PG8_SB(0, 1), cB + hstep, voffB); PG8_STAGE(PG8_SA(0, 1), cA + hstep, voffA);
    if (wr == 1) PG8_BAR;
    PG8_WAIT_V(4); PG8_BAR;
    PG8_STAGE(PG8_SB(1, 0), cB + kstep, voffB); PG8_STAGE(PG8_SA(1, 0), cA + kstep, voffA); PG8_STAGE(PG8_SB(1, 1), cB + hstep + kstep, voffB);
    PG8_WAIT_V(6); PG8_BAR;
    PG8_STAMP();
    for (;;) {
        const bool has_next = S.next(ui + 1, nxt);
        const char* nA = has_next ? (const char*)g.A + (size_t)nxt.pm * tstep : cA; const char* nB = has_next ? (const char*)g.Bt + (size_t)nxt.pn * tstep : cB;
        for (int t = 0; t < nt; t += 2) {
            const bool last = (t == nt - 2);
            const char* a1 = cA + (size_t)(t + 1) * kstep;
            const char* a2 = last ? nA : cA + (size_t)(t + 2) * kstep; const char* b2 = last ? nB : cB + (size_t)(t + 2) * kstep;
            const char* a3 = a2 + kstep; const char* b3 = b2 + kstep;
            if (last && has_next) S.a_ready(nxt);
            PG8_LDB(B0, 0, 0); PG8_SCHED; PG8_LDA(At, 0, 0); PG8_STAGE(PG8_SA(1, 1), a1 + hstep, voffA);
            PG8_WAIT_L(8); PG8_BAR; PG8_WAIT_L(0); PG8_MMA(0, 0, At, B0); PG8_BAR; PG8_SCHED;
            PG8_LDB(B1, 0, 1); PG8_STAGE(PG8_SB(0, 0), b2, voffB);
            PG8_BAR; PG8_WAIT_L(0); PG8_MMA(0, 1, At, B1); PG8_BAR;
            PG8_LDA(At, 0, 1); PG8_STAGE(PG8_SA(0, 0), a2, voffA);
            PG8_BAR; PG8_WAIT_L(0); PG8_MMA(1, 0, At, B0); PG8_BAR; PG8_SCHED;
            PG8_STAGE(PG8_SB(0, 1), b2 + hstep, voffB);
            PG8_WAIT_V(6); PG8_BAR; PG8_MMA(1, 1, At, B1); PG8_BAR;
            PG8_LDB(B0, 1, 0); PG8_SCHED; PG8_LDA(At, 1, 0); PG8_STAGE(PG8_SA(0, 1), a2 + hstep, voffA);
            PG8_WAIT_L(8); PG8_BAR; PG8_WAIT_L(0); PG8_MMA(0, 0, At, B0); PG8_BAR; PG8_SCHED;
            PG8_LDB(B1, 1, 1); PG8_STAGE(PG8_SB(1, 0), b3, voffB);
            PG8_BAR; PG8_WAIT_L(0); PG8_MMA(0, 1, At, B1); PG8_BAR;
            PG8_LDA(At, 1, 1); PG8_STAGE(PG8_SA(1, 0), a3, voffA);
            PG8_BAR; PG8_WAIT_L(0); PG8_MMA(1, 0, At, B0); PG8_BAR; PG8_SCHED;
            PG8_STAGE(PG8_SB(1, 1), b3 + hstep, voffB);
            PG8_WAIT_V(6); PG8_BAR; PG8_MMA(1, 1, At, B1); PG8_BAR;
        }
        PG8_STAMP();
        if constexpr (!Epi::AFTER_DRAIN) { E(acc, cur, wr, wc, fr, fq); S.done(cur); }
        PG8_STAMP();
        if (!has_next) break;
#pragma unroll
        for (int a = 0; a < 2; ++a)
#pragma unroll
            for (int b = 0; b < 2; ++b)
#pragma unroll
                for (int m = 0; m < 4; ++m)
#pragma unroll
                    for (int n = 0; n < 2; ++n) acc[a][b][m][n] = (f32x4){0.f, 0.f, 0.f, 0.f};
        cur = nxt; cA = nA; cB = nB; ++ui;
    }
    PG8_WAIT_V(0);
    if (wr == 0) PG8_BAR;
    PG8_BAR;
    if constexpr (Epi::AFTER_DRAIN) { E.fused(acc, cur, wr, wc, fr, fq, lds, wid, lane); S.done(cur); }
    PG8_STAMP();
    if (STAMP && wid == 0) { stamps[lane] = lane < nts ? (((unsigned long long)(unsigned)ts_hi << 32) | (unsigned)ts_lo) : 0ull;
        if (lane == 62) stamps[62] = rt_entry; if (lane == 63) stamps[63] = (unsigned long long)wall_clock64(); }
#undef PG8_STAMP
#undef PG8_SA
#undef PG8_SB
#undef PG8_STAGE
#undef PG8_LDA
#undef PG8_LDB
#undef PG8_MMA
#undef PG8_WAIT_V
#undef PG8_WAIT_L
#undef PG8_BAR
#undef PG8_SCHED
}
}
namespace att {
constexpr int D = 128;
constexpr float THR = 8.f;
constexpr bool WSKIP = false;
constexpr float SCALE = 0.08838834764831845f;
constexpr int NW = 8, QBLK = 32, KVBLK = 64, QB = NW * QBLK;
constexpr int SHM_V = KVBLK * D * 2, SHM_K = KVBLK * D * 2;
using bf16 = __hip_bfloat16;
typedef short bf16x8 __attribute__((ext_vector_type(8)));
typedef short s16x4 __attribute__((ext_vector_type(4)));
typedef float f32x16 __attribute__((ext_vector_type(16)));
typedef float f32x4 __attribute__((ext_vector_type(4)));
typedef unsigned u32x4 __attribute__((ext_vector_type(4)));
template <class A, class Bt> struct same_t { static constexpr bool v = false; };
template <class A> struct same_t<A, A> { static constexpr bool v = true; };

#define KSWZ(row, colB) ((row) * 256 + ((colB) ^ (((row) & 7) << 4)))
#define SBAR() __builtin_amdgcn_sched_barrier(0)
__device__ __forceinline__ int v_st(int k, int c) { const int kk = (k & ~0xC) | ((k & 4) << 1) | ((k & 8) >> 1); return ((kk >> 3) * 4 + (c >> 5)) * 512 + ((kk & 7) * 32 + (c & 31)) * 2; }
__device__ __forceinline__ int v_rd_base(int lane) { return ((lane & 3) << 3) | (((lane >> 2) & 3) << 6) | (((lane >> 4) & 1) << 5) | (((lane >> 5) & 1) << 8); }
constexpr int v_rd_off(int d0, int ks, int half) { return d0 * 512 + ks * 4096 + half * 2048; }
__device__ __forceinline__ int crow(int r, int hi) { return (r & 3) + 8 * (r >> 2) + 4 * hi; }
__device__ __forceinline__ unsigned cvtpk(float lo, float hi) {
    unsigned r; asm volatile("v_cvt_pk_bf16_f32 %0, %1, %2" : "=v"(r) : "v"(lo), "v"(hi)); return r;
}
__device__ __forceinline__ bf16x8 pack8(f32x4 a, f32x4 b) {
    u32x4 w = {cvtpk(a[0], a[1]), cvtpk(a[2], a[3]), cvtpk(b[0], b[1]), cvtpk(b[2], b[3])};
    return *reinterpret_cast<bf16x8*>(&w);
}
template <class T> __device__ __forceinline__ bf16x8 load8(const T* p) {
    if constexpr (same_t<T, float>::v) { return pack8(*(const f32x4*)p, *(const f32x4*)(p + 4)); }
    else { return *reinterpret_cast<const bf16x8*>(p); }
}
__device__ __forceinline__ void mask_tile(f32x16& p0, f32x16& p1, int dq, unsigned W) {
    const float NEG = -__builtin_inff();
#pragma unroll
    for (int r = 0; r < 16; ++r) {
        const int c = (r & 3) + 8 * (r >> 2);
        if ((unsigned)(dq - c) >= W) p0[r] = NEG;
        if ((unsigned)(dq - c - 32) >= W) p1[r] = NEG;
    }
}
__device__ __forceinline__ void partialSM(f32x16& p0, f32x16& p1, float& m_reg, float& mn, float& alpha) {
    float pmax = p0[0]; for (int r = 1; r < 16; ++r) pmax = fmaxf(pmax, p0[r]); for (int r = 0; r < 16; ++r) pmax = fmaxf(pmax, p1[r]);
    { auto rr = __builtin_amdgcn_permlane32_swap(__float_as_uint(pmax), __float_as_uint(pmax), false, false);
      pmax = fmaxf(__uint_as_float(rr[0]), __uint_as_float(rr[1])); }
    constexpr float C2 = 1.4426950408889634f * SCALE;
    if (__builtin_expect(__all((pmax - m_reg) * SCALE <= THR), 1)) { mn = m_reg; alpha = 1.f; }
    else { mn = fmaxf(m_reg, pmax); alpha = __builtin_amdgcn_exp2f((m_reg - mn) * C2); m_reg = mn; }
    const float mnL = -mn * C2;
    for (int r = 0; r < 16; ++r) p0[r] = fmaf(p0[r], C2, mnL); for (int r = 0; r < 16; ++r) p1[r] = fmaf(p1[r], C2, mnL);
    for (int r = 0; r < 16; ++r) p0[r] = __builtin_amdgcn_exp2f(p0[r]);
}
__device__ __forceinline__ void finishSM(f32x16& p0, f32x16& p1, float alpha, float& l_reg, bf16x8& pa0, bf16x8& pa1, bf16x8& pa2, bf16x8& pa3) {
    for (int r = 0; r < 16; ++r) p1[r] = __builtin_amdgcn_exp2f(p1[r]);
    float ps = 0; for (int r = 0; r < 16; ++r) ps += p0[r]; for (int r = 0; r < 16; ++r) ps += p1[r];
    { auto rr = __builtin_amdgcn_permlane32_swap(__float_as_uint(ps), __float_as_uint(ps), false, false);
      ps = __uint_as_float(rr[0]) + __uint_as_float(rr[1]); }
    l_reg = l_reg * alpha + ps;
#define PK4(P, B_, OUT) do { unsigned a0 = cvtpk(P[B_+0], P[B_+1]), a1 = cvtpk(P[B_+2], P[B_+3]);                          \
        unsigned b0 = cvtpk(P[B_+4], P[B_+5]), b1 = cvtpk(P[B_+6], P[B_+7]);                                             \
        auto r0 = __builtin_amdgcn_permlane32_swap(a0, b0, false, false); auto r1 = __builtin_amdgcn_permlane32_swap(a1, b1, false, false); \
        u32x4 w = {r0[0], r1[0], r0[1], r1[1]}; OUT = *reinterpret_cast<bf16x8*>(&w); } while (0)
    PK4(p0, 0, pa0); PK4(p0, 8, pa1); PK4(p1, 0, pa2); PK4(p1, 8, pa3);
#undef PK4
}
template <int KB, bool SK>
__device__ __forceinline__ void qkt(f32x16& p0, f32x16& p1, const char* K_lds, int r32, int hi, const bf16x8* qr, bool act) {
    if (SK && !act) { const float NEG = -__builtin_inff();
#pragma unroll
        for (int r = 0; r < 16; ++r) { p0[r] = NEG; p1[r] = NEG; } return; }
    p0 = f32x16{}; p1 = f32x16{};
    const char* kb[4];
#pragma unroll
    for (int dd = 0; dd < 4; ++dd) kb[dd] = K_lds + KB * SHM_K + KSWZ(r32, (dd * 16 + hi * 8) * 2);
#pragma unroll
    for (int d0 = 0; d0 < 8; ++d0) { const char* a = kb[d0 & 3] + (d0 >> 2) * 128;
        bf16x8 b0 = *reinterpret_cast<const bf16x8*>(a);
        bf16x8 b1 = *reinterpret_cast<const bf16x8*>(a + 32 * 256);
        p0 = __builtin_amdgcn_mfma_f32_32x32x16_bf16(b0, qr[d0], p0, 0, 0, 0);
        p1 = __builtin_amdgcn_mfma_f32_32x32x16_bf16(b1, qr[d0], p1, 0, 0, 0); }
}
template <int VB, bool SK>
__device__ __forceinline__ void pv_tile(f32x16* o, int vb0, bf16x8 pa0, bf16x8 pa1, bf16x8 pa2, bf16x8 pa3, bool act) {
    if (SK && !act) return;
#define TRRD(dst, off) asm volatile("ds_read_b64_tr_b16 %0, %1 offset:%2" : "=&v"(dst) : "v"(vb0), "i"(off) : "memory")
#define PV_D0(d0) do { s16x4 l0, l1, l2, l3, h0, h1, h2, h3; constexpr int b_ = VB * SHM_V + v_rd_off(d0, 0, 0);     \
        TRRD(l0, b_); TRRD(h0, b_ + 2048); TRRD(l1, b_ + 4096); TRRD(h1, b_ + 6144); TRRD(l2, b_ + 8192); TRRD(h2, b_ + 10240); TRRD(l3, b_ + 12288); TRRD(h3, b_ + 14336); \
        asm volatile("s_waitcnt lgkmcnt(0)" ::: "memory"); SBAR();                 \
        o[d0] = __builtin_amdgcn_mfma_f32_32x32x16_bf16(pa0, (bf16x8){l0[0], l0[1], l0[2], l0[3], h0[0], h0[1], h0[2], h0[3]}, o[d0], 0, 0, 0);   \
        o[d0] = __builtin_amdgcn_mfma_f32_32x32x16_bf16(pa1, (bf16x8){l1[0], l1[1], l1[2], l1[3], h1[0], h1[1], h1[2], h1[3]}, o[d0], 0, 0, 0);   \
        o[d0] = __builtin_amdgcn_mfma_f32_32x32x16_bf16(pa2, (bf16x8){l2[0], l2[1], l2[2], l2[3], h2[0], h2[1], h2[2], h2[3]}, o[d0], 0, 0, 0);   \
        o[d0] = __builtin_amdgcn_mfma_f32_32x32x16_bf16(pa3, (bf16x8){l3[0], l3[1], l3[2], l3[3], h3[0], h3[1], h3[2], h3[3]}, o[d0], 0, 0, 0); } while (0)
    PV_D0(0); PV_D0(1); PV_D0(2); PV_D0(3);
#undef PV_D0
#undef TRRD
}

template <class TIn, class TOut> struct BlockRef { const TIn* Q; const TIn* K; const TIn* V; TOut* O; int P0; };
template <class TIn> struct Seam {
    bf16x8 qr[8];
    bf16x8 st_v0, st_v1, st_k0, st_k1; f32x4 sf0, sf1, sf2, sf3;
    f32x4 tq[16];
};
__device__ __forceinline__ int swa_jlo(int P0, int W) { const int lowk = P0 - W + 1; return lowk > 0 ? lowk / KVBLK : 0; }
#define ROW(p, k0, rr) ((p) + (size_t)((k0) + (rr)) * D + sc)
#define VMW() asm volatile("s_waitcnt vmcnt(0)" ::: "memory")
#define VMWN(n) asm volatile("s_waitcnt vmcnt(%0)" :: "i"(n) : "memory")
#define SLOAD_H(Kp, Vp, k0) do { S.st_v0 = load8<TIn>(ROW(Vp, k0, sr)); S.st_v1 = load8<TIn>(ROW(Vp, k0, 32 + sr));              \
                         S.st_k0 = load8<TIn>(ROW(Kp, k0, sr)); S.st_k1 = load8<TIn>(ROW(Kp, k0, 32 + sr)); } while (0)
#define SWRITE_HK(bf) do { *(bf16x8*)(K_lds + (bf) * SHM_K + kws) = S.st_k0; *(bf16x8*)(K_lds + (bf) * SHM_K + kws + 32 * 256) = S.st_k1; } while (0)
#define SWRITE_HV(bf) do { *(bf16x8*)(V_lds + (bf) * SHM_V + vst0) = S.st_v0; *(bf16x8*)(V_lds + (bf) * SHM_V + vst1) = S.st_v1; } while (0)
#define SWRITE_H(bf) do { SWRITE_HV(bf); SWRITE_HK(bf); } while (0)
#define SLOAD_F(p, k0) do { S.sf0 = *(const f32x4*)ROW(p, k0, sr); S.sf1 = *(const f32x4*)(ROW(p, k0, sr) + 4);                \
                            S.sf2 = *(const f32x4*)ROW(p, k0, 32 + sr); S.sf3 = *(const f32x4*)(ROW(p, k0, 32 + sr) + 4); } while (0)
#define SWRITE_KF(bf) do { *(bf16x8*)(K_lds + (bf) * SHM_K + kws) = pack8(S.sf0, S.sf1); *(bf16x8*)(K_lds + (bf) * SHM_K + kws + 32 * 256) = pack8(S.sf2, S.sf3); } while (0)
#define SWRITE_VF(bf) do { *(bf16x8*)(V_lds + (bf) * SHM_V + vst0) = pack8(S.sf0, S.sf1); *(bf16x8*)(V_lds + (bf) * SHM_V + vst1) = pack8(S.sf2, S.sf3); } while (0)
template <class TIn, class TOut>
__device__ __forceinline__ void causal_swa_prime(const BlockRef<TIn, TOut>& cur, int W, char* lds, Seam<TIn>& S) {
    constexpr bool F32 = same_t<TIn, float>::v;
    const int tid = threadIdx.x, wid = __builtin_amdgcn_readfirstlane(tid >> 6), lane = tid & 63, r32 = lane & 31, hi = lane >> 5;
    const int sr = tid >> 4, sc = (tid & 15) * 8, kws = KSWZ(sr, sc * 2); char* K_lds = lds + 2 * SHM_V;
    const int kb0 = swa_jlo(cur.P0, W) * KVBLK;
    for (int d0 = 0; d0 < 8; ++d0) S.qr[d0] = load8<TIn>(cur.Q + (size_t)(wid * QBLK + r32) * D + d0 * 16 + hi * 8);
    if constexpr (F32) { SLOAD_F((const float*)cur.K, kb0); VMW(); SWRITE_KF(0); SBAR(); SLOAD_F((const float*)cur.V, kb0); }
    else { SLOAD_H(cur.K, cur.V, kb0); VMW(); SWRITE_HK(0); }
    __syncthreads();
}
template <class TIn, class TOut>
__device__ __forceinline__ void causal_swa_block(const BlockRef<TIn, TOut>& cur, const BlockRef<TIn, TOut>& nxt, int skv, int W, char* lds, Seam<TIn>& S) {
    constexpr bool F32 = same_t<TIn, float>::v;
    const int tid = threadIdx.x, wid = __builtin_amdgcn_readfirstlane(tid >> 6), lane = tid & 63, r32 = lane & 31, hi = lane >> 5;
    const int j_lo = swa_jlo(cur.P0, W);
    int j_hi = (cur.P0 + QB - 1) / KVBLK + 1; if (j_hi > skv / KVBLK) j_hi = skv / KVBLK;
    const int NT = j_hi - j_lo;
    const int kbn = swa_jlo(nxt.P0, W) * KVBLK;
    const int qlo = cur.P0 + wid * QBLK, qm = qlo + r32 - 4 * hi;
    char* V_lds = lds; char* K_lds = lds + 2 * SHM_V;
    float* ws = (float*)(lds + 2 * SHM_V + 2 * SHM_K) + wid * 64; float* li_l = ws, * al_l = ws + 32;
    float m_reg = -1e30f, l_reg = 0; f32x16 o[4] = {};
    const int sr = tid >> 4, sc = (tid & 15) * 8, vst0 = v_st(sr, sc), vst1 = v_st(32 + sr, sc), kws = KSWZ(sr, sc * 2);
    const int vb0 = (int)(uintptr_t)V_lds + v_rd_base(lane);
    const TIn* Kh = cur.K; const TIn* Vh = cur.V;
#define RESC(a) do { if (__any((a) < 1.f)) { if (hi == 0) al_l[r32] = (a); asm volatile("s_waitcnt lgkmcnt(0)" ::: "memory");              \
                     for (int d_ = 0; d_ < 4; ++d_) for (int r = 0; r < 16; ++r) o[d_][r] *= al_l[crow(r, hi)]; } } while (0)
#define KBASE(t) ((j_lo + (t)) * KVBLK)
#define ACT(t) (KBASE(t) <= qlo + QBLK - 1 && KBASE(t) + KVBLK - 1 >= qlo - W + 1)
#define MASKT(P0_, P1_, t) do { const int kb_ = KBASE(t); if ((!SK || ACT(t)) && (kb_ + KVBLK - 1 > qlo || kb_ <= qlo + QBLK - 1 - W)) mask_tile(P0_, P1_, qm - kb_, (unsigned)W); } while (0)
    constexpr int NQL = F32 ? 16 : 8;
    constexpr bool SK = WSKIP && !F32;
#define SEAM_K0() do { VMWN(NQL); if constexpr (F32) { SWRITE_KF(0); SBAR(); SLOAD_F((const float*)nxt.V, kbn); } else { SWRITE_HK(0); } SBAR(); } while (0)
    f32x16 pA0, pA1, pB0, pB1; float mnA, mnB, alA, alB; bf16x8 pa0, pa1, pa2, pa3;
    if constexpr (F32) { VMW(); SWRITE_VF(0); SBAR(); } else { SWRITE_HV(0); SBAR(); }
    if (NT > 1) { if constexpr (F32) SLOAD_F((const float*)Kh, KBASE(1)); else SLOAD_H(Kh, Vh, KBASE(1)); }
    SBAR(); qkt<0, SK>(pA0, pA1, K_lds, r32, hi, S.qr, ACT(0));
    if constexpr (F32) { if (NT > 1) { VMW(); SWRITE_KF(1); SBAR(); SLOAD_F((const float*)Vh, KBASE(1)); } }
    MASKT(pA0, pA1, 0); partialSM(pA0, pA1, m_reg, mnA, alA);
    if (NT > 1) { VMW(); if constexpr (F32) { SWRITE_VF(1); SBAR(); if (NT > 2) SLOAD_F((const float*)Kh, KBASE(2)); } else SWRITE_H(1); }
    __syncthreads();
#define HALF_STEP(PX0, PX1, mnX, alX, PY0, PY1, alY, t, KB, VB, SB) do {                                                      \
        SBAR(); qkt<KB, SK>(PX0, PX1, K_lds, r32, hi, S.qr, ACT(t));                                             \
        finishSM(PY0, PY1, alY, l_reg, pa0, pa1, pa2, pa3); SBAR();                                                           \
        if ((t) + 1 < NT) { if constexpr (F32) { VMW(); SWRITE_KF(SB); SBAR(); SLOAD_F((const float*)Vh, KBASE((t) + 1)); }  \
                            else { SLOAD_H(Kh, Vh, KBASE((t) + 1)); } SBAR(); }                                               \
        pv_tile<VB, SK>(o, vb0, pa0, pa1, pa2, pa3, ACT((t) - 1)); MASKT(PX0, PX1, (t)); partialSM(PX0, PX1, m_reg, mnX, alX);                                        \
        __syncthreads();                                                                                                      \
        if ((t) + 1 < NT) { VMW(); if constexpr (F32) { SWRITE_VF(SB); SBAR(); if ((t) + 2 < NT) SLOAD_F((const float*)Kh, KBASE((t) + 2)); } \
                            else { SWRITE_H(SB); } }                                                                          \
        RESC(alX); __syncthreads(); } while (0)
    for (int t = 1; t + 1 < NT; t += 2) {
        HALF_STEP(pB0, pB1, mnB, alB, pA0, pA1, alA, t, 1, 0, 0);
        HALF_STEP(pA0, pA1, mnA, alA, pB0, pB1, alB, t + 1, 0, 1, 1);
    }
    const bool even = (NT & 1) == 0;
    if (even) { SBAR(); qkt<1, SK>(pB0, pB1, K_lds, r32, hi, S.qr, ACT(NT - 1)); SBAR(); }
#define QROW(e) (nxt.Q + (size_t)(wid * QBLK + r32) * D + ((e) >> 1) * 16 + hi * 8 + ((e) & 1) * 4)
    if constexpr (F32) { SLOAD_F((const float*)nxt.K, kbn); SBAR();
#pragma unroll
        for (int e = 0; e < 8; ++e) S.tq[e] = *(const f32x4*)QROW(e); }
    else { SLOAD_H(nxt.K, nxt.V, kbn); SBAR();
#pragma unroll
        for (int d0 = 0; d0 < 8; ++d0) S.qr[d0] = load8<TIn>(nxt.Q + (size_t)(wid * QBLK + r32) * D + d0 * 16 + hi * 8); }
    SBAR();
    finishSM(pA0, pA1, alA, l_reg, pa0, pa1, pa2, pa3); SBAR();
    if constexpr (F32) {
#pragma unroll
        for (int e = 8; e < 16; ++e) S.tq[e] = *(const f32x4*)QROW(e); SBAR(); }
#undef QROW
    pv_tile<0, SK>(o, vb0, pa0, pa1, pa2, pa3, ACT(even ? NT - 2 : NT - 1));
    if (even) { MASKT(pB0, pB1, NT - 1); partialSM(pB0, pB1, m_reg, mnB, alB); __syncthreads(); RESC(alB);
        finishSM(pB0, pB1, alB, l_reg, pa0, pa1, pa2, pa3); SBAR(); pv_tile<1, SK>(o, vb0, pa0, pa1, pa2, pa3, ACT(NT - 1)); }
    SBAR(); SEAM_K0();
    if (hi == 0) li_l[r32] = l_reg; asm volatile("s_waitcnt lgkmcnt(0)" ::: "memory");
    float rli[16];
#pragma unroll
    for (int r = 0; r < 16; ++r) rli[r] = __builtin_amdgcn_rcpf(li_l[crow(r, hi)]);
    TOut* Ow = cur.O + (size_t)(wid * QBLK) * D;
#pragma unroll
    for (int r = 0; r < 16; ++r) { const int orow = crow(r, hi);
#pragma unroll
        for (int d0 = 0; d0 < 4; ++d0) { const float v = o[d0][r] * rli[r];
            if constexpr (same_t<TOut, float>::v) { Ow[(size_t)orow * D + d0 * 32 + r32] = v; }
            else { const float vn = __shfl_xor(v, 1);
                   if ((r32 & 1) == 0) *(unsigned*)(Ow + (size_t)orow * D + d0 * 32 + r32) = cvtpk(v, vn); } } }
    if constexpr (F32) {
#pragma unroll
        for (int d0 = 0; d0 < 8; ++d0) S.qr[d0] = pack8(S.tq[2 * d0], S.tq[2 * d0 + 1]); }
    __syncthreads();
#undef RESC
#undef KBASE
#undef ACT
#undef MASKT
#undef SEAM_K0
#undef HALF_STEP
}
#undef ROW
#undef VMW
#undef VMWN
#undef SLOAD_H
#undef SWRITE_HK
#undef SWRITE_HV
#undef SWRITE_H
#undef SLOAD_F
#undef SWRITE_KF
#undef SWRITE_VF
}
namespace att {
#define A2_LAS __attribute__((address_space(3)))
struct Blk2 { const bf16* Q; const bf16* K; const bf16* V0; const bf16* V1; bf16* O0; bf16* O1; int P0; float* stash; bf16* comb; float lam; };
template <int EPI>
__device__ __forceinline__ void attn_block_v256(const Blk2& c, char* lds) {
    const int tid = threadIdx.x, wid = __builtin_amdgcn_readfirstlane(tid >> 6), lane = tid & 63, r32 = lane & 31, hi = lane >> 5;
    const int NT = c.P0 / KVBLK + 4;
    const int qlo = c.P0 + wid * QBLK, qm = qlo + r32 - 4 * hi;
    char* K_lds = lds; char* V_lds = lds + 2 * SHM_K;
    float* wsf = (float*)(lds + 4 * SHM_V + 2 * SHM_K) + wid * 64; float* li_l = wsf; float* al_l = wsf + 32;
    const int vb0 = (int)(uintptr_t)V_lds + v_rd_base(lane);
    const char* kbs[4];
#pragma unroll
    for (int dd = 0; dd < 4; ++dd) kbs[dd] = K_lds + KSWZ(r32, (dd * 16 + hi * 8) * 2);
    unsigned koff[2];
#pragma unroll
    for (int j = 0; j < 2; ++j) { const int q = (2 * wid + j) * 64 + lane, row = q >> 4, slot = q & 15; koff[j] = (unsigned)(row * 256 + ((slot ^ (row & 7)) << 4)); }
    unsigned voff;
    { const int kk = 8 * wid + ((lane & 31) >> 2), k = (kk & ~0xC) | ((kk & 4) << 1) | ((kk & 8) >> 1); voff = (unsigned)(k * 256 + (lane >> 5) * 64 + (lane & 3) * 16); }
    bf16x8 qr[8];
#pragma unroll
    for (int d0 = 0; d0 < 8; ++d0) qr[d0] = load8<bf16>(c.Q + (size_t)(wid * QBLK + r32) * D + d0 * 16 + hi * 8);
#define A2_DMA(gp, lp) __builtin_amdgcn_global_load_lds((const unsigned*)(gp), (A2_LAS unsigned*)(lp), 16, 0, 0)
#define A2_STAGE(k0, bf) do { const char* kp_ = (const char*)c.K + (size_t)(k0) * (D * 2); const char* v0_ = (const char*)c.V0 + (size_t)(k0) * (D * 2); const char* v1_ = (const char*)c.V1 + (size_t)(k0) * (D * 2); \
        char* kl_ = K_lds + (bf) * SHM_K + wid * 2048; char* vl_ = V_lds + (bf) * (2 * SHM_V) + wid * 2048; \
        A2_DMA(kp_ + koff[0], kl_); A2_DMA(kp_ + koff[1], kl_ + 1024); \
        A2_DMA(v0_ + voff, vl_); A2_DMA(v0_ + voff + 128, vl_ + 1024); A2_DMA(v1_ + voff, vl_ + SHM_V); A2_DMA(v1_ + voff + 128, vl_ + SHM_V + 1024); } while (0)
#define A2_VMW() asm volatile("s_waitcnt vmcnt(0)" ::: "memory")
#define A2_RESC(a) do { if (__any((a) < 1.f)) { if (hi == 0) al_l[r32] = (a); asm volatile("s_waitcnt lgkmcnt(0)" ::: "memory"); \
                        for (int d_ = 0; d_ < 8; ++d_) for (int r = 0; r < 16; ++r) o[d_][r] *= al_l[crow(r, hi)]; } } while (0)
    A2_STAGE(0, 0); A2_VMW();
    __syncthreads();
    float m_reg = -1e30f, l_reg = 0.f; f32x16 o[8] = {};
    f32x16 p0, p1; float mn, alpha; bf16x8 pa0, pa1, pa2, pa3;
#define A2_QKT(KB) do { p0 = f32x16{}; p1 = f32x16{}; _Pragma("unroll") for (int d0 = 0; d0 < 8; ++d0) { const char* a_ = kbs[d0 & 3] + (KB) * SHM_K + (d0 >> 2) * 128; \
        const bf16x8 b0_ = *reinterpret_cast<const bf16x8*>(a_); const bf16x8 b1_ = *reinterpret_cast<const bf16x8*>(a_ + 32 * 256); \
        p0 = __builtin_amdgcn_mfma_f32_32x32x16_bf16(b0_, qr[d0], p0, 0, 0, 0); p1 = __builtin_amdgcn_mfma_f32_32x32x16_bf16(b1_, qr[d0], p1, 0, 0, 0); } } while (0)
#define A2_STEP(t, BUF) do { \
        if ((t) + 1 < NT) { A2_STAGE(((t) + 1) * KVBLK, (BUF) ^ 1); } \
        if ((t) * KVBLK <= qlo + QBLK - 1) {     \
        SBAR(); A2_QKT(BUF); SBAR(); \
        { const int kb_ = (t) * KVBLK; if (kb_ + KVBLK - 1 > qlo) mask_tile(p0, p1, qm - kb_, (unsigned)0x40000000); } \
        partialSM(p0, p1, m_reg, mn, alpha); \
        finishSM(p0, p1, alpha, l_reg, pa0, pa1, pa2, pa3); SBAR(); \
        A2_RESC(alpha); \
        pv_tile<0, false>(o, vb0 + (BUF) * (2 * SHM_V), pa0, pa1, pa2, pa3, true); \
        pv_tile<1, false>(o + 4, vb0 + (BUF) * (2 * SHM_V), pa0, pa1, pa2, pa3, true); } \
        A2_VMW(); __syncthreads(); } while (0)
    for (int t = 0; t < NT; t += 2) { A2_STEP(t, 0); A2_STEP(t + 1, 1); }
    if (hi == 0) li_l[r32] = l_reg; asm volatile("s_waitcnt lgkmcnt(0)" ::: "memory");
    if (EPI == 0) {
    float rli[16];
#pragma unroll
    for (int r = 0; r < 16; ++r) rli[r] = __builtin_amdgcn_rcpf(li_l[crow(r, hi)]);
#pragma unroll
    for (int r = 0; r < 16; ++r) { const int orow = wid * QBLK + crow(r, hi);
#pragma unroll
        for (int d0 = 0; d0 < 8; ++d0) { const float v = o[d0][r] * rli[r]; const float vn = __shfl_xor(v, 1);
            bf16* Ob = (d0 < 4) ? c.O0 : c.O1;
            if ((r32 & 1) == 0) *(unsigned*)(Ob + (size_t)orow * D + (d0 & 3) * 32 + r32) = cvtpk(v, vn); } }
    } else if (EPI == 1) {
        int tid1 = threadIdx.x; asm volatile("" : "+v"(tid1)); const unsigned toff1 = (unsigned)tid1 * 16u;
#pragma unroll
        for (int q = 0; q < 4; ++q) {
            float rl[4];
#pragma unroll
            for (int j = 0; j < 4; ++j) rl[j] = __builtin_amdgcn_rcpf(li_l[crow(4 * q + j, hi)]);
#pragma unroll
            for (int d0 = 0; d0 < 8; ++d0) { char* sbs = (char*)c.stash + (size_t)(d0 * 4 + q) * 8192;
                *(f32x4*)(sbs + toff1) = (f32x4){o[d0][4 * q] * rl[0], o[d0][4 * q + 1] * rl[1], o[d0][4 * q + 2] * rl[2], o[d0][4 * q + 3] * rl[3]}; }
        }
    } else {
        int tid2 = threadIdx.x; asm volatile("" : "+v"(tid2));
        const int lane2 = tid2 & 63;
        char* tl = lds + 2 * SHM_K + (tid2 >> 6) * 8192;
#pragma unroll
        for (int q = 0; q < 4; ++q) {
            f32x4 sv[8];
#pragma unroll
            for (int d0 = 0; d0 < 8; ++d0) { const char* sbs = (const char*)c.stash + (size_t)(d0 * 4 + q) * 8192; sv[d0] = *(const f32x4*)(sbs + (unsigned)tid2 * 16u); }
#pragma unroll
            for (int j = 0; j < 4; ++j) { const int r = 4 * q + j;
                const float rl = c.lam * __builtin_amdgcn_rcpf(li_l[crow(r, hi)]);
                float dv[8]; float ss = 0.f;
#pragma unroll
                for (int d0 = 0; d0 < 8; ++d0) { dv[d0] = sv[d0][j] - o[d0][r] * rl; ss += dv[d0] * dv[d0]; }
                ss += __shfl_xor(ss, 1); ss += __shfl_xor(ss, 2); ss += __shfl_xor(ss, 4); ss += __shfl_xor(ss, 8); ss += __shfl_xor(ss, 16);
                const float rs = rsqrtf(ss * (1.f / 256.f) + 1e-6f);
                const int lrow = crow(r, hi) - 16 * (q >> 1);
#pragma unroll
                for (int d0 = 0; d0 < 8; ++d0) *(unsigned short*)(tl + lrow * 512 + (d0 * 32 + (lane2 & 31)) * 2) = (unsigned short)cvtpk(dv[d0] * rs, 0.f); }
            if (q & 1) {
                asm volatile("s_waitcnt lgkmcnt(0)" ::: "memory");
                const unsigned loff = (unsigned)((lane2 >> 5) * 4096 + (lane2 & 31) * 16);
#pragma unroll
                for (int it = 0; it < 8; ++it) {
                    const u32x4 w = *(const u32x4*)(tl + (lane2 >> 5) * 512 + (lane2 & 31) * 16 + it * 1024);
                    char* ob = (char*)c.comb + (size_t)(wid * QBLK + 16 * (q >> 1) + 2 * it) * 4096;
                    *(u32x4*)(ob + loff) = w; }
                asm volatile("s_waitcnt lgkmcnt(0)" ::: "memory");
            }
        }
    }
    __syncthreads();
#undef A2_VMW
#undef A2_DMA
#undef A2_STAGE
#undef A2_RESC
#undef A2_STEP
#undef A2_QKT
}
}

#define XB_TMO      128
#define XB_XCNT(j)  (256  + 64 * (j))
#define XB_XSUB(j)  (1280 + 64 * (j))
#define XB_XGEN(j)  (2304 + 64 * (j))
#define XB_TOP      3328
#define XB_TOPGEN   3392
#define XCD_BAR_WORDS 3456
#define XB_SPIN_CAP (1u << 18)
#define LAS __attribute__((address_space(3)))

__device__ __forceinline__ unsigned xb_ld(unsigned* p)              { return __hip_atomic_load(p, __ATOMIC_RELAXED, __HIP_MEMORY_SCOPE_AGENT); }
__device__ __forceinline__ unsigned xb_add(unsigned* p, unsigned v) { return __hip_atomic_fetch_add(p, v, __ATOMIC_RELAXED, __HIP_MEMORY_SCOPE_AGENT); }
__device__ __forceinline__ unsigned xb_xcc_id() { return (unsigned)__builtin_amdgcn_s_getreg((3 << 11) | 20) & 0xFu; }
#define XB_SPIN(cond, bar) do { unsigned _sp = 0; while (cond) { __builtin_amdgcn_s_sleep(1); \
    if ((++_sp & 255u) == 0u) { if (xb_ld(&(bar)[XB_TMO])) break; if (_sp > XB_SPIN_CAP) { atomicAdd(&(bar)[XB_TMO], 1u); break; } } } } while (0)

struct XcdBarrier {
    unsigned* bar; unsigned x;
    volatile LAS unsigned* st;
};

__device__ __forceinline__ XcdBarrier xcd_barrier_post(unsigned* bar, volatile LAS unsigned* st) {
    XcdBarrier b; b.bar = bar; b.x = xb_xcc_id(); b.st = st;
    if (threadIdx.x == 0) (void)xb_add(&bar[XB_XCNT(b.x)], 1u);
    return b;
}
__device__ __forceinline__ void xcd_barrier_complete(unsigned* bar, unsigned x, unsigned& nloc, unsigned& nx) {
    const unsigned G = gridDim.x * gridDim.y * gridDim.z;
    unsigned sum, cnt, mine, sp = 0u;
    for (;;) {
        sum = 0u; cnt = 0u; mine = 0u;
#pragma unroll
        for (unsigned j = 0; j < 16; ++j) { const unsigned c = xb_ld(&bar[XB_XCNT(j)]); sum += c; cnt += (c > 0u) ? 1u : 0u; mine = (j == x) ? c : mine; }
        if (sum == G) break;
        __builtin_amdgcn_s_sleep(1);
        if ((++sp & 255u) == 0u) { if (xb_ld(&bar[XB_TMO])) break; if (sp > XB_SPIN_CAP) { atomicAdd(&bar[XB_TMO], 1u); break; } }
    }
    nloc = mine > 0u ? mine : 1u; nx = cnt > 0u ? cnt : 1u;
}

__device__ __forceinline__ void xcd_barrier(const XcdBarrier& b) {
    asm volatile("s_waitcnt vmcnt(0)" ::: "memory");
    __syncthreads();
    if (threadIdx.x == 0) {
        unsigned* bar = b.bar;
        __builtin_amdgcn_s_waitcnt(0);
        unsigned nloc = b.st[0], nx = b.st[1];
        if (nloc == 0u) { xcd_barrier_complete(bar, b.x, nloc, nx); b.st[0] = nloc; b.st[1] = nx; }
        const unsigned old = xb_add(&bar[XB_XSUB(b.x)], 1u);
        const unsigned gen = old / nloc;
        if (old + 1u == (gen + 1u) * nloc) {
            __builtin_amdgcn_fence(__ATOMIC_RELEASE, "agent");
            asm volatile("s_waitcnt vmcnt(0)" ::: "memory");
            const unsigned og = xb_add(&bar[XB_TOP], 1u);
            const unsigned tg = og / nx;
            if (og + 1u == (tg + 1u) * nx) xb_add(&bar[XB_TOPGEN], 1u);
            else XB_SPIN(xb_ld(&bar[XB_TOPGEN]) == tg, bar);
            __builtin_amdgcn_fence(__ATOMIC_ACQUIRE, "agent");
            xb_add(&bar[XB_XGEN(b.x)], 1u);
            asm volatile("s_waitcnt vmcnt(0)" ::: "memory");
        } else {
            XB_SPIN(xb_ld(&bar[XB_XGEN(b.x)]) == gen, bar);
            __builtin_amdgcn_fence(__ATOMIC_ACQUIRE, "agent");
            asm volatile("s_waitcnt vmcnt(0)" ::: "memory");
        }
    }
    __syncthreads();
}

#undef LAS

namespace cg = cooperative_groups;
#ifndef REP_GEMM
#define REP_GEMM 1
#endif
#ifndef REP_GU
#define REP_GU REP_GEMM
#endif
#ifndef REP_DN
#define REP_DN REP_GEMM
#endif
#ifndef REP_P3
#define REP_P3 1
#endif
#ifndef REP_ATT
#define REP_ATT 1
#endif
#ifndef REP_CONV
#define REP_CONV 1
#endif
typedef unsigned short u16;
typedef float f32x4v __attribute__((ext_vector_type(4)));
typedef unsigned u32x4v __attribute__((ext_vector_type(4)));
typedef unsigned u32x2v __attribute__((ext_vector_type(2)));

constexpr int T_TOK = 16384, DM = 2048, DFF = 5632, SEQ = 4096, NBATCH = 4;
constexpr float EPS = 1e-6f;
constexpr float LAMBDA_INIT = 0.35550906759096934f;
constexpr size_t MiB = (size_t)1 << 20;
constexpr size_t WS_WPOOL = 0, WS_WGU = 2 * MiB, WS_WDN = 46 * MiB, WS_WQKV = 68 * MiB, WS_WO = 92 * MiB, WS_MISC = 100 * MiB,
                 WS_A = 101 * MiB, WS_B = 293 * MiB, WS_C = 357 * MiB, WS_END = 485 * MiB;
constexpr size_t MISC_RSTD = 0, MISC_COS = 64 * 1024, MISC_SIN = 320 * 1024, MISC_BAR = 640 * 1024, BAR_BYTES = 16 * 1024, MISC_RSTDX = 704 * 1024;
constexpr int LDS_TOTAL = 131072;
constexpr int NPHASE = 14;

struct Params {
    const float* x; const float* norm_mix_pre; const float* norm_mix_post; const float* norm_ffn_pre; const float* norm_ffn_post;
    const float* w_pool; const float* pool_scale; const float* kv_norm; const float* w_kv; const float* w_q;
    const float* lq1; const float* lk1; const float* lq2; const float* lk2; const float* subln; const float* w_o;
    const float* w_gate; const float* w_up; const float* w_down;
    float* out; unsigned char* ws;
    int ph_lo, ph_hi;
};

__device__ __forceinline__ unsigned pk_bf16(float lo, float hi) { unsigned r; asm volatile("v_cvt_pk_bf16_f32 %0, %1, %2" : "=v"(r) : "v"(lo), "v"(hi)); return r; }
__device__ __forceinline__ float bf_lo(unsigned w) { return __uint_as_float(w << 16); }
__device__ __forceinline__ float bf_hi(unsigned w) { return __uint_as_float(w & 0xffff0000u); }
__device__ __forceinline__ float wave_sum(float v) {
#pragma unroll
    for (int o = 32; o >= 1; o >>= 1) v += __shfl_xor(v, o);
    return v;
}

struct ConvJob { const float* src; int ld; int c0; int k0; const float* rgain; int rmask; const float* cgain; float scal; u16* dst; int Kdst; };

__device__ __forceinline__ void conv_load(const ConvJob& j, float (&v)[32]) {
    const int tid = threadIdx.x, w = tid >> 6, lane = tid & 63;
    const float* sp = j.src + (size_t)(j.k0 + w * 16 + (lane >> 5) * 8) * j.ld + j.c0 + 4 * (lane & 31);
#pragma unroll
    for (int q = 0; q < 8; ++q) { const f32x4v t = __builtin_nontemporal_load((const f32x4v*)(sp + (size_t)q * j.ld)); v[4 * q] = t.x; v[4 * q + 1] = t.y; v[4 * q + 2] = t.z; v[4 * q + 3] = t.w; }
}
__device__ __forceinline__ void conv_store(const ConvJob& j, const float (&v)[32], unsigned char* lds) {
    const int tid = threadIdx.x, w = tid >> 6, lane = tid & 63, l4 = lane & 31, kh = lane >> 5;
    float cg[4] = {j.scal, j.scal, j.scal, j.scal};
    if (j.cgain) { const float* cp = j.cgain + j.c0 + 4 * l4; cg[0] *= cp[0]; cg[1] *= cp[1]; cg[2] *= cp[2]; cg[3] *= cp[3]; }
#pragma unroll
    for (int q = 0; q < 8; q += 2) {
        const int kl = w * 16 + kh * 8 + q;
        const float rg0 = j.rgain ? j.rgain[(j.k0 + kl) & j.rmask] : 1.f, rg1 = j.rgain ? j.rgain[(j.k0 + kl + 1) & j.rmask] : 1.f;
#pragma unroll
        for (int jj = 0; jj < 4; ++jj)
            *(unsigned*)(lds + (jj * 32 + l4) * 260 + kl * 2) = pk_bf16(v[4 * q + jj] * (cg[jj] * rg0), v[4 * (q + 1) + jj] * (cg[jj] * rg1));
    }
    __syncthreads();
#pragma unroll
    for (int i = 0; i < 4; ++i) {
        const int id = tid + 512 * i, n = id >> 4, c = id & 15, slot = (n & 3) * 32 + (n >> 2);
        const unsigned* lp = (const unsigned*)(lds + slot * 260 + c * 16);
        u32x4v o; o.x = lp[0]; o.y = lp[1]; o.z = lp[2]; o.w = lp[3];
        *(u32x4v*)(j.dst + (size_t)n * j.Kdst + j.k0 + c * 8) = o;
    }
    __syncthreads();
}

__device__ __forceinline__ ConvJob conv_ffn_job(const Params& p, int l, int t) {
    ConvJob j; j.rmask = -1; j.cgain = nullptr; j.scal = 1.f;
    if (t < 1408) { const int nb = t % 88, kt = t / 88, pn = nb >> 1, which = nb & 1;
        j.src = (which ? p.w_up : p.w_gate) + (size_t)l * DM * DFF; j.ld = DFF; j.c0 = pn * 128; j.k0 = kt * 128; j.rgain = p.norm_ffn_pre + l * DM;
        j.dst = (u16*)(p.ws + WS_WGU) + (size_t)nb * 128 * DM; j.Kdst = DM; }
    else { t -= 1408; const int nb = t % 16, kt = t / 16;
        j.src = p.w_down + (size_t)l * DFF * DM; j.ld = DM; j.c0 = nb * 128; j.k0 = kt * 128; j.rgain = nullptr;
        j.dst = (u16*)(p.ws + WS_WDN) + (size_t)nb * 128 * DFF; j.Kdst = DFF; }
    return j;
}
__device__ __forceinline__ ConvJob conv_misc_job(const Params& p, int t) {
    ConvJob j; j.rmask = -1; j.cgain = nullptr; j.scal = 1.f;
    if (t < 64) { const int g = t >> 4, r = t & 15, nt = r & 3, kt = r >> 2;
        j.src = p.w_pool + (size_t)g * 512 * 512; j.ld = 512; j.c0 = nt * 128; j.k0 = kt * 128; j.rgain = p.norm_mix_pre + g * 512; j.cgain = p.pool_scale + g * 512;
        j.dst = (u16*)(p.ws + WS_WPOOL) + (size_t)(g * 512 + nt * 128) * 512; j.Kdst = 512; }
    else if (t < 64 + 768) { t -= 64; const int nb = t % 48, kt = t / 48;
        if (nb < 32) { j.src = p.w_kv; j.ld = 2 * DM; j.c0 = nb * 128; j.rgain = p.kv_norm; }
        else { j.src = p.w_q; j.ld = DM; j.c0 = (nb - 32) * 128; j.rgain = p.norm_mix_pre + DM; }
        j.k0 = kt * 128; j.dst = (u16*)(p.ws + WS_WQKV) + (size_t)nb * 128 * DM; j.Kdst = DM; }
    else { t -= 64 + 768; const int nb = t % 16, kt = t / 16;
        j.src = p.w_o; j.ld = DM; j.c0 = nb * 128; j.k0 = kt * 128; j.rgain = p.subln; j.rmask = 255; j.scal = 1.f - LAMBDA_INIT;
        j.dst = (u16*)(p.ws + WS_WO) + (size_t)nb * 128 * DM; j.Kdst = DM; }
    return j;
}
template <int WHICH>
__device__ __forceinline__ ConvJob conv_job(const Params& p, int t) {
    if (WHICH == 0) { const int tm = t % (2112 + 1088); return tm < 2112 ? conv_ffn_job(p, 0, tm) : conv_misc_job(p, tm - 2112); }
    return conv_ffn_job(p, 1, t);
}
template <int WHICH>
__device__ __forceinline__ void conv_loop(const Params& p, int n, unsigned char* lds) {
    const int G = (int)gridDim.x; int t = (int)blockIdx.x; if (t >= n) return;
    float v[32]; { const ConvJob j = conv_job<WHICH>(p, t); conv_load(j, v); }
    for (;;) {
        const int tn = t + G; const bool more = tn < n;
        float vn[32];
        if (more) { const ConvJob jn = conv_job<WHICH>(p, tn); conv_load(jn, vn); }
        { const ConvJob j = conv_job<WHICH>(p, t); conv_store(j, v, lds); }
        if (!more) break;
        t = tn;
#pragma unroll
        for (int q = 0; q < 32; ++q) v[q] = vn[q];
    }
}

__device__ const float ROPE_INV[16] = {1.000000000e+00f, 4.403665960e-01f, 1.939227432e-01f, 8.539710194e-02f, 3.760603070e-02f, 1.656044088e-02f, 7.292664610e-03f, 3.211446106e-03f,
                                        1.414213562e-03f, 6.227724371e-04f, 2.742481884e-04f, 1.207697351e-04f, 5.318295734e-05f, 2.341999971e-05f, 1.031338525e-05f, 4.541670478e-06f};
__device__ __forceinline__ void rope_entry(int e, float* cosT, float* sinT) {
    constexpr double I2PI = 0.15915494309189535;
    constexpr float HI = (float)I2PI, LO = (float)(I2PI - (double)HI);
    const int s = e >> 4, i = e & 15;
    const float ang = (float)s * ROPE_INV[i];
    const float pr = ang * HI;
    float er = fmaf(ang, HI, -pr); er = fmaf(ang, LO, er);
    const float fr = (pr - rintf(pr)) + er;
    cosT[e] = __builtin_amdgcn_cosf(fr); sinT[e] = __builtin_amdgcn_sinf(fr);
}

__device__ __forceinline__ void rstd_rows(const float* __restrict__ x, float* __restrict__ rstd) {
    const int lane = threadIdx.x & 63, gw = blockIdx.x * 8 + (threadIdx.x >> 6), nw = gridDim.x * 8;
    for (int row0 = gw * 4; row0 < T_TOK; row0 += nw * 4) {
        f32x4v v[4][8];
#pragma unroll
        for (int r = 0; r < 4; ++r) { const f32x4v* rp = (const f32x4v*)(x + (size_t)(row0 + r) * DM);
#pragma unroll
            for (int i = 0; i < 8; ++i) v[r][i] = rp[lane + 64 * i]; }
        float ss[4];
#pragma unroll
        for (int r = 0; r < 4; ++r) { float s = 0.f;
#pragma unroll
            for (int i = 0; i < 8; ++i) s += v[r][i].x * v[r][i].x + v[r][i].y * v[r][i].y + v[r][i].z * v[r][i].z + v[r][i].w * v[r][i].w;
            ss[r] = s; }
#pragma unroll
        for (int o = 32; o >= 1; o >>= 1) {
#pragma unroll
            for (int r = 0; r < 4; ++r) ss[r] += __shfl_xor(ss[r], o); }
        if (lane < 4) { const float s = lane == 0 ? ss[0] : lane == 1 ? ss[1] : lane == 2 ? ss[2] : ss[3]; rstd[row0 + lane] = rsqrtf(s * (1.f / DM) + EPS); }
    }
}

template <int W>
__device__ __forceinline__ void mixed_window(const float* __restrict__ x, const float* rs, u16* __restrict__ op, int t0, int pos0, int col) {
    f32x4v ring[W]; f32x4v S = {0.f, 0.f, 0.f, 0.f};
#pragma unroll
    for (int j = 0; j < W; ++j) { const bool ok = pos0 - W + j >= 0;
        const f32x4v v = *(const f32x4v*)(x + (size_t)(ok ? t0 - W + j : t0) * DM + col) * (ok ? rs[16 - W + j] : 0.f);
        ring[j] = v; S += v; }
#pragma nounroll
    for (int i0 = 0; i0 < 64; i0 += W) {
#pragma unroll
        for (int k = 0; k < W; ++k) { const int i = i0 + k;
            const f32x4v vt = *(const f32x4v*)(x + (size_t)(t0 + i) * DM + col) * rs[16 + i];
            S += vt - ring[k]; ring[k] = vt;
            const float ic = 1.f / (float)min(pos0 + i + 1, W);
            const f32x4v o = S * ic - vt;
            u32x2v pk; pk.x = pk_bf16(o.x, o.y); pk.y = pk_bf16(o.z, o.w);
            *(u32x2v*)(op + (size_t)i * 512) = pk; }
    }
}
__device__ __forceinline__ void mixed_phase(const float* __restrict__ x, u16* __restrict__ mixed, unsigned char* lds) {
    const int tid = threadIdx.x, g = tid >> 7, w = 2 << g, col = tid * 4, wid = tid >> 6, lane = tid & 63;
    float* rs = (float*)(lds + 40 * 1024);
    for (int ch = blockIdx.x; ch < T_TOK / 64; ch += gridDim.x) {
        const int t0 = ch * 64, pos0 = t0 & (SEQ - 1);
#pragma unroll
        for (int gq = 0; gq < 2; ++gq) {
            f32x4v v[5][8]; const int jr0 = wid * 10 + gq * 5;
#pragma unroll
            for (int r = 0; r < 5; ++r) { const int jr = jr0 + r; const bool ok = pos0 - 16 + jr >= 0; const f32x4v* rp = (const f32x4v*)(x + (size_t)(ok ? t0 - 16 + jr : t0) * DM);
#pragma unroll
                for (int i = 0; i < 8; ++i) v[r][i] = rp[lane + 64 * i]; }
            float ss[5];
#pragma unroll
            for (int r = 0; r < 5; ++r) { float s = 0.f;
#pragma unroll
                for (int i = 0; i < 8; ++i) s += v[r][i].x * v[r][i].x + v[r][i].y * v[r][i].y + v[r][i].z * v[r][i].z + v[r][i].w * v[r][i].w;
                ss[r] = s; }
#pragma unroll
            for (int o = 32; o >= 1; o >>= 1) {
#pragma unroll
                for (int r = 0; r < 5; ++r) ss[r] += __shfl_xor(ss[r], o); }
            if (lane < 5) { const float s = lane == 0 ? ss[0] : lane == 1 ? ss[1] : lane == 2 ? ss[2] : lane == 3 ? ss[3] : ss[4]; rs[jr0 + lane] = rsqrtf(s * (1.f / DM) + EPS); }
        }
        __syncthreads();
        u16* op = mixed + ((size_t)g * T_TOK + t0) * 512 + (col & 511);
        switch (g) {
            case 0: mixed_window<2>(x, rs, op, t0, pos0, col); break;
            case 1: mixed_window<4>(x, rs, op, t0, pos0, col); break;
            case 2: mixed_window<8>(x, rs, op, t0, pos0, col); break;
            default: mixed_window<16>(x, rs, op, t0, pos0, col); break;
        }
        __syncthreads();
    }
}

template <int MODE>
__device__ __forceinline__ void norm_phase(const float* __restrict__ xin, const u16* __restrict__ xprev, const float* __restrict__ rprev, const u16* __restrict__ m, const float* __restrict__ gpost, u16* __restrict__ xn, float* __restrict__ rnew, float* __restrict__ out) {
    constexpr int R = 2;
    const int lane = threadIdx.x & 63, gw = blockIdx.x * 8 + (threadIdx.x >> 6), nw = gridDim.x * 8;
    f32x4v gv[8];
#pragma unroll
    for (int i = 0; i < 4; ++i) { gv[2 * i] = ((const f32x4v*)gpost)[2 * (lane + 64 * i)]; gv[2 * i + 1] = ((const f32x4v*)gpost)[2 * (lane + 64 * i) + 1]; }
    for (int row0 = gw * R; row0 < T_TOK; row0 += nw * R) {
        u32x4v mv[R][4]; u32x4v xh[R][4]; f32x4v xw[(MODE == 0) ? R : 1][8];
#pragma unroll
        for (int r = 0; r < R; ++r) {
            const u32x4v* mp = (const u32x4v*)(m + (size_t)(row0 + r) * DM);
#pragma unroll
            for (int i = 0; i < 4; ++i) mv[r][i] = mp[lane + 64 * i];
            if (MODE == 0) { const f32x4v* xp = (const f32x4v*)(xin + (size_t)(row0 + r) * DM);
#pragma unroll
                for (int i = 0; i < 4; ++i) { xw[r][2 * i] = xp[2 * (lane + 64 * i)]; xw[r][2 * i + 1] = xp[2 * (lane + 64 * i) + 1]; } }
            else { const u32x4v* xp = (const u32x4v*)(xprev + (size_t)(row0 + r) * DM);
#pragma unroll
                for (int i = 0; i < 4; ++i) xh[r][i] = xp[lane + 64 * i]; }
        }
        float ss[R];
#pragma unroll
        for (int r = 0; r < R; ++r) { float s = 0.f;
#pragma unroll
            for (int i = 0; i < 4; ++i) { const u32x4v a = mv[r][i];
                const float f0 = bf_lo(a.x), f1 = bf_hi(a.x), f2 = bf_lo(a.y), f3 = bf_hi(a.y), f4 = bf_lo(a.z), f5 = bf_hi(a.z), f6 = bf_lo(a.w), f7 = bf_hi(a.w);
                s += f0 * f0 + f1 * f1 + f2 * f2 + f3 * f3 + f4 * f4 + f5 * f5 + f6 * f6 + f7 * f7; }
            ss[r] = s; }
#pragma unroll
        for (int o = 32; o >= 1; o >>= 1) {
#pragma unroll
            for (int r = 0; r < R; ++r) ss[r] += __shfl_xor(ss[r], o); }
#pragma unroll
        for (int r = 0; r < R; ++r) {
            const float rs = rsqrtf(ss[r] * (1.f / DM) + EPS);
            const float inv = (MODE == 0) ? 1.f : 1.f / rprev[row0 + r];
            f32x4v xv[8]; float sxr = 0.f;
#pragma unroll
            for (int i = 0; i < 4; ++i) {
                const u32x4v a = mv[r][i];
                f32x4v x0, x1;
                if (MODE == 0) { x0 = xw[r][2 * i]; x1 = xw[r][2 * i + 1]; }
                else { const u32x4v b = xh[r][i]; x0 = (f32x4v){bf_lo(b.x), bf_hi(b.x), bf_lo(b.y), bf_hi(b.y)} * inv; x1 = (f32x4v){bf_lo(b.z), bf_hi(b.z), bf_lo(b.w), bf_hi(b.w)} * inv; }
                x0 += (f32x4v){bf_lo(a.x), bf_hi(a.x), bf_lo(a.y), bf_hi(a.y)} * rs * gv[2 * i];
                x1 += (f32x4v){bf_lo(a.z), bf_hi(a.z), bf_lo(a.w), bf_hi(a.w)} * rs * gv[2 * i + 1];
                if (MODE == 2) { f32x4v* op = (f32x4v*)(out + (size_t)(row0 + r) * DM); op[2 * (lane + 64 * i)] = x0; op[2 * (lane + 64 * i) + 1] = x1; }
                else { xv[2 * i] = x0; xv[2 * i + 1] = x1;
                    sxr += x0.x * x0.x + x0.y * x0.y + x0.z * x0.z + x0.w * x0.w + x1.x * x1.x + x1.y * x1.y + x1.z * x1.z + x1.w * x1.w; }
            }
            if (MODE != 2) {
                sxr = wave_sum(sxr);
                const float rx = rsqrtf(sxr * (1.f / DM) + EPS);
                if (lane == 0) rnew[row0 + r] = rx;
#pragma unroll
                for (int i = 0; i < 4; ++i) { const f32x4v a = xv[2 * i] * rx, b = xv[2 * i + 1] * rx; u32x4v o;
                    o.x = pk_bf16(a.x, a.y); o.y = pk_bf16(a.z, a.w); o.z = pk_bf16(b.x, b.y); o.w = pk_bf16(b.z, b.w);
                    ((u32x4v*)(xn + (size_t)(row0 + r) * DM))[lane + 64 * i] = o; }
            }
        }
    }
}

__device__ __forceinline__ void comb_phase(const Params& p, const u16* osub, u16* attn_out) {
    const int lane = threadIdx.x & 63, gw = blockIdx.x * 8 + (threadIdx.x >> 6), nw = gridDim.x * 8;
    float d1 = p.lq1[lane] * p.lk1[lane] + p.lq1[lane + 64] * p.lk1[lane + 64];
    float d2 = p.lq2[lane] * p.lk2[lane] + p.lq2[lane + 64] * p.lk2[lane + 64];
    d1 = wave_sum(d1); d2 = wave_sum(d2);
    const float lam = __expf(d1) - __expf(d2) + LAMBDA_INIT;
    const int half = lane >> 5, dd = (lane & 31) * 4;
    for (int it = gw; it < T_TOK * 8; it += nw) {
        const int h = it & 7, t = it >> 3, b = t >> 12, s = t & (SEQ - 1);
        const u16* r0 = osub + (((size_t)(b * 32 + (2 * h) * 2 + half)) * SEQ + s) * 128 + dd;
        const u16* r1 = osub + (((size_t)(b * 32 + (2 * h + 1) * 2 + half)) * SEQ + s) * 128 + dd;
        const u32x2v a = *(const u32x2v*)r0, c = *(const u32x2v*)r1;
        const float o0 = bf_lo(a.x) - lam * bf_lo(c.x), o1 = bf_hi(a.x) - lam * bf_hi(c.x), o2 = bf_lo(a.y) - lam * bf_lo(c.y), o3 = bf_hi(a.y) - lam * bf_hi(c.y);
        float ss = o0 * o0 + o1 * o1 + o2 * o2 + o3 * o3;
        ss = wave_sum(ss);
        const float rs = rsqrtf(ss * (1.f / 256.f) + EPS);
        u32x2v o; o.x = pk_bf16(o0 * rs, o1 * rs); o.y = pk_bf16(o2 * rs, o3 * rs);
        *(u32x2v*)(attn_out + (size_t)t * DM + h * 256 + half * 128 + dd) = o;
    }
}

struct EpiPlain {
    static constexpr bool PERM = true, AFTER_DRAIN = false;
    u16* O; int ldc; int pool;
    __device__ __forceinline__ void operator()(const pg8::f32x4 (&acc)[2][2][4][2], const pg8::Unit& u, int wr, int wc, int fr, int fq) const {
        const int pm = pool ? (u.pm & 63) : u.pm;
        const int row0 = pm * 256 + wr * 64 + fr, col0 = u.pn * 256 + wc * 32 + 8 * fq;
#pragma unroll
        for (int ai = 0; ai < 2; ++ai)
#pragma unroll
            for (int m = 0; m < 4; ++m) { u16* rowp = O + (size_t)(row0 + ai * 128 + m * 16) * ldc + col0;
#pragma unroll
                for (int bj = 0; bj < 2; ++bj) { const pg8::f32x4 v0 = acc[ai][bj][m][0], v1 = acc[ai][bj][m][1]; u32x4v w;
                    w.x = pk_bf16(v0[0], v0[1]); w.y = pk_bf16(v0[2], v0[3]); w.z = pk_bf16(v1[0], v1[1]); w.w = pk_bf16(v1[2], v1[3]);
                    *(u32x4v*)(rowp + bj * 128) = w; } }
    }
};
__device__ __forceinline__ float silu_mul(float g, float u) { return g * __builtin_amdgcn_rcpf(1.f + __builtin_amdgcn_exp2f(-1.4426950408889634f * g)) * u; }
struct EpiGateUp {
    static constexpr bool PERM = true, AFTER_DRAIN = false;
    u16* O;
    __device__ __forceinline__ void operator()(const pg8::f32x4 (&acc)[2][2][4][2], const pg8::Unit& u, int wr, int wc, int fr, int fq) const {
        const int row0 = u.pm * 256 + wr * 64 + fr, col0 = u.pn * 128 + wc * 32 + 8 * fq;
#pragma unroll
        for (int ai = 0; ai < 2; ++ai)
#pragma unroll
            for (int m = 0; m < 4; ++m) { u16* rowp = O + (size_t)(row0 + ai * 128 + m * 16) * DFF + col0;
                const pg8::f32x4 g0 = acc[ai][0][m][0], g1 = acc[ai][0][m][1], u0 = acc[ai][1][m][0], u1 = acc[ai][1][m][1]; u32x4v w;
                w.x = pk_bf16(silu_mul(g0[0], u0[0]), silu_mul(g0[1], u0[1])); w.y = pk_bf16(silu_mul(g0[2], u0[2]), silu_mul(g0[3], u0[3]));
                w.z = pk_bf16(silu_mul(g1[0], u1[0]), silu_mul(g1[1], u1[1])); w.w = pk_bf16(silu_mul(g1[2], u1[2]), silu_mul(g1[3], u1[3]));
                *(u32x4v*)rowp = w; }
    }
};
struct EpiQKV {
    static constexpr bool PERM = true, AFTER_DRAIN = false;
    u16* base; const float* cosT; const float* sinT;
    __device__ __forceinline__ void operator()(const pg8::f32x4 (&acc)[2][2][4][2], const pg8::Unit& u, int wr, int wc, int fr, int fq) const {
        const int kind = u.pn >> 3;
        u16* dst = base + (size_t)kind * ((size_t)T_TOK * DM);
        const bool rope = (kind != 1) && (wc == 0);
        const bool up = fq >= 2;
#pragma unroll
        for (int ai = 0; ai < 2; ++ai)
#pragma unroll
            for (int m = 0; m < 4; ++m) {
                const int row = u.pm * 256 + ai * 128 + wr * 64 + m * 16 + fr, b = row >> 12, s = row & (SEQ - 1);
                f32x4v cs0 = {1.f, 1.f, 1.f, 1.f}, cs1 = cs0, sn0 = {0.f, 0.f, 0.f, 0.f}, sn1 = sn0;
                if (rope) { const int i0 = s * 16 + 8 * (fq & 1);
                    cs0 = *(const f32x4v*)(cosT + i0); cs1 = *(const f32x4v*)(cosT + i0 + 4); sn0 = *(const f32x4v*)(sinT + i0); sn1 = *(const f32x4v*)(sinT + i0 + 4);
                    if (!up) { sn0 = -sn0; sn1 = -sn1; } }
#pragma unroll
                for (int bj = 0; bj < 2; ++bj) {
                    const int head = 2 * (u.pn & 7) + bj;
                    u16* rp = dst + ((size_t)(b * 16 + head) * SEQ + s) * 128 + wc * 32 + 8 * fq;
                    pg8::f32x4 a = acc[ai][bj][m][0], c = acc[ai][bj][m][1];
                    if (rope) {
#pragma unroll
                        for (int j = 0; j < 4; ++j) {
                            auto ra = __builtin_amdgcn_permlane32_swap(__float_as_uint(a[j]), __float_as_uint(a[j]), false, false);
                            auto rc = __builtin_amdgcn_permlane32_swap(__float_as_uint(c[j]), __float_as_uint(c[j]), false, false);
                            const float pa_ = __uint_as_float(up ? ra[0] : ra[1]), pc_ = __uint_as_float(up ? rc[0] : rc[1]);
                            a[j] = a[j] * cs0[j] + pa_ * sn0[j]; c[j] = c[j] * cs1[j] + pc_ * sn1[j]; }
                    }
                    u32x4v w; w.x = pk_bf16(a[0], a[1]); w.y = pk_bf16(a[2], a[3]); w.z = pk_bf16(c[0], c[1]); w.w = pk_bf16(c[2], c[3]);
                    *(u32x4v*)rp = w;
                }
            }
    }
};
struct PoolOrder {
    int G, c;
    __device__ bool next(int i, pg8::Unit& u) const { int L = i * G + c; if (L >= 512 * REP_GEMM) return false; L &= 511; const int pne = L & 7, pm = L >> 3; u.pm = (pne >> 1) * 64 + pm; u.pn = pne; return true; }
    __device__ __forceinline__ void a_ready(const pg8::Unit&) const {}
    __device__ __forceinline__ void done(const pg8::Unit&) const {}
};

struct AttItem { int vhd, qb0, qb1; };
__device__ __forceinline__ AttItem att_decode(int L) { AttItem it; const int xcd = L & 7, k = (L >> 3) & 127; it.vhd = xcd * 16 + (k >> 3); it.qb0 = k & 7; it.qb1 = 15 - it.qb0; return it; }
__device__ __forceinline__ att::BlockRef<att::bf16, att::bf16> att_ref(const AttItem& it, int pass, const u16* Kb, const u16* Vb, const u16* Qb, u16* Ob) {
    const int qb = pass ? it.qb1 : it.qb0, b = it.vhd >> 5, r = it.vhd & 31, sh = r >> 1, half = r & 1;
    att::BlockRef<att::bf16, att::bf16> R;
    R.Q = (const att::bf16*)(Qb + ((size_t)(b * 16 + sh) * SEQ + (size_t)qb * 256) * 128);
    R.K = (const att::bf16*)(Kb + ((size_t)(b * 16 + sh) * SEQ) * 128);
    R.V = (const att::bf16*)(Vb + ((size_t)(b * 16 + (sh >> 1) * 2 + half) * SEQ) * 128);
    R.O = (att::bf16*)(Ob + ((size_t)it.vhd * SEQ + (size_t)qb * 256) * 128);
    R.P0 = qb * 256;
    return R;
}
__device__ __forceinline__ void attention_phase(const u16* Kb, const u16* Vb, const u16* Qb, u16* Ob, char* lds) {
    constexpr int TOTAL = 1024 * REP_ATT;
    int L = blockIdx.x; if (L >= TOTAL) return;
    const int stride = gridDim.x;
    AttItem it = att_decode(L); int pass = 0;
    att::BlockRef<att::bf16, att::bf16> cur = att_ref(it, 0, Kb, Vb, Qb, Ob);
    att::Seam<att::bf16> S;
    att::causal_swa_prime<att::bf16, att::bf16>(cur, SEQ, lds, S);
    for (;;) {
        const bool more_pass = pass == 0, more_item = L + stride < TOTAL, last = !more_pass && !more_item;
        AttItem itn = it; int passn = pass + 1, Ln = L;
        if (!more_pass) { passn = 0; Ln = more_item ? L + stride : L; itn = att_decode(Ln); }
        const att::BlockRef<att::bf16, att::bf16> nxt = last ? cur : att_ref(itn, passn, Kb, Vb, Qb, Ob);
        att::causal_swa_block<att::bf16, att::bf16>(cur, nxt, SEQ, SEQ, lds, S);
        if (last) break;
        cur = nxt; it = itn; pass = passn; L = Ln;
    }
}


__device__ __forceinline__ void attention_phase3(const Params& p, const u16* Kb, const u16* Vb, const u16* Qb, float* stash, u16* attn_out, char* lds) {
    const int G = (int)gridDim.x, lane = threadIdx.x & 63;
    float d1 = p.lq1[lane] * p.lk1[lane] + p.lq1[lane + 64] * p.lk1[lane + 64];
    float d2 = p.lq2[lane] * p.lk2[lane] + p.lq2[lane + 64] * p.lk2[lane + 64];
    d1 = wave_sum(d1); d2 = wave_sum(d2);
    const float lam = __expf(d1) - __expf(d2) + LAMBDA_INIT;
#pragma nounroll
    for (int idx = 0; ; ++idx) {
        const int L = (int)blockIdx.x + (idx >> 2) * G; if (L >= 256 * REP_ATT) break;
        const int Lm = L & 255, xcd = Lm & 7, k = Lm >> 3, dh = xcd * 4 + (k >> 3), x = k & 7, b = dh >> 3, h = dh & 7;
        const int qb = (idx & 2) ? 15 - x : x, sub = idx & 1, sh = 2 * h + sub;
        att::Blk2 c;
        c.Q = (const att::bf16*)(Qb + ((size_t)(b * 16 + sh) * SEQ + (size_t)qb * 256) * 128);
        c.K = (const att::bf16*)(Kb + ((size_t)(b * 16 + sh) * SEQ) * 128);
        c.V0 = (const att::bf16*)(Vb + ((size_t)(b * 16 + h * 2) * SEQ) * 128);
        c.V1 = c.V0 + (size_t)SEQ * 128;
        c.O0 = nullptr; c.O1 = nullptr; c.P0 = qb * 256;
        c.stash = stash + (size_t)blockIdx.x * (128 * 512);
        c.comb = (att::bf16*)(attn_out + ((size_t)(b * SEQ + qb * 256)) * DM + h * 256);
        c.lam = lam;
        if (sub == 0) att::attn_block_v256<1>(c, lds); else att::attn_block_v256<2>(c, lds);
    }
}

__global__ __launch_bounds__(512, 2) void mega(Params p) {
    extern __shared__ __attribute__((aligned(16))) unsigned char shm[];
    cg::grid_group grid = cg::this_grid();
    __shared__ uint4 xb_words;
    if (threadIdx.x == 0) xb_words = make_uint4(0u, 0u, 0u, 0u);
    __syncthreads();
    if (p.ph_hi > 1000) grid.sync();
    const XcdBarrier xb = xcd_barrier_post((unsigned*)(p.ws + WS_MISC + MISC_BAR), (volatile __attribute__((address_space(3))) unsigned*)&xb_words);
    unsigned char* ws = p.ws;
    u16* const wpool = (u16*)(ws + WS_WPOOL); u16* const wgu = (u16*)(ws + WS_WGU); u16* const wdn = (u16*)(ws + WS_WDN); u16* const wqkv = (u16*)(ws + WS_WQKV); u16* const wo = (u16*)(ws + WS_WO);
    float* const rstd0 = (float*)(ws + WS_MISC + MISC_RSTD); float* const rstdx = (float*)(ws + WS_MISC + MISC_RSTDX); float* const rs1 = (float*)(ws + WS_MISC + 768 * 1024); float* const rs2 = (float*)(ws + WS_MISC + 832 * 1024); float* const rs3 = (float*)(ws + WS_MISC + 896 * 1024); float* const cosT = (float*)(ws + WS_MISC + MISC_COS); float* const sinT = (float*)(ws + WS_MISC + MISC_SIN);
    u16* const bufA = (u16*)(ws + WS_A); u16* const bufB = (u16*)(ws + WS_B); u16* const mixed = (u16*)(ws + WS_C); u16* const mbuf = (u16*)(ws + WS_C + 64 * MiB); u16* const osub = (u16*)(ws + WS_C);
    const int G = (int)gridDim.x, bid = (int)blockIdx.x;
#define IN(k) (p.ph_lo <= (k) && (k) < p.ph_hi)
#define SYNC(k) do { if (IN(k) && IN((k) + 1) && (k) != 9 && (k) != 0) { xcd_barrier(xb); } } while (0)
    if (IN(0)) {
        conv_loop<0>(p, (2112 + 1088) * REP_CONV, shm);
        for (int e = bid * 512 + (int)threadIdx.x; e < SEQ * 16; e += G * 512) rope_entry(e, cosT, sinT);
        mixed_phase(p.x, mixed, shm);
    }
    SYNC(0);
    SYNC(1);
#ifdef PROBE_MFMA
    if (IN(2)) mfma_probe(rstdx);
#endif
    if (IN(2)) { pg8::Gemm g{mixed, wpool, 4 * T_TOK, 512, 512}; PoolOrder S{G, bid}; EpiPlain E{mbuf, DM, 1};
        pg8::gemm_phase<EpiPlain, PoolOrder, false>((PG8_LAS unsigned char*)shm, g, S, E, nullptr); }
    SYNC(2);
    if (IN(3)) norm_phase<0>(p.x, nullptr, nullptr, mbuf, p.norm_mix_post, mixed, rs1, nullptr);
    SYNC(3);
    if (IN(4)) { pg8::Gemm g{mixed, wgu, T_TOK, 2 * DFF, DM}; pg8::StaticOrder S; S.init(T_TOK, 2 * DFF, G, bid); S.rep = REP_GU; EpiGateUp E{bufA};
        pg8::gemm_phase<EpiGateUp, pg8::StaticOrder, false>((PG8_LAS unsigned char*)shm, g, S, E, nullptr); }
    SYNC(4);
    if (IN(5)) { pg8::Gemm g{bufA, wdn, T_TOK, DM, DFF}; pg8::StaticOrder S; S.init(T_TOK, DM, G, bid); S.rep = REP_DN; EpiPlain E{mbuf, DM, 0};
        pg8::gemm_phase<EpiPlain, pg8::StaticOrder, false>((PG8_LAS unsigned char*)shm, g, S, E, nullptr); }
    SYNC(5);
    if (IN(6)) { norm_phase<1>(nullptr, mixed, rs1, mbuf, p.norm_ffn_post, bufB, rs2, nullptr);
        conv_loop<1>(p, 2112, shm); }
    SYNC(6);
    if (IN(7)) { pg8::Gemm g{bufB, wqkv, T_TOK, 3 * DM, DM}; pg8::StaticOrder S; S.init(T_TOK, 3 * DM, G, bid); EpiQKV E{bufA, cosT, sinT};
        pg8::gemm_phase<EpiQKV, pg8::StaticOrder, false>((PG8_LAS unsigned char*)shm, g, S, E, nullptr); }
    SYNC(7);
    if (IN(8)) attention_phase3(p, bufA, bufA + (size_t)T_TOK * DM, bufA + 2 * (size_t)T_TOK * DM, (float*)mixed, mbuf, (char*)shm);
    SYNC(8);
    SYNC(9);
    if (IN(10)) { pg8::Gemm g{mbuf, wo, T_TOK, DM, DM}; pg8::StaticOrder S; S.init(T_TOK, DM, G, bid); EpiPlain E{mixed, DM, 0};
        pg8::gemm_phase<EpiPlain, pg8::StaticOrder, false>((PG8_LAS unsigned char*)shm, g, S, E, nullptr); }
    SYNC(10);
    if (IN(11)) norm_phase<1>(nullptr, bufB, rs2, mixed, p.norm_mix_post + DM, mbuf, rs3, nullptr);
    SYNC(11);
    if (IN(12)) { pg8::Gemm g{mbuf, wgu, T_TOK, 2 * DFF, DM}; pg8::StaticOrder S; S.init(T_TOK, 2 * DFF, G, bid); S.rep = REP_GU; EpiGateUp E{bufA};
        pg8::gemm_phase<EpiGateUp, pg8::StaticOrder, false>((PG8_LAS unsigned char*)shm, g, S, E, nullptr); }
    SYNC(12);
    if (IN(13)) { pg8::Gemm g{bufA, wdn, T_TOK, DM, DFF}; pg8::StaticOrder S; S.init(T_TOK, DM, G, bid); S.rep = REP_DN; EpiPlain E{mixed, DM, 0};
        pg8::gemm_phase<EpiPlain, pg8::StaticOrder, false>((PG8_LAS unsigned char*)shm, g, S, E, nullptr); }
    SYNC(13);
    if (IN(14)) norm_phase<2>(nullptr, mbuf, rs3, mixed, p.norm_ffn_post + DM, nullptr, nullptr, p.out);
#undef IN
#undef SYNC
}

#ifndef MK_PER_PHASE
#define MK_PER_PHASE 0
#endif
extern "C" void kernel_launch(void* const* d_in, const int* in_sizes, int n_in, void* d_out, int out_size, void* d_ws, size_t ws_size, hipStream_t stream) {
    static int grid = 0;
    if (grid == 0) {
        if (n_in != 19 || out_size != T_TOK * DM || ws_size < WS_END) { fprintf(stderr, "kernel_launch: unexpected shapes (n_in %d out %d ws %zu)\n", n_in, out_size, ws_size); grid = -1; return; }
        int dev = 0, cus = 0, per_cu = 0;
        (void)hipGetDevice(&dev);
        if (hipDeviceGetAttribute(&cus, hipDeviceAttributeMultiprocessorCount, dev) != hipSuccess || cus <= 0) cus = 256;
        if (hipFuncSetAttribute((const void*)mega, hipFuncAttributeMaxDynamicSharedMemorySize, LDS_TOTAL) != hipSuccess) { fprintf(stderr, "kernel_launch: hipFuncSetAttribute failed\n"); grid = -1; return; }
        if (hipOccupancyMaxActiveBlocksPerMultiprocessor(&per_cu, (const void*)mega, 512, LDS_TOTAL) != hipSuccess || per_cu < 1) { fprintf(stderr, "kernel_launch: occupancy query says %d\n", per_cu); per_cu = 1; }
        (void)hipGetLastError();
        grid = cus * per_cu;
    }
    if (grid < 0) return;
    Params p{};
    p.x = (const float*)d_in[0]; p.norm_mix_pre = (const float*)d_in[1]; p.norm_mix_post = (const float*)d_in[2]; p.norm_ffn_pre = (const float*)d_in[3]; p.norm_ffn_post = (const float*)d_in[4];
    p.w_pool = (const float*)d_in[5]; p.pool_scale = (const float*)d_in[6]; p.kv_norm = (const float*)d_in[7]; p.w_kv = (const float*)d_in[8]; p.w_q = (const float*)d_in[9];
    p.lq1 = (const float*)d_in[10]; p.lk1 = (const float*)d_in[11]; p.lq2 = (const float*)d_in[12]; p.lk2 = (const float*)d_in[13]; p.subln = (const float*)d_in[14]; p.w_o = (const float*)d_in[15];
    p.w_gate = (const float*)d_in[16]; p.w_up = (const float*)d_in[17]; p.w_down = (const float*)d_in[18];
    p.out = (float*)d_out; p.ws = (unsigned char*)d_ws;
#if MK_PER_PHASE
    for (int ph = 0; ph <= NPHASE; ++ph) { p.ph_lo = ph; p.ph_hi = ph + 1; hipLaunchKernelGGL(mega, dim3(grid), dim3(512), LDS_TOTAL, stream, p); }
#else
    p.ph_lo = 0; p.ph_hi = NPHASE + 1;
    (void)hipMemsetAsync((unsigned char*)d_ws + WS_MISC + MISC_BAR, 0, BAR_BYTES, stream);
    void* args[] = {&p};
    hipError_t e = hipLaunchCooperativeKernel((const void*)mega, dim3(grid), dim3(512), args, LDS_TOTAL, stream);
    if (e != hipSuccess) fprintf(stderr, "cooperative launch failed: %s (grid %d)\n", hipGetErrorString(e), grid);
#endif
}
```
